# Optimizing an MI355X kernel written in HIP

```python
import jax, jax.numpy as jnp
from jax import lax
import numpy as np

D_MODEL = 2048
BATCH = 2
SEQ = 16384
DEPTH = 2

GRID_W = 64
CTX_LEN = 256
HEAD_DIM = 128
N_MIX_HEADS = D_MODEL // HEAD_DIM
GM_GROUPS = N_MIX_HEADS // 4
ATT_HEADS = (3 * N_MIX_HEADS) // 8
ML_HEADS = N_MIX_HEADS - GM_GROUPS - ATT_HEADS
ATT_KV_HEADS = ATT_HEADS // 3
ATT_GROUP = ATT_HEADS // ATT_KV_HEADS
GM_WIDTH = GM_GROUPS * HEAD_DIM
ATT_WIDTH = ATT_HEADS * HEAD_DIM
ATT_KV_WIDTH = ATT_KV_HEADS * HEAD_DIM
ML_WIDTH = ML_HEADS * HEAD_DIM
MIX_WIDTH = GM_WIDTH + ATT_WIDTH + ML_WIDTH
GM_CHUNK = 128
ATT_BLOCK = 128
WINDOW = 128
ROPE_BASE = 10000.0
ML_CHUNK = 128
ML_CONV = 3
FFN_HIDDEN = 4 * D_MODEL
IN_SPLITS = (GM_WIDTH, GM_WIDTH, ATT_WIDTH, ATT_KV_WIDTH, ATT_KV_WIDTH,
             ML_WIDTH, ML_WIDTH, ML_WIDTH, ML_WIDTH, 4 * ML_HEADS)
N_IN = sum(IN_SPLITS)
EPS = 1e-6

kernel_name = 'hybrid_parallel_gmlp_swa_mlstm_dit'


def rms_norm(x, gain):
    x32 = x.astype(jnp.float32)
    y = x32 * lax.rsqrt(jnp.mean(x32 * x32, axis=-1, keepdims=True) + EPS)
    return (y * gain.astype(jnp.float32)).astype(x.dtype)


def modulate(h, shift, scale):
    return h * (1 + scale) + shift


def axial_angles(rows):
    row = jnp.broadcast_to(jnp.arange(rows)[:, None], (rows, GRID_W)).reshape(-1).astype(jnp.float32)
    col = jnp.broadcast_to(jnp.arange(GRID_W)[None, :], (rows, GRID_W)).reshape(-1).astype(jnp.float32)
    half = HEAD_DIM // 2
    freqs = 1.0 / (ROPE_BASE ** (jnp.arange(0, half, 2, dtype=jnp.float32) / half))
    return row[:, None] * freqs, col[:, None] * freqs


def rotate(x, ang):
    m = ang.shape[-1]
    cos = jnp.cos(ang)[:, None, :].astype(x.dtype)
    sin = jnp.sin(ang)[:, None, :].astype(x.dtype)
    x1, x2 = x[..., :m], x[..., m:]
    return jnp.concatenate([x1 * cos - x2 * sin, x1 * sin + x2 * cos], axis=-1)


def axial_rope(x, ang_row, ang_col):
    half = HEAD_DIM // 2
    return jnp.concatenate([rotate(x[..., :half], ang_row), rotate(x[..., half:], ang_col)], axis=-1)


def short_conv(x, w, b):
    pad = ML_CONV // 2
    L = x.shape[1]
    xp = jnp.pad(x, ((0, 0), (pad, pad), (0, 0)))
    y = b + xp[:, 0:L] * w[0]
    for i in range(1, ML_CONV):
        y = y + xp[:, i:i + L] * w[i]
    return jax.nn.silu(y)


def chunk_gmlp(u, v, v_gain, w_s, b_s):
    B, L, _ = u.shape
    n = L // GM_CHUNK
    vh = rms_norm(v.reshape(B, n, GM_CHUNK, GM_GROUPS, HEAD_DIM), v_gain.reshape(GM_GROUPS, HEAD_DIM))
    s = jnp.einsum('gpq,bnqgc->bnpgc', w_s, vh) + b_s.T[None, None, :, :, None]
    return u * s.reshape(B, L, GM_WIDTH)


def window_attention(q, k, v, kc, vc, sink):
    B, L = q.shape[:2]
    nb = L // ATT_BLOCK
    scale = HEAD_DIM ** -0.5
    qb = q.reshape(B, nb, ATT_BLOCK, ATT_KV_HEADS, ATT_GROUP, HEAD_DIM)

    def band(t):
        tp = jnp.pad(t, ((0, 0), (ATT_BLOCK, ATT_BLOCK), (0, 0), (0, 0)))
        tp = tp.reshape(B, nb + 2, ATT_BLOCK, ATT_KV_HEADS, HEAD_DIM)
        return jnp.concatenate([tp[:, :-2], tp[:, 1:-1], tp[:, 2:]], axis=2)

    kw, vw = band(k), band(v)
    blk = jnp.arange(nb)[:, None, None]
    qpos = blk * ATT_BLOCK + jnp.arange(ATT_BLOCK)[None, :, None]
    kpos = (blk - 1) * ATT_BLOCK + jnp.arange(3 * ATT_BLOCK)[None, None, :]
    valid = (jnp.abs(kpos - qpos) <= WINDOW) & (kpos >= 0) & (kpos < L)
    s_loc = jnp.einsum('bnqhgd,bnkhd->bnhgqk', qb, kw).astype(jnp.float32) * scale
    s_loc = jnp.where(valid[None, :, None, None], s_loc, -jnp.inf)
    s_ctx = jnp.einsum('bnqhgd,bchd->bnhgqc', qb, kc).astype(jnp.float32) * scale
    sk = sink.astype(jnp.float32).reshape(ATT_KV_HEADS, ATT_GROUP)[:, :, None]
    m = jnp.maximum(jnp.maximum(s_loc.max(-1), s_ctx.max(-1)), sk)
    p_loc = jnp.exp(s_loc - m[..., None])
    p_ctx = jnp.exp(s_ctx - m[..., None])
    den = p_loc.sum(-1) + p_ctx.sum(-1) + jnp.exp(sk - m)
    o = (jnp.einsum('bnhgqk,bnkhd->bnqhgd', p_loc.astype(v.dtype), vw)
         + jnp.einsum('bnhgqc,bchd->bnqhgd', p_ctx.astype(vc.dtype), vc))
    o = o / jnp.moveaxis(den, -1, 2)[..., None].astype(o.dtype)
    return o.reshape(B, L, ATT_WIDTH)


def context_attention(qc, kc, vc, sink):
    B, Lc = qc.shape[:2]
    scale = HEAD_DIM ** -0.5
    qg = qc.reshape(B, Lc, ATT_KV_HEADS, ATT_GROUP, HEAD_DIM)
    s = jnp.einsum('bqhgd,bkhd->bhgqk', qg, kc).astype(jnp.float32) * scale
    sk = sink.astype(jnp.float32).reshape(ATT_KV_HEADS, ATT_GROUP)[:, :, None]
    m = jnp.maximum(s.max(-1), sk)
    p = jnp.exp(s - m[..., None])
    den = p.sum(-1) + jnp.exp(sk - m)
    o = jnp.einsum('bhgqk,bkhd->bqhgd', p.astype(vc.dtype), vc)
    o = o / jnp.moveaxis(den, -1, 1)[..., None].astype(o.dtype)
    return o.reshape(B, Lc, ATT_WIDTH)


def mlstm_states(k, v, log_i, log_f, state):
    B, H, L, d = k.shape
    nc = L // ML_CHUNK
    kb = k.reshape(B, H, nc, ML_CHUNK, d)
    vb = v.reshape(B, H, nc, ML_CHUNK, d)
    li = log_i.reshape(B, H, nc, ML_CHUNK)
    b = jnp.cumsum(log_f.reshape(B, H, nc, ML_CHUNK), axis=-1)
    g = b[..., -1]
    a = g[..., None] - b + li
    m_loc = a.max(-1)
    w = jnp.exp(a - m_loc[..., None])
    dC = jnp.einsum('bhntv,bhntk->bhnvk', vb * w[..., None], kb)
    dn = jnp.einsum('bhnt,bhntk->bhnk', w, kb)

    def step(carry, xs):
        C, n, m = carry
        g_j, ml_j, dC_j, dn_j = xs
        m_new = jnp.maximum(g_j + m, ml_j)
        a_old = jnp.exp(g_j + m - m_new)
        a_new = jnp.exp(ml_j - m_new)
        C_new = a_old[..., None, None] * C + a_new[..., None, None] * dC_j
        n_new = a_old[..., None] * n + a_new[..., None] * dn_j
        return (C_new, n_new, m_new), (C, n, m)

    xs = (jnp.moveaxis(g, 2, 0), jnp.moveaxis(m_loc, 2, 0), jnp.moveaxis(dC, 2, 0), jnp.moveaxis(dn, 2, 0))
    final, starts = lax.scan(step, state, xs)
    starts = tuple(jnp.moveaxis(s, 0, 2) for s in starts)
    return b, starts, final


def mlstm_outputs(q, k, v, log_i, b, starts):
    C0, n0, m0 = starts
    B, H, L, d = q.shape
    nc = L // ML_CHUNK
    qb = q.reshape(B, H, nc, ML_CHUNK, d)
    kb = k.reshape(B, H, nc, ML_CHUNK, d)
    vb = v.reshape(B, H, nc, ML_CHUNK, d)
    li = log_i.reshape(B, H, nc, ML_CHUNK)
    order = jnp.tril(jnp.ones((ML_CHUNK, ML_CHUNK), dtype=bool))
    D = jnp.where(order, b[..., :, None] - b[..., None, :] + li[..., None, :], -jnp.inf)
    e = b + m0[..., None]
    m_t = jnp.maximum(e, D.max(-1))
    S = jnp.einsum('bhntd,bhnsd->bhnts', qb, kb) * jnp.exp(D - m_t[..., None])
    inter = jnp.exp(e - m_t)
    num = jnp.einsum('bhnts,bhnsv->bhntv', S, vb) + inter[..., None] * jnp.einsum('bhnvk,bhntk->bhntv', C0, qb)
    den = S.sum(-1) + inter * jnp.einsum('bhnk,bhntk->bhnt', n0, qb)
    h = num / jnp.maximum(jnp.abs(den), jnp.exp(-m_t))[..., None]
    return h.reshape(B, H, L, d)


def mlstm_mixer(q, k, v, o, gates, kc, vc, gates_c, b_i, b_f, out_gain, qc=None, oc=None):
    f32 = jnp.float32
    scale = HEAD_DIM ** -0.5

    def heads(t):
        B, L, _ = t.shape
        return t.reshape(B, L, ML_HEADS, HEAD_DIM).transpose(0, 2, 1, 3).astype(f32)

    def gate_logs(gt, direction):
        B, L, _ = gt.shape
        gt = gt.reshape(B, L, 2, 2, ML_HEADS).astype(f32)
        log_i = gt[:, :, direction, 0] + b_i[direction].astype(f32)
        log_f = jax.nn.log_sigmoid(gt[:, :, direction, 1] + b_f[direction].astype(f32))
        return log_i.transpose(0, 2, 1), log_f.transpose(0, 2, 1)

    qh, kh, vh = heads(q), heads(k) * scale, heads(v)
    kch, vch = heads(kc) * scale, heads(vc)
    B = q.shape[0]
    zero = (jnp.zeros((B, ML_HEADS, HEAD_DIM, HEAD_DIM), f32),
            jnp.zeros((B, ML_HEADS, HEAD_DIM), f32),
            jnp.zeros((B, ML_HEADS), f32))
    h_dirs, hc_dirs = [], []
    for direction in range(2):
        if direction == 0:
            rev = lambda t: t
        else:
            rev = lambda t: jnp.flip(t, axis=2)
        lic, lfc = (rev(t) for t in gate_logs(gates_c, direction))
        b_c, starts_c, final_c = mlstm_states(rev(kch), rev(vch), lic, lfc, zero)
        if qc is not None:
            hc_dirs.append(rev(mlstm_outputs(rev(heads(qc)), rev(kch), rev(vch), lic, b_c, starts_c)))
        li, lf = (rev(t) for t in gate_logs(gates, direction))
        b_l, starts_l, _ = mlstm_states(rev(kh), rev(vh), li, lf, final_c)
        h_dirs.append(rev(mlstm_outputs(rev(qh), rev(kh), rev(vh), li, b_l, starts_l)))

    def merge(hs, og):
        h = (hs[0] + hs[1]).transpose(0, 2, 1, 3)
        Bm, L = h.shape[:2]
        h = rms_norm(h, out_gain.reshape(ML_HEADS, HEAD_DIM)).reshape(Bm, L, ML_WIDTH)
        return (h * jax.nn.sigmoid(og.astype(f32))).astype(og.dtype)

    y = merge(h_dirs, o)
    yc = merge(hc_dirs, oc) if qc is not None else None
    return y, yc


def sq_relu_mlp(h, w1, w2):
    return jnp.square(jax.nn.relu(h @ w1)) @ w2


def hybrid_layer(x, xc, mod, mod_c, g_mix, g_ffn, w_in, gm_v_gain, gm_w_s, gm_b_s, attn_sink,
                 ml_conv_w, ml_conv_b, ml_b_i, ml_b_f, ml_out_gain, w_out, w_ff1, w_ff2,
                 ang_row, ang_col, need_ctx):
    B, L, _ = x.shape
    Lc = xc.shape[1]
    sh1, sc1, gt1, sh2, sc2, gt2 = jnp.split(mod, 6, axis=-1)
    csh1, csc1, cgt1, csh2, csc2, cgt2 = jnp.split(mod_c, 6, axis=-1)
    cuts = np.cumsum(IN_SPLITS)[:-1].tolist()
    gu, gv, aq, ak, av, mq, mk, mv, mo, mg = jnp.split(
        modulate(rms_norm(x, g_mix), sh1, sc1) @ w_in, cuts, axis=-1)
    gu_c, gv_c, aq_c, ak_c, av_c, mq_c, mk_c, mv_c, mo_c, mg_c = jnp.split(
        modulate(rms_norm(xc, g_mix), csh1, csc1) @ w_in, cuts, axis=-1)

    ya = chunk_gmlp(jax.nn.gelu(gu), jax.nn.gelu(gv), gm_v_gain, gm_w_s, gm_b_s)

    k_c = ak_c.reshape(B, Lc, ATT_KV_HEADS, HEAD_DIM)
    v_c = av_c.reshape(B, Lc, ATT_KV_HEADS, HEAD_DIM)
    yb = window_attention(axial_rope(aq.reshape(B, L, ATT_HEADS, HEAD_DIM), ang_row, ang_col),
                          axial_rope(ak.reshape(B, L, ATT_KV_HEADS, HEAD_DIM), ang_row, ang_col),
                          av.reshape(B, L, ATT_KV_HEADS, HEAD_DIM), k_c, v_c, attn_sink)

    wq, wk = ml_conv_w[:, :ML_WIDTH], ml_conv_w[:, ML_WIDTH:]
    bq, bk = ml_conv_b[:ML_WIDTH], ml_conv_b[ML_WIDTH:]
    yc, yc_c = mlstm_mixer(short_conv(mq, wq, bq), short_conv(mk, wk, bk), mv, mo, mg,
                           short_conv(mk_c, wk, bk), mv_c, mg_c, ml_b_i, ml_b_f, ml_out_gain,
                           qc=short_conv(mq_c, wq, bq) if need_ctx else None,
                           oc=mo_c if need_ctx else None)

    x = x + gt1 * (jnp.concatenate([ya, yb, yc], axis=-1) @ w_out)
    x = x + gt2 * sq_relu_mlp(modulate(rms_norm(x, g_ffn), sh2, sc2), w_ff1, w_ff2)

    if need_ctx:
        ya_c = chunk_gmlp(jax.nn.gelu(gu_c), jax.nn.gelu(gv_c), gm_v_gain, gm_w_s, gm_b_s)
        yb_c = context_attention(aq_c.reshape(B, Lc, ATT_HEADS, HEAD_DIM), k_c, v_c, attn_sink)
        xc = xc + cgt1 * (jnp.concatenate([ya_c, yb_c, yc_c], axis=-1) @ w_out)
        xc = xc + cgt2 * sq_relu_mlp(modulate(rms_norm(xc, g_ffn), csh2, csc2), w_ff1, w_ff2)
    return x, xc


def setup_inputs(seed: int = 0) -> dict:
    key = jax.random.key(seed)
    ks = jax.random.split(key, 24)
    f32 = jnp.float32

    def nrm(k, shape, s):
        return jax.random.normal(k, shape, f32) * s

    return {
        'x': nrm(ks[0], (BATCH, SEQ, D_MODEL), 1.0),
        'c': nrm(ks[1], (BATCH, D_MODEL), 1.0),
        'ctx': nrm(ks[2], (BATCH, CTX_LEN, D_MODEL), 1.0),
        'c_ctx': nrm(ks[3], (D_MODEL,), 1.0),
        'w_ada': nrm(ks[4], (DEPTH, D_MODEL, 6 * D_MODEL), 0.5 * D_MODEL ** -0.5),
        'b_ada': nrm(ks[5], (DEPTH, 6 * D_MODEL), 0.02),
        'g_mix': 1.0 + nrm(ks[6], (DEPTH, D_MODEL), 0.02),
        'g_ffn': 1.0 + nrm(ks[7], (DEPTH, D_MODEL), 0.02),
        'w_in': nrm(ks[8], (DEPTH, D_MODEL, N_IN), D_MODEL ** -0.5),
        'gm_v_gain': 1.0 + nrm(ks[9], (DEPTH, GM_WIDTH), 0.02),
        'gm_w_s': nrm(ks[10], (DEPTH, GM_GROUPS, GM_CHUNK, GM_CHUNK), GM_CHUNK ** -0.5),
        'gm_b_s': 1.0 + nrm(ks[11], (DEPTH, GM_GROUPS, GM_CHUNK), 0.02),
        'attn_sink': nrm(ks[12], (DEPTH, ATT_HEADS), 0.5),
        'ml_conv_w': nrm(ks[13], (DEPTH, ML_CONV, 2 * ML_WIDTH), ML_CONV ** -0.5),
        'ml_conv_b': nrm(ks[14], (DEPTH, 2 * ML_WIDTH), 0.02),
        'ml_b_i': nrm(ks[15], (DEPTH, 2, ML_HEADS), 0.1),
        'ml_b_f': jax.random.uniform(ks[16], (DEPTH, 2, ML_HEADS), f32, 3.0, 6.0),
        'ml_out_gain': 1.0 + nrm(ks[17], (DEPTH, ML_WIDTH), 0.02),
        'w_out': nrm(ks[18], (DEPTH, MIX_WIDTH, D_MODEL), MIX_WIDTH ** -0.5),
        'w_ff1': nrm(ks[19], (DEPTH, D_MODEL, FFN_HIDDEN), D_MODEL ** -0.5),
        'w_ff2': nrm(ks[20], (DEPTH, FFN_HIDDEN, D_MODEL), FFN_HIDDEN ** -0.5),
        'g_final': 1.0 + nrm(ks[21], (D_MODEL,), 0.02),
    }


def reference(x, c, ctx, c_ctx, w_ada, b_ada, g_mix, g_ffn, w_in, gm_v_gain, gm_w_s, gm_b_s, attn_sink,
              ml_conv_w, ml_conv_b, ml_b_i, ml_b_f, ml_out_gain, w_out, w_ff1, w_ff2, g_final):
    rows = x.shape[1] // GRID_W
    ang_row, ang_col = axial_angles(rows)
    xc = ctx
    sc = jax.nn.silu(c)
    scc = jax.nn.silu(c_ctx)
    for layer in range(DEPTH):
        mod = (sc @ w_ada[layer] + b_ada[layer])[:, None, :]
        mod_c = scc @ w_ada[layer] + b_ada[layer]
        x, xc = hybrid_layer(x, xc, mod, mod_c, g_mix[layer], g_ffn[layer], w_in[layer],
                             gm_v_gain[layer], gm_w_s[layer], gm_b_s[layer], attn_sink[layer],
                             ml_conv_w[layer], ml_conv_b[layer], ml_b_i[layer], ml_b_f[layer],
                             ml_out_gain[layer], w_out[layer], w_ff1[layer], w_ff2[layer],
                             ang_row, ang_col, layer < DEPTH - 1)
    return rms_norm(x, g_final)
```

```cpp
#include <hip/hip_runtime.h>
#include <hip/hip_cooperative_groups.h>
#include <cstdio>
namespace cg = cooperative_groups;
namespace pg8 {
#define PG8_LAS __attribute__((address_space(3)))
typedef unsigned short bf16_t;
typedef short bf16x8 __attribute__((ext_vector_type(8)));
typedef float f32x4 __attribute__((ext_vector_type(4)));
typedef unsigned u32x4 __attribute__((ext_vector_type(4)));
constexpr int BM = 256, BK = 64, HALF = 128, HTB = HALF * BK * 2  , STAGE_BYTES = 8 * HTB, NXCD = 8, WGM = 8;

__host__ __device__ __forceinline__ int lds_byte(int r, int c) { const int st = (r >> 4) * 2 + (c >> 5), rr = r & 15, cc = c & 31, ob = rr * 64 + cc * 2; return st * 1024 + (ob ^ (((ob >> 9) & 1) << 5)); }
__host__ __device__ __forceinline__ void stage_rc(int b, int& R, int& C) { const int st = b / 1024, sb = b % 1024, swz = sb ^ (((sb >> 9) & 1) << 5); R = (st >> 1) * 16 + swz / 64; C = (st & 1) * 32 + (swz % 64) / 2; }
__host__ __device__ __forceinline__ int perm32(int rho) { const int n = rho >> 4, i = rho & 15; return 8 * (i >> 2) + 4 * n + (i & 3); }

struct Unit { int pm, pn; };
struct Gemm { const bf16_t* A; const bf16_t* Bt; int M, N, K; };

struct StaticOrder {
    int nM, nN, nwg, G, c;
    __host__ __device__ void init(int M, int N, int G_, int c_) { nM = M / BM; nN = N / BM; nwg = nM * nN; G = G_; c = c_; }
    __host__ __device__ bool next(int i, Unit& u) const {
        const long L = (long)i * G + c; if (L >= nwg) return false;
        int wgid = (int)L; { const int q = nwg / NXCD, r = nwg % NXCD, xcd = wgid % NXCD, off = wgid / NXCD; wgid = (xcd < r ? xcd * (q + 1) : r * (q + 1) + (xcd - r) * q) + off; }
        const int nig = WGM * nN, gid = wgid / nig, fm = gid * WGM, gsz = (nM - fm) < WGM ? (nM - fm) : WGM;
        u.pm = fm + ((wgid % nig) % gsz); u.pn = (wgid % nig) / gsz; return true;
    }
    __device__ __forceinline__ void a_ready(const Unit&) const {}
    __device__ __forceinline__ void done(const Unit&) const {}
};
template <class Epi, class Sched, bool STAMP = false>
__device__ __forceinline__ void gemm_phase(PG8_LAS unsigned char* lds, const Gemm g, const Sched& S, const Epi& E, unsigned long long* stamps) {
    int tid_ = threadIdx.x; asm volatile("" : "+v"(tid_)); const int tid = tid_, wid = __builtin_amdgcn_readfirstlane(tid >> 6), lane = tid & 63, wr = wid >> 2, wc = wid & 3, fr = lane & 15, fq = lane >> 4;
    const int K = g.K, nt = K / BK;
    int ts_lo = 0, ts_hi = 0, nts = 0; const unsigned long long rt_entry = STAMP ? (unsigned long long)wall_clock64() : 0ull;
#define PG8_STAMP() do { if (STAMP && wid == 0 && nts < 64) { const unsigned long long _c = (unsigned long long)clock64(); \
        ts_lo = (lane == nts) ? (int)(unsigned)_c : ts_lo; ts_hi = (lane == nts) ? (int)(unsigned)(_c >> 32) : ts_hi; ++nts; } } while (0)
    PG8_STAMP();
    unsigned voffA[2], voffB[2];
#pragma unroll
    for (int i = 0; i < 2; ++i) { int R, C; stage_rc(tid * 16 + i * 8192, R, C); const int Rb = Epi::PERM ? ((R & ~31) + perm32(R & 31)) : R;
        voffA[i] = (unsigned)(R * K + C) * 2u; voffB[i] = (unsigned)(Rb * K + C) * 2u; }
    const size_t kstep = (size_t)(BK * 2);
    const size_t hstep = (size_t)HALF * K * 2;
    const size_t tstep = 2 * hstep;
    const unsigned ldsw = (unsigned)wid * 1024u;
    const int aoff = lds_byte(wr * 64 + fr, fq * 8), boff = lds_byte(wc * 32 + fr, fq * 8);
#define PG8_SA(b, h) (((b) * 2 + (h)) * HTB)
#define PG8_SB(b, h) ((4 + (b) * 2 + (h)) * HTB)
#define PG8_STAGE(bufoff, gbase, voff) do { _Pragma("unroll") for (int _i = 0; _i < 2; ++_i) \
        __builtin_amdgcn_global_load_lds((const unsigned*)((const char*)(gbase) + (voff)[_i]), (PG8_LAS unsigned*)(lds + (bufoff) + ldsw + _i * 8192), 16, 0, 0); } while (0)
#define PG8_LDA(dst, b, h) do { _Pragma("unroll") for (int m = 0; m < 4; ++m) _Pragma("unroll") for (int k = 0; k < 2; ++k) dst[m][k] = *(const PG8_LAS bf16x8*)(lds + PG8_SA(b, h) + aoff + m * 2048 + k * 1024); } while (0)
#define PG8_LDB(dst, b, h) do { _Pragma("unroll") for (int n = 0; n < 2; ++n) _Pragma("unroll") for (int k = 0; k < 2; ++k) dst[n][k] = *(const PG8_LAS bf16x8*)(lds + PG8_SB(b, h) + boff + n * 2048 + k * 1024); } while (0)
#define PG8_MMA(ai, bj, At, Bt) do { __builtin_amdgcn_s_setprio(1); _Pragma("unroll") for (int m = 0; m < 4; ++m) _Pragma("unroll") for (int n = 0; n < 2; ++n) _Pragma("unroll") for (int k = 0; k < 2; ++k) \
        acc[ai][bj][m][n] = __builtin_amdgcn_mfma_f32_16x16x32_bf16(Bt[n][k], At[m][k], acc[ai][bj][m][n], 0, 0, 0); __builtin_amdgcn_s_setprio(0); } while (0)
#define PG8_WAIT_V(n) asm volatile("s_waitcnt vmcnt(" #n ")" ::: "memory")
#define PG8_WAIT_L(n) asm volatile("s_waitcnt lgkmcnt(" #n ")" ::: "memory")
#define PG8_BAR __builtin_amdgcn_s_barrier()
#define PG8_SCHED __builtin_amdgcn_sched_barrier(0)
    Unit cur, nxt; int ui = 0;
    if (!S.next(0, cur)) return;
    f32x4 acc[2][2][4][2];
#pragma unroll
    for (int a = 0; a < 2; ++a)
#pragma unroll
        for (int b = 0; b < 2; ++b)
#pragma unroll
            for (int m = 0; m < 4; ++m)
#pragma unroll
                for (int n = 0; n < 2; ++n) acc[a][b][m][n] = (f32x4){0.f, 0.f, 0.f, 0.f};
    bf16x8 At[4][2], B0[2][2], B1[2][2];
    const char* cA = (const char*)g.A + (size_t)cur.pm * tstep; const char* cB = (const char*)g.Bt + (size_t)cur.pn * tstep;
    S.a_ready(cur);
    PG8_STAGE(PG8_SB(0, 0), cB, voffB); PG8_STAGE(PG8_SA(0, 0), cA, voffA); PG8_STAGE(PG8_SB(0, 1), cB + hstep, voffB); PG8_STAGE(PG8_SA(0, 1), cA + hstep, voffA);
    if (wr == 1) PG8_BAR;
    PG8_WAIT_V(4); PG8_BAR;
    PG8_STAGE(PG8_SB(1, 0), cB + kstep, voffB); PG8_STAGE(PG8_SA(1, 0), cA + kstep, voffA); PG8_STAGE(PG8_SB(1, 1), cB + hstep + kstep, voffB);
    PG8_WAIT_V(6); PG8_BAR;
    PG8_STAMP();
    for (;;) {
        const bool has_next = S.next(ui + 1, nxt);
        const char* nA = has_next ? (const char*)g.A + (size_t)nxt.pm * tstep : cA; const char* nB = has_next ? (const char*)g.Bt + (size_t)nxt.pn * tstep : cB;
        for (int t = 0; t < nt; t += 2) {
            const bool last = (t == nt - 2);
            const char* a1 = cA + (size_t)(t + 1) * kstep;
            const char* a2 = last ? nA : cA + (size_t)(t + 2) * kstep; const char* b2 = last ? nB : cB + (size_t)(t + 2) * kstep;
            const char* a3 = a2 + kstep; const char* b3 = b2 + kstep;
            if (last && has_next) S.a_ready(nxt);
            PG8_LDB(B0, 0, 0); PG8_SCHED; PG8_LDA(At, 0, 0); PG8_STAGE(PG8_SA(1, 1), a1 + hstep, voffA);
            PG8_WAIT_L(8); PG8_BAR; PG8_WAIT_L(0); PG8_MMA(0, 0, At, B0); PG8_BAR; PG8_SCHED;
            PG8_LDB(B1, 0, 1); PG8_STAGE(PG8_SB(0, 0), b2, voffB);
            PG8_BAR; PG8_WAIT_L(0); PG8_MMA(0, 1, At, B1); PG8_BAR;
            PG8_LDA(At, 0, 1); PG8_STAGE(PG8_SA(0, 0), a2, voffA);
            PG8_BAR; PG8_WAIT_L(0); PG8_MMA(1, 0, At, B0); PG8_BAR; PG8_SCHED;
            PG8_STAGE(PG8_SB(0, 1), b2 + hstep, voffB);
            PG8_WAIT_V(6); PG8_BAR; PG8_MMA(1, 1, At, B1); PG8_BAR;
            PG8_LDB(B0, 1, 0); PG8_SCHED; PG8_LDA(At, 1, 0); PG8_STAGE(PG8_SA(0, 1), a2 + hstep, voffA);
            PG8_WAIT_L(8); PG8_BAR; PG8_WAIT_L(0); PG8_MMA(0, 0, At, B0); PG8_BAR; PG8_SCHED;
            PG8_LDB(B1, 1, 1); PG8_STAGE(PG8_SB(1, 0), b3, voffB);
            PG8_BAR; PG8_WAIT_L(0); PG8_MMA(0, 1, At, B1); PG8_BAR;
            PG8_LDA(At, 1, 1); PG8_STAGE(PG8_SA(1, 0), a3, voffA);
            PG8_BAR; PG8_WAIT_L(0); PG8_MMA(1, 0, At, B0); PG8_BAR; PG8_SCHED;
            PG8_STAGE(PG8_SB(1, 1), b3 + hstep, voffB);
            PG8_WAIT_V(6); PG8_BAR; PG8_MMA(1, 1, At, B1); PG8_BAR;
        }
        PG8_STAMP();
        if constexpr (!Epi::AFTER_DRAIN) { E(acc, cur, wr, wc, fr, fq); S.done(cur); }
        PG8_STAMP();
        if (!has_next) break;
#pragma unroll
        for (int a = 0; a < 2; ++a)
#pragma unroll
            for (int b = 0; b < 2; ++b)
#pragma unroll
                for (int m = 0; m < 4; ++m)
#pragma unroll
                    for (int n = 0; n < 2; ++n) acc[a][b][m][n] = (f32x4){0.f, 0.f, 0.f, 0.f};
        cur = nxt; cA = nA; cB = nB; ++ui;
    }
    PG8_WAIT_V(0);
    if (wr == 0) PG8_BAR;
    PG8_BAR;
    if constexpr (Epi::AFTER_DRAIN) { E.fused(acc, cur, wr, wc, fr, fq, lds, wid, lane); S.done(cur); }
    PG8_STAMP();
    if (STAMP && wid == 0) { stamps[lane] = lane < nts ? (((unsigned long long)(unsigned)ts_hi << 32) | (unsigned)ts_lo) : 0ull;
        if (lane == 62) stamps[62] = rt_entry; if (lane == 63) stamps[63] = (unsigned long long)wall_clock64(); }
#undef PG8_STAMP
#undef PG8_SA
#undef PG8_SB
#undef PG8_STAGE
#undef PG8_LDA
#undef PG8_LDB
#undef PG8_MMA
#undef PG8_WAIT_V
#undef PG8_WAIT_L
#undef PG8_BAR
#undef PG8_SCHED
}
}

#define LAS __attribute__((address_space(3)))
typedef unsigned short u16;
typedef short s16x4 __attribute__((ext_vector_type(4)));
typedef unsigned u32x2 __attribute__((ext_vector_type(2)));
typedef __bf16 bf2_t __attribute__((ext_vector_type(2)));
typedef float f2_t __attribute__((ext_vector_type(2)));
using pg8::bf16x8; using pg8::f32x4; using pg8::u32x4;

constexpr int DM = 2048, SEQ = 16384, RLAT = 32768, LCTX = 256, MROWS = 33280, DFF = 8192;
constexpr int PLD = 5376, NPROJ = 5632, NIN = 5400;
constexpr int OFF_GU = 0, OFF_GV = 512, OFF_AQ = 1024, OFF_AK = 1792, OFF_AV = 2048, OFF_MQ = 2304, OFF_MK = 3072, OFF_MV = 3840, OFF_MO = 4608;
constexpr int NCH = 130;
constexpr int NSEQ = 24;
constexpr float EPSN = 1e-6f;
constexpr float LOG2E = 1.4426950408889634f;
constexpr float QSCALE = 0.08838834764831845f;

constexpr size_t WS_WIN = 0;
constexpr size_t SZ_WIN = (size_t)NPROJ * DM * 2;
constexpr size_t WS_WOUT = WS_WIN + 2 * SZ_WIN;
constexpr size_t SZ_WOUT = (size_t)DM * DM * 2;
constexpr size_t WS_WFF1 = WS_WOUT + 2 * SZ_WOUT;
constexpr size_t SZ_WFF = (size_t)DFF * DM * 2;
constexpr size_t WS_WFF2 = WS_WFF1 + 2 * SZ_WFF;
constexpr size_t WS_MOD = WS_WFF2 + 2 * SZ_WFF;
constexpr size_t WS_ROPE = WS_MOD + 2 * 3 * 12288 * 4;
constexpr size_t WS_XC = WS_ROPE + 320 * 32 * 8;
constexpr size_t WS_GATES = WS_XC + (size_t)512 * DM * 4;
constexpr size_t WS_NST = WS_GATES + (size_t)MROWS * 32 * 4;
constexpr size_t WS_GSC = WS_NST + (size_t)NSEQ * NCH * 128 * 4;
constexpr size_t WS_MLS = WS_GSC + 16384;
constexpr size_t WS_M0 = WS_MLS + 16384;
constexpr size_t WS_XN = WS_M0 + 16384;
constexpr size_t WS_R = WS_XN + (size_t)MROWS * DM * 2;
constexpr size_t SZ_PROJ = (size_t)MROWS * PLD * 2;
constexpr size_t WS_Y = WS_R + SZ_PROJ;
constexpr size_t SZ_H = (size_t)MROWS * DFF * 2;
constexpr size_t WS_CST = WS_R + SZ_H;
constexpr size_t WS_END = WS_CST + (size_t)NSEQ * NCH * 16384 * 2;

constexpr int LDS_BYTES = 163840;
constexpr int TSTR = 272;
constexpr int TILE_B = 128 * TSTR;
constexpr int SC_OFF = 4 * TILE_B;

struct Params {
    const float *x, *c, *ctx, *c_ctx, *w_ada, *b_ada, *g_mix, *g_ffn, *w_in, *gm_v_gain, *gm_w_s, *gm_b_s, *attn_sink,
        *ml_conv_w, *ml_conv_b, *ml_b_i, *ml_b_f, *ml_out_gain, *w_out, *w_ff1, *w_ff2, *g_final;
    float* out; unsigned char* ws;
};

#define DI __device__ __forceinline__
typedef const __attribute__((address_space(4))) Params* KP;
DI int tid_l() { int t = threadIdx.x; asm volatile("" : "+v"(t)); return t; }
DI KP launder(KP p) { asm volatile("" : "+s"(p)); return p; }
DI unsigned pk2(float lo, float hi) { bf2_t v = __builtin_convertvector((f2_t){lo, hi}, bf2_t); return __builtin_bit_cast(unsigned, v); }
DI float bf_lo(unsigned u) { return __uint_as_float(u << 16); }
DI float bf_hi(unsigned u) { return __uint_as_float(u & 0xffff0000u); }
DI float wave_sum(float v) {
#pragma unroll
    for (int o = 1; o < 64; o <<= 1) v += __shfl_xor(v, o);
    return v;
}
DI float wave_max(float v) {
#pragma unroll
    for (int o = 1; o < 64; o <<= 1) v = fmaxf(v, __shfl_xor(v, o));
    return v;
}
DI float gelu_tanh(float x) {
    const float u = 0.7978845608028654f * (x + 0.044715f * x * x * x);
    const float e = __expf(2.f * u);
    const float t = 1.f - 2.f / (e + 1.f);
    return 0.5f * x * (1.f + t);
}
DI float sigmoidf_(float x) { return 1.f / (1.f + __expf(-x)); }
DI float log_sigmoid(float x) { return fminf(x, 0.f) - log1pf(__expf(-fabsf(x))); }
#define MFMA16(a, b, c) __builtin_amdgcn_mfma_f32_16x16x32_bf16((a), (b), (c), 0, 0, 0)

DI bf16x8 frag_row(const LAS unsigned char* tile, int idx0, int k0, int lane) {
    return *(const LAS bf16x8*)(tile + (idx0 + (lane & 15)) * TSTR + (k0 + 8 * (lane >> 4)) * 2);
}
DI bf16x8 tr_pair(const LAS unsigned char* p, int second_off) {
    s16x4 a = __builtin_amdgcn_ds_read_tr16_b64_v4i16((LAS s16x4*)p);
    s16x4 b = __builtin_amdgcn_ds_read_tr16_b64_v4i16((LAS s16x4*)(p + second_off));
    return (bf16x8){a[0], a[1], a[2], a[3], b[0], b[1], b[2], b[3]};
}
DI bf16x8 frag_tr(const LAS unsigned char* tile, int k0, int idx0, int lane) {
    const int i = lane & 15, q = lane >> 4;
    return tr_pair(tile + (k0 + 8 * q + (i >> 2)) * TSTR + (idx0 + 4 * (i & 3)) * 2, 4 * TSTR);
}
DI bf16x8 frag_tr_perm(const LAS unsigned char* tile, int k0, int idx0, int lane) {
    const int i = lane & 15, q = lane >> 4;
    return tr_pair(tile + (k0 + 4 * q + (i >> 2)) * TSTR + (idx0 + 4 * (i & 3)) * 2, 16 * TSTR);
}

DI const float* xrow_in(KP p, int stage, int row) {
    if (row < RLAT) return (stage ? (const float*)p->out : p->x) + (size_t)row * DM;
    return (stage ? (const float*)(p->ws + WS_XC) : p->ctx) + (size_t)(row - RLAT) * DM;
}
DI float* xrow_out(KP p, int row) {
    if (row < RLAT) return p->out + (size_t)row * DM;
    return (float*)(p->ws + WS_XC) + (size_t)(row - RLAT) * DM;
}
DI int mod_index(int row) { return row < SEQ ? 0 : (row < RLAT ? 1 : 2); }

DI void transpose_item(const float* W, int K, int N, u16* WT, LAS float* scr, int item, int nblk, int lane) {
    const int kb = item / nblk, nb = item % nblk, k0 = 64 * kb, n0 = 32 * nb;
    const int n = n0 + (lane & 31);
    const bool ok = n < N;
#pragma unroll 8
    for (int i = 0; i < 32; ++i) { const int kk = 2 * i + (lane >> 5); scr[kk * 33 + (lane & 31)] = ok ? W[(size_t)(k0 + kk) * N + n] : 0.f; }
    asm volatile("s_waitcnt lgkmcnt(0)" ::: "memory"); __builtin_amdgcn_wave_barrier();
    const int c = lane & 7;
#pragma unroll
    for (int j = 0; j < 4; ++j) { const int nn = (lane >> 3) + 8 * j; const LAS float* s = scr + (8 * c) * 33 + nn;
        u32x4 o; o.x = pk2(s[0 * 33], s[1 * 33]); o.y = pk2(s[2 * 33], s[3 * 33]); o.z = pk2(s[4 * 33], s[5 * 33]); o.w = pk2(s[6 * 33], s[7 * 33]);
        *(u32x4*)(WT + (size_t)(n0 + nn) * K + k0 + 8 * c) = o; }
    asm volatile("s_waitcnt lgkmcnt(0)" ::: "memory"); __builtin_amdgcn_wave_barrier();
}

DI void phase_prep(KP p, LAS unsigned char* lds) {
    const int tid = tid_l(), lane = tid & 63, wave = tid >> 6, bid = blockIdx.x, G = gridDim.x;
    {
        LAS float* sv = (LAS float*)lds;
        LAS float* red = (LAS float*)(lds + 3 * 2048 * 4);
        for (int i = tid; i < 3 * 2048; i += 512) { const int v = i >> 11, k = i & 2047; const float x = v == 0 ? p->c[k] : (v == 1 ? p->c[2048 + k] : p->c_ctx[k]); sv[i] = x * sigmoidf_(x); }
        __syncthreads();
        float* MOD = (float*)(p->ws + WS_MOD);
        for (int it = bid; it < 2 * 192; it += G) {
            const int l = it / 192, n0 = (it % 192) * 64, j = tid & 15, kk = tid >> 4;
            const float* w = p->w_ada + (size_t)l * 2048 * 12288 + n0 + 4 * j;
            f32x4 a0 = {0, 0, 0, 0}, a1 = a0, a2 = a0;
#pragma unroll 8
            for (int k = kk; k < 2048; k += 32) { const f32x4 wv = *(const f32x4*)(w + (size_t)k * 12288); a0 += wv * sv[k]; a1 += wv * sv[2048 + k]; a2 += wv * sv[4096 + k]; }
            LAS float* r = red + (kk * 16 + j) * 12;
            *(LAS f32x4*)(r) = a0; *(LAS f32x4*)(r + 4) = a1; *(LAS f32x4*)(r + 8) = a2;
            __syncthreads();
            if (tid < 192) { const int v = tid >> 6, cc = tid & 63, jj = cc >> 2, e = cc & 3; float s = 0.f;
                for (int q = 0; q < 32; ++q) s += red[(q * 16 + jj) * 12 + v * 4 + e];
                MOD[(size_t)(l * 3 + v) * 12288 + n0 + cc] = s + p->b_ada[l * 12288 + n0 + cc]; }
            __syncthreads();
        }
    }
    {
        f2_t* ROPE = (f2_t*)(p->ws + WS_ROPE);
        for (int i = bid * 512 + tid; i < 320 * 32; i += G * 512) { const int pos = i >> 5, f = i & 31; const int pa = pos < 256 ? pos : pos - 256;
            const float freq = 1.0f / powf(10000.0f, (float)(2 * f) / 64.0f); const float ang = (float)pa * freq; ROPE[i] = (f2_t){cosf(ang), sinf(ang)}; }
    }
    {
        LAS float* scr = (LAS float*)(lds + wave * 8448);
        const int gw = bid * 8 + wave, NGW = G * 8;
        constexpr int I_IN = 32 * 176, I_OUT = 32 * 64, I_F1 = 32 * 256, I_F2 = 128 * 64, I_L = I_IN + I_OUT + I_F1 + I_F2;
        for (int it = gw; it < 2 * I_L; it += NGW) {
            const int l = it / I_L; int r = it % I_L;
            if (r < I_IN) { transpose_item(p->w_in + (size_t)l * DM * NIN, DM, NIN, (u16*)(p->ws + WS_WIN + l * SZ_WIN), scr, r, 176, lane); continue; } r -= I_IN;
            if (r < I_OUT) { transpose_item(p->w_out + (size_t)l * DM * DM, DM, DM, (u16*)(p->ws + WS_WOUT + l * SZ_WOUT), scr, r, 64, lane); continue; } r -= I_OUT;
            if (r < I_F1) { transpose_item(p->w_ff1 + (size_t)l * DM * DFF, DM, DFF, (u16*)(p->ws + WS_WFF1 + l * SZ_WFF), scr, r, 256, lane); continue; } r -= I_F1;
            transpose_item(p->w_ff2 + (size_t)l * DFF * DM, DFF, DM, (u16*)(p->ws + WS_WFF2 + l * SZ_WFF), scr, r, 64, lane);
        }
    }
}

DI void phase_norm(KP p, int l, int which, int stage, int M) {
    const int tid = tid_l(), lane = tid & 63, gw = blockIdx.x * 8 + (tid >> 6), NGW = gridDim.x * 8;
    const float* gain = (which ? p->g_ffn : p->g_mix) + l * DM;
    u16* XN = (u16*)(p->ws + WS_XN);
    for (int row = gw; row < M; row += NGW) {
        const float* xr = xrow_in(p, stage, row);
        const float* md = (const float*)(p->ws + WS_MOD) + (size_t)(l * 3 + mod_index(row)) * 12288 + which * 3 * DM;
        f32x4 v[8]; float s = 0.f;
#pragma unroll
        for (int j = 0; j < 8; ++j) { v[j] = *(const f32x4*)(xr + 4 * lane + 256 * j); s += (v[j].x * v[j].x + v[j].y * v[j].y) + (v[j].z * v[j].z + v[j].w * v[j].w); }
        const float rstd = rsqrtf(wave_sum(s) * (1.f / DM) + EPSN);
#pragma unroll
        for (int j = 0; j < 8; ++j) { const int c = 4 * lane + 256 * j;
            const f32x4 g = *(const f32x4*)(gain + c), sh = *(const f32x4*)(md + c), sc = *(const f32x4*)(md + DM + c);
            const f32x4 y = (v[j] * rstd * g) * (sc + 1.f) + sh;
            u32x2 o; o.x = pk2(y.x, y.y); o.y = pk2(y.z, y.w);
            *(u32x2*)(XN + (size_t)row * DM + c) = o; }
    }
}
DI void phase_final(KP p) {
    const int tid = tid_l(), lane = tid & 63, gw = blockIdx.x * 8 + (tid >> 6), NGW = gridDim.x * 8;
    for (int row = gw; row < RLAT; row += NGW) {
        float* xr = p->out + (size_t)row * DM;
        f32x4 v[8]; float s = 0.f;
#pragma unroll
        for (int j = 0; j < 8; ++j) { v[j] = *(const f32x4*)(xr + 4 * lane + 256 * j); s += (v[j].x * v[j].x + v[j].y * v[j].y) + (v[j].z * v[j].z + v[j].w * v[j].w); }
        const float rstd = rsqrtf(wave_sum(s) * (1.f / DM) + EPSN);
#pragma unroll
        for (int j = 0; j < 8; ++j) { const int c = 4 * lane + 256 * j; const f32x4 g = *(const f32x4*)(p->g_final + c); *(f32x4*)(xr + c) = v[j] * rstd * g; }
    }
}

struct EpiProj {
    static constexpr bool PERM = true, AFTER_DRAIN = false;
    u16* O; float* gates;
    __device__ __forceinline__ void operator()(const f32x4 (&acc)[2][2][4][2], const pg8::Unit& u, int wr, int wc, int fr, int fq) const {
        const int row0 = u.pm * 256 + wr * 64 + fr;
        if (u.pn < 21) {
            const int col0 = u.pn * 256 + wc * 32 + 8 * fq;
#pragma unroll
            for (int ai = 0; ai < 2; ++ai)
#pragma unroll
                for (int m = 0; m < 4; ++m) { u16* rowp = O + (size_t)(row0 + ai * 128 + m * 16) * PLD + col0;
#pragma unroll
                    for (int bj = 0; bj < 2; ++bj) { const f32x4 v0 = acc[ai][bj][m][0], v1 = acc[ai][bj][m][1];
                        u32x4 o; o.x = pk2(v0[0], v0[1]); o.y = pk2(v0[2], v0[3]); o.z = pk2(v1[0], v1[1]); o.w = pk2(v1[2], v1[3]);
                        *(u32x4*)(rowp + bj * 128) = o; } }
        } else if (wc == 0 && fq < 3) {
#pragma unroll
            for (int ai = 0; ai < 2; ++ai)
#pragma unroll
                for (int m = 0; m < 4; ++m) { float* gp = gates + (size_t)(row0 + ai * 128 + m * 16) * 32 + 8 * fq;
                    *(f32x4*)gp = acc[ai][0][m][0]; *(f32x4*)(gp + 4) = acc[ai][0][m][1]; }
        }
    }
};
struct EpiRes {
    static constexpr bool PERM = false, AFTER_DRAIN = false;
    KP p; int stage; const float* gate0;
    __device__ __forceinline__ void operator()(const f32x4 (&acc)[2][2][4][2], const pg8::Unit& u, int wr, int wc, int fr, int fq) const {
        const int row0 = u.pm * 256 + wr * 64 + fr, col0 = u.pn * 256 + wc * 32 + 4 * fq;
        const float* gate = gate0 + (size_t)mod_index(u.pm * 256) * 12288;
        f32x4 gv[2][2];
#pragma unroll
        for (int bj = 0; bj < 2; ++bj)
#pragma unroll
            for (int n = 0; n < 2; ++n) gv[bj][n] = *(const f32x4*)(gate + col0 + bj * 128 + n * 16);
#pragma unroll
        for (int ai = 0; ai < 2; ++ai)
#pragma unroll
            for (int m = 0; m < 4; ++m) { const int row = row0 + ai * 128 + m * 16; const float* xi = xrow_in(p, stage, row) + col0; float* xo = xrow_out(p, row) + col0;
#pragma unroll
                for (int bj = 0; bj < 2; ++bj)
#pragma unroll
                    for (int n = 0; n < 2; ++n) { const f32x4 v = *(const f32x4*)(xi + bj * 128 + n * 16); *(f32x4*)(xo + bj * 128 + n * 16) = v + gv[bj][n] * acc[ai][bj][m][n]; } }
    }
};
struct EpiSqRelu {
    static constexpr bool PERM = true, AFTER_DRAIN = false;
    u16* O;
    __device__ __forceinline__ void operator()(const f32x4 (&acc)[2][2][4][2], const pg8::Unit& u, int wr, int wc, int fr, int fq) const {
        const int row0 = u.pm * 256 + wr * 64 + fr, col0 = u.pn * 256 + wc * 32 + 8 * fq;
#pragma unroll
        for (int ai = 0; ai < 2; ++ai)
#pragma unroll
            for (int m = 0; m < 4; ++m) { u16* rowp = O + (size_t)(row0 + ai * 128 + m * 16) * DFF + col0;
#pragma unroll
                for (int bj = 0; bj < 2; ++bj) { f32x4 v0 = acc[ai][bj][m][0], v1 = acc[ai][bj][m][1];
#pragma unroll
                    for (int e = 0; e < 4; ++e) { const float a = fmaxf(v0[e], 0.f), b = fmaxf(v1[e], 0.f); v0[e] = a * a; v1[e] = b * b; }
                    u32x4 o; o.x = pk2(v0[0], v0[1]); o.y = pk2(v0[2], v0[3]); o.z = pk2(v1[0], v1[1]); o.w = pk2(v1[2], v1[3]);
                    *(u32x4*)(rowp + bj * 128) = o; } }
    }
};
template <class Epi> DI void run_gemm(LAS unsigned char* lds, const u16* A, const u16* Bt, int M, int N, int K, const Epi& E) {
    pg8::Gemm g; g.A = A; g.Bt = Bt; g.M = M; g.N = N; g.K = K;
    pg8::StaticOrder S; S.init(M, N, (int)gridDim.x, (int)blockIdx.x);
    pg8::gemm_phase<Epi, pg8::StaticOrder, false>(lds, g, S, E, nullptr);
}

DI void unpack8(const u32x4 v, float* f) { f[0] = bf_lo(v.x); f[1] = bf_hi(v.x); f[2] = bf_lo(v.y); f[3] = bf_hi(v.y); f[4] = bf_lo(v.z); f[5] = bf_hi(v.z); f[6] = bf_lo(v.w); f[7] = bf_hi(v.w); }
DI u32x4 pack8(const float* f) { u32x4 o; o.x = pk2(f[0], f[1]); o.y = pk2(f[2], f[3]); o.z = pk2(f[4], f[5]); o.w = pk2(f[6], f[7]); return o; }

DI void stage_plain(LAS unsigned char* T, const u16* src, int ld, int tid) {
#pragma unroll
    for (int i = 0; i < 4; ++i) { const int id = tid + 512 * i, row = id >> 4, ch = id & 15;
        *(LAS u32x4*)(T + row * TSTR + ch * 16) = *(const u32x4*)(src + (size_t)row * ld + ch * 8); }
}
DI void stage_rope(LAS unsigned char* T, const u16* src, int ld, int pos0, float scale, const f2_t* ROPE, int tid) {
#pragma unroll
    for (int i = 0; i < 2; ++i) { const int task = tid + 512 * i, row = task >> 3, pp = task & 7, cq = pp & 3, half = pp >> 2, chA = half * 8 + cq;
        const int pos = pos0 + row, pa = half ? 256 + (pos & 63) : (pos >> 6);
        const u32x4 ra = *(const u32x4*)(src + (size_t)row * ld + chA * 8), rb = *(const u32x4*)(src + (size_t)row * ld + (chA + 4) * 8);
        float x1[8], x2[8], o1[8], o2[8]; unpack8(ra, x1); unpack8(rb, x2);
        const f2_t* tb = ROPE + pa * 32 + cq * 8;
#pragma unroll
        for (int e = 0; e < 8; ++e) { const f2_t cs = tb[e]; o1[e] = (x1[e] * cs.x - x2[e] * cs.y) * scale; o2[e] = (x1[e] * cs.y + x2[e] * cs.x) * scale; }
        *(LAS u32x4*)(T + row * TSTR + chA * 16) = pack8(o1); *(LAS u32x4*)(T + row * TSTR + (chA + 4) * 16) = pack8(o2); }
}
DI void stage_conv(LAS unsigned char* T, const u16* src, int ld, int lo, int hi, const float* cw  , const float* cb, float scale, int tid) {
#pragma unroll
    for (int i = 0; i < 4; ++i) { const int id = tid + 512 * i, row = id >> 4, ch = id & 15;
        float xm[8], x0[8], xp[8], y[8];
        const u32x4 z = {0u, 0u, 0u, 0u};
        const u32x4 r0 = *(const u32x4*)(src + (size_t)row * ld + ch * 8);
        const u32x4 rm = (row - 1 >= lo) ? *(const u32x4*)(src + (ptrdiff_t)(row - 1) * ld + ch * 8) : z;
        const u32x4 rp = (row + 1 < hi) ? *(const u32x4*)(src + (size_t)(row + 1) * ld + ch * 8) : z;
        unpack8(rm, xm); unpack8(r0, x0); unpack8(rp, xp);
#pragma unroll
        for (int e = 0; e < 8; ++e) { const int c = ch * 8 + e; const float v = cb[c] + xm[e] * cw[c] + x0[e] * cw[1536 + c] + xp[e] * cw[3072 + c]; y[e] = v * sigmoidf_(v) * scale; }
        *(LAS u32x4*)(T + row * TSTR + ch * 16) = pack8(y); }
}

DI void gmlp_item(KP p, int l, int it, LAS unsigned char* lds) {
    const int tid = tid_l(), lane = tid & 63, wid = tid >> 6, fr = lane & 15, fq = lane >> 4;
    const int n = it >> 2, g = it & 3, r0 = n * 128;
    const u16* proj = (const u16*)(p->ws + WS_R);
    u16* Y = (u16*)(p->ws + WS_Y);
    LAS unsigned char* T0 = lds; LAS unsigned char* T1 = lds + TILE_B;
    { const float* ws = p->gm_w_s + (size_t)(l * 4 + g) * 16384;
#pragma unroll
      for (int i = 0; i < 8; ++i) { const int f = tid + 512 * i, row = f >> 5, c4 = f & 31; const f32x4 v = *(const f32x4*)(ws + (size_t)f * 4);
          u32x2 o; o.x = pk2(v.x, v.y); o.y = pk2(v.z, v.w); *(LAS u32x2*)(T0 + row * TSTR + c4 * 8) = o; } }
    { const float* vg = p->gm_v_gain + l * 512 + g * 128;
#pragma unroll
      for (int i = 0; i < 4; ++i) { const int id = tid + 512 * i, row = id >> 4, ch = id & 15;
          float v[8]; unpack8(*(const u32x4*)(proj + (size_t)(r0 + row) * PLD + OFF_GV + g * 128 + ch * 8), v);
          float ss = 0.f;
#pragma unroll
          for (int e = 0; e < 8; ++e) { v[e] = gelu_tanh(v[e]); ss += v[e] * v[e]; }
          ss += __shfl_xor(ss, 1); ss += __shfl_xor(ss, 2); ss += __shfl_xor(ss, 4); ss += __shfl_xor(ss, 8);
          const float rstd = rsqrtf(ss * (1.f / 128.f) + EPSN);
#pragma unroll
          for (int e = 0; e < 8; ++e) v[e] = v[e] * rstd * vg[ch * 8 + e];
          *(LAS u32x4*)(T1 + row * TSTR + ch * 16) = pack8(v); } }
    __syncthreads();
    const int cb = 32 * (wid >> 1), pb = 64 * (wid & 1);
    f32x4 acc[2][4];
#pragma unroll
    for (int a = 0; a < 2; ++a)
#pragma unroll
        for (int b = 0; b < 4; ++b) acc[a][b] = (f32x4){0.f, 0.f, 0.f, 0.f};
#pragma unroll
    for (int ks = 0; ks < 4; ++ks) {
        bf16x8 af[2], bfg[4];
#pragma unroll
        for (int a = 0; a < 2; ++a) af[a] = frag_tr(T1, 32 * ks, cb + 16 * a, lane);
#pragma unroll
        for (int b = 0; b < 4; ++b) bfg[b] = frag_row(T0, pb + 16 * b, 32 * ks, lane);
#pragma unroll
        for (int a = 0; a < 2; ++a)
#pragma unroll
            for (int b = 0; b < 4; ++b) acc[a][b] = MFMA16(af[a], bfg[b], acc[a][b]);
    }
    const float* bs = p->gm_b_s + (l * 4 + g) * 128;
#pragma unroll
    for (int a = 0; a < 2; ++a)
#pragma unroll
        for (int b = 0; b < 4; ++b) { const int pp = pb + 16 * b + fr, c0 = cb + 16 * a + 4 * fq; const float bias = bs[pp];
            const u32x2 uu = *(const u32x2*)(proj + (size_t)(r0 + pp) * PLD + OFF_GU + g * 128 + c0);
            const float u0 = gelu_tanh(bf_lo(uu.x)), u1 = gelu_tanh(bf_hi(uu.x)), u2 = gelu_tanh(bf_lo(uu.y)), u3 = gelu_tanh(bf_hi(uu.y));
            u32x2 o; o.x = pk2(u0 * (acc[a][b][0] + bias), u1 * (acc[a][b][1] + bias)); o.y = pk2(u2 * (acc[a][b][2] + bias), u3 * (acc[a][b][3] + bias));
            *(u32x2*)(Y + (size_t)(r0 + pp) * DM + g * 128 + c0) = o; }
    __syncthreads();
}

DI void attn_item(KP p, int l, int it, LAS unsigned char* lds) {
    const int tid = tid_l(), lane = tid & 63, wid = tid >> 6, fr = lane & 15, fq = lane >> 4;
    const u16* proj = (const u16*)(p->ws + WS_R);
    u16* Y = (u16*)(p->ws + WS_Y);
    const f2_t* ROPE = (const f2_t*)(p->ws + WS_ROPE);
    LAS unsigned char* T0 = lds; LAS unsigned char* T1 = lds + TILE_B; LAS unsigned char* T2 = lds + 2 * TILE_B;
    int b, nb, hq, qrow0; bool isctx;
    if (it < 1536) { hq = it % 6; nb = (it / 6) & 127; b = it / 768; qrow0 = b * SEQ + nb * 128; isctx = false; }
    else { const int r = it - 1536; hq = r % 6; const int cbk = (r / 6) & 1; b = r / 12; nb = 0; qrow0 = RLAT + b * LCTX + cbk * 128; isctx = true; }
    const int kvh = hq / 3;
    const float qs = QSCALE * LOG2E;
    if (isctx) {
#pragma unroll
        for (int i = 0; i < 4; ++i) { const int id = tid + 512 * i, row = id >> 4, ch = id & 15; float v[8];
            unpack8(*(const u32x4*)(proj + (size_t)(qrow0 + row) * PLD + OFF_AQ + hq * 128 + ch * 8), v);
#pragma unroll
            for (int e = 0; e < 8; ++e) v[e] *= qs;
            *(LAS u32x4*)(T0 + row * TSTR + ch * 16) = pack8(v); }
    } else stage_rope(T0, proj + (size_t)qrow0 * PLD + OFF_AQ + hq * 128, PLD, nb * 128, qs, ROPE, tid);
    __syncthreads();
    bf16x8 Qf[4];
#pragma unroll
    for (int ks = 0; ks < 4; ++ks) Qf[ks] = frag_row(T0, 16 * wid, 32 * ks, lane);
    float m = p->attn_sink[l * 6 + hq] * LOG2E, lsum = 1.f;
    f32x4 O[8];
#pragma unroll
    for (int i = 0; i < 8; ++i) O[i] = (f32x4){0.f, 0.f, 0.f, 0.f};
    const int rin = 16 * wid + fr;
    for (int kt = 0; kt < 5; ++kt) {
        int krow0, jloc = 0; bool local = false;
        if (kt < 2) krow0 = RLAT + b * LCTX + kt * 128;
        else { if (isctx) break; jloc = kt - 3; const int kb = nb + jloc; if (kb < 0 || kb > 127) continue; krow0 = b * SEQ + kb * 128; local = true; }
        __syncthreads();
        if (local) stage_rope(T1, proj + (size_t)krow0 * PLD + OFF_AK + kvh * 128, PLD, (nb + jloc) * 128, 1.f, ROPE, tid);
        else stage_plain(T1, proj + (size_t)krow0 * PLD + OFF_AK + kvh * 128, PLD, tid);
        stage_plain(T2, proj + (size_t)krow0 * PLD + OFF_AV + kvh * 128, PLD, tid);
        __syncthreads();
        f32x4 S[8];
        const int dlo = (local && jloc < 0) ? 0 : -1000, dhi = (local && jloc > 0) ? 0 : 1000;
        float mx = -INFINITY;
#pragma unroll
        for (int n = 0; n < 8; ++n) { S[n] = (f32x4){0.f, 0.f, 0.f, 0.f};
#pragma unroll
            for (int ks = 0; ks < 4; ++ks) S[n] = MFMA16(frag_row(T1, 16 * n, 32 * ks, lane), Qf[ks], S[n]);
#pragma unroll
            for (int j = 0; j < 4; ++j) { const int dk = 16 * n + 4 * fq + j - rin;
                const float s = (dk < dlo || dk > dhi) ? -INFINITY : S[n][j]; S[n][j] = s; mx = fmaxf(mx, s); }
            __builtin_amdgcn_sched_barrier(0); }
        mx = fmaxf(mx, __shfl_xor(mx, 16)); mx = fmaxf(mx, __shfl_xor(mx, 32));
        const float mnew = fmaxf(m, mx), alpha = exp2f(m - mnew);
        float rs = 0.f;
#pragma unroll
        for (int n = 0; n < 8; ++n)
#pragma unroll
            for (int j = 0; j < 4; ++j) { const float e = exp2f(S[n][j] - mnew); S[n][j] = e; rs += e; }
        rs += __shfl_xor(rs, 16); rs += __shfl_xor(rs, 32);
        lsum = lsum * alpha + rs; m = mnew;
#pragma unroll
        for (int i = 0; i < 8; ++i) O[i] *= alpha;
        bf16x8 Pf[4];
#pragma unroll
        for (int nn = 0; nn < 4; ++nn) { u32x4 o; o.x = pk2(S[2 * nn][0], S[2 * nn][1]); o.y = pk2(S[2 * nn][2], S[2 * nn][3]); o.z = pk2(S[2 * nn + 1][0], S[2 * nn + 1][1]); o.w = pk2(S[2 * nn + 1][2], S[2 * nn + 1][3]); Pf[nn] = __builtin_bit_cast(bf16x8, o); }
#pragma unroll
        for (int nd = 0; nd < 8; ++nd)
#pragma unroll
            for (int nn = 0; nn < 4; ++nn) O[nd] = MFMA16(frag_tr_perm(T2, 32 * nn, 16 * nd, lane), Pf[nn], O[nd]);
    }
    const float inv = 1.f / lsum;
    u16* yr = Y + (size_t)(qrow0 + rin) * DM + 512 + hq * 128 + 4 * fq;
#pragma unroll
    for (int nd = 0; nd < 8; ++nd) { u32x2 o; o.x = pk2(O[nd][0] * inv, O[nd][1] * inv); o.y = pk2(O[nd][2] * inv, O[nd][3] * inv); *(u32x2*)(yr + 16 * nd) = o; }
    __syncthreads();
}

DI void ml_item_geom(int it, int& b, int& c, int& h, int& base, int& lo, int& hi) {
    h = it % 6; c = (it / 6) % NCH; b = it / (6 * NCH);
    if (c < 2) { base = RLAT + b * LCTX + c * 128; lo = -c * 128; hi = LCTX - c * 128; }
    else { base = b * SEQ + (c - 2) * 128; lo = -(c - 2) * 128; hi = SEQ - (c - 2) * 128; }
}
DI int ml_pos(int c, int d) { return d == 0 ? c : (c < 2 ? 1 - c : 131 - c); }
DI void ml_gate_scan(const float* gates, int base, int d, int h, float bi, float bff, int lane, int& t0, int& t1, float& li0, float& li1, float& b0, float& b1) {
    t0 = d ? 127 - 2 * lane : 2 * lane; t1 = d ? t0 - 1 : t0 + 1;
    const float* g0 = gates + (size_t)(base + t0) * 32 + d * 12 + h; const float* g1 = gates + (size_t)(base + t1) * 32 + d * 12 + h;
    li0 = g0[0] + bi; li1 = g1[0] + bi;
    const float lf0 = log_sigmoid(g0[6] + bff), lf1 = log_sigmoid(g1[6] + bff);
    float s = lf0 + lf1;
#pragma unroll
    for (int o = 1; o < 64; o <<= 1) { const float v = __shfl_up(s, o); if (lane >= o) s += v; }
    b1 = s; b0 = s - lf1;
}

DI void ml1_item(KP p, int l, int it, LAS unsigned char* lds) {
    const int tid = tid_l(), lane = tid & 63, wid = tid >> 6, fr = lane & 15, fq = lane >> 4;
    int b, c, h, base, lo, hi; ml_item_geom(it, b, c, h, base, lo, hi);
    const u16* proj = (const u16*)(p->ws + WS_R);
    const float* gates = (const float*)(p->ws + WS_GATES);
    LAS unsigned char* T0 = lds; LAS unsigned char* T1 = lds + TILE_B; LAS unsigned char* T2 = lds + 2 * TILE_B;
    LAS float* wsc = (LAS float*)(lds + SC_OFF);
    if (wid < 2) { const int d = wid; int t0, t1; float li0, li1, b0, b1;
        ml_gate_scan(gates, base, d, h, p->ml_b_i[l * 12 + d * 6 + h], p->ml_b_f[l * 12 + d * 6 + h], lane, t0, t1, li0, li1, b0, b1);
        const float g = __shfl(b1, 63);
        const float a0 = g - b0 + li0, a1 = g - b1 + li1;
        const float ml = wave_max(fmaxf(a0, a1));
        wsc[d * 128 + t0] = __expf(a0 - ml); wsc[d * 128 + t1] = __expf(a1 - ml);
        if (lane == 0) { const int sq = ((b * 6 + h) * 2 + d) * NCH + ml_pos(c, d); ((float*)(p->ws + WS_GSC))[sq] = g; ((float*)(p->ws + WS_MLS))[sq] = ml; } }
    stage_conv(T0, proj + (size_t)base * PLD + OFF_MK + h * 128, PLD, lo, hi, p->ml_conv_w + (size_t)l * 4608 + 768 + h * 128, p->ml_conv_b + l * 1536 + 768 + h * 128, QSCALE, tid);
    __syncthreads();
#pragma unroll
    for (int i = 0; i < 4; ++i) { const int id = tid + 512 * i, row = id >> 4, ch = id & 15; float v[8], y[8];
        unpack8(*(const u32x4*)(proj + (size_t)(base + row) * PLD + OFF_MV + h * 128 + ch * 8), v);
        const float w0 = wsc[row], w1 = wsc[128 + row];
#pragma unroll
        for (int e = 0; e < 8; ++e) y[e] = v[e] * w0;
        *(LAS u32x4*)(T1 + row * TSTR + ch * 16) = pack8(y);
#pragma unroll
        for (int e = 0; e < 8; ++e) y[e] = v[e] * w1;
        *(LAS u32x4*)(T2 + row * TSTR + ch * 16) = pack8(y); }
    __syncthreads();
    const int kb = 32 * (wid >> 1), vb = 64 * (wid & 1);
    u16* CST = (u16*)(p->ws + WS_CST);
#pragma unroll
    for (int d = 0; d < 2; ++d) {
        const LAS unsigned char* TV = d ? T2 : T1;
        f32x4 acc[2][4];
#pragma unroll
        for (int a = 0; a < 2; ++a)
#pragma unroll
            for (int bb = 0; bb < 4; ++bb) acc[a][bb] = (f32x4){0.f, 0.f, 0.f, 0.f};
#pragma unroll
        for (int ks = 0; ks < 4; ++ks) {
            bf16x8 af[2], bfg[4];
#pragma unroll
            for (int a = 0; a < 2; ++a) af[a] = frag_tr(T0, 32 * ks, kb + 16 * a, lane);
#pragma unroll
            for (int bb = 0; bb < 4; ++bb) bfg[bb] = frag_tr(TV, 32 * ks, vb + 16 * bb, lane);
#pragma unroll
            for (int a = 0; a < 2; ++a)
#pragma unroll
                for (int bb = 0; bb < 4; ++bb) acc[a][bb] = MFMA16(af[a], bfg[bb], acc[a][bb]);
        }
        u16* Cd = CST + ((size_t)(((b * 6 + h) * 2 + d) * NCH + ml_pos(c, d))) * 16384;
#pragma unroll
        for (int a = 0; a < 2; ++a)
#pragma unroll
            for (int bb = 0; bb < 4; ++bb) { const int v = vb + 16 * bb + fr, k0 = kb + 16 * a + 4 * fq;
                u32x2 o; o.x = pk2(acc[a][bb][0], acc[a][bb][1]); o.y = pk2(acc[a][bb][2], acc[a][bb][3]); *(u32x2*)(Cd + v * 128 + k0) = o; }
    }
    if (tid < 256) { const int d = tid >> 7, k = tid & 127; float s = 0.f;
        for (int t = 0; t < 128; ++t) s += wsc[d * 128 + t] * bf_lo((unsigned)*(const LAS u16*)(T0 + t * TSTR + k * 2));
        ((float*)(p->ws + WS_NST))[((size_t)(((b * 6 + h) * 2 + d) * NCH + ml_pos(c, d))) * 128 + k] = s; }
    __syncthreads();
}

DI void phase_scan(KP p) {
    const float* GSC = (const float*)(p->ws + WS_GSC); const float* MLS = (const float*)(p->ws + WS_MLS);
    for (int gt = blockIdx.x * 512 + tid_l(); gt < NSEQ * 4096 + NSEQ * 128; gt += gridDim.x * 512)
    if (gt < NSEQ * 4096) {
        const int sq = gt >> 12, e4 = gt & 4095;
        u16* base = (u16*)(p->ws + WS_CST) + (size_t)sq * NCH * 16384 + e4 * 4;
        float c0 = 0.f, c1 = 0.f, c2 = 0.f, c3 = 0.f, m = 0.f;
        for (int j0 = 0; j0 < NCH; j0 += 10) {
            u32x2 v[10]; float gj[10], mj[10];
#pragma unroll
            for (int u = 0; u < 10; ++u) { v[u] = *(const u32x2*)(base + (size_t)(j0 + u) * 16384); gj[u] = GSC[sq * NCH + j0 + u]; mj[u] = MLS[sq * NCH + j0 + u]; }
#pragma unroll
            for (int u = 0; u < 10; ++u) {
                u32x2 o; o.x = pk2(c0, c1); o.y = pk2(c2, c3); *(u32x2*)(base + (size_t)(j0 + u) * 16384) = o;
                const float mn = fmaxf(gj[u] + m, mj[u]), ao = __expf(gj[u] + m - mn), an = __expf(mj[u] - mn);
                c0 = ao * c0 + an * bf_lo(v[u].x); c1 = ao * c1 + an * bf_hi(v[u].x); c2 = ao * c2 + an * bf_lo(v[u].y); c3 = ao * c3 + an * bf_hi(v[u].y); m = mn; }
        }
    } else {
        const int r = gt - NSEQ * 4096, sq = r >> 7, k = r & 127;
        float* nb = (float*)(p->ws + WS_NST) + (size_t)sq * NCH * 128 + k; float* M0 = (float*)(p->ws + WS_M0);
        float n = 0.f, m = 0.f;
        for (int j = 0; j < NCH; ++j) { const float dn = nb[(size_t)j * 128], gj = GSC[sq * NCH + j], mj = MLS[sq * NCH + j];
            nb[(size_t)j * 128] = n; if (k == 0) M0[sq * NCH + j] = m;
            const float mn = fmaxf(gj + m, mj), ao = __expf(gj + m - mn), an = __expf(mj - mn); n = ao * n + an * dn; m = mn; }
    }
}

DI void ml3_item(KP p, int l, int it, LAS unsigned char* lds) {
    const int tid = tid_l(), lane = tid & 63, wid = tid >> 6, fr = lane & 15, fq = lane >> 4;
    int b, c, h, base, lo, hi; ml_item_geom(it, b, c, h, base, lo, hi);
    const u16* proj = (const u16*)(p->ws + WS_R);
    const float* gates = (const float*)(p->ws + WS_GATES);
    u16* Y = (u16*)(p->ws + WS_Y);
    LAS unsigned char* T0 = lds; LAS unsigned char* T1 = lds + TILE_B; LAS unsigned char* T2 = lds + 2 * TILE_B; LAS unsigned char* T3 = lds + 3 * TILE_B;
    LAS float* sc_rt = (LAS float*)(lds + SC_OFF);
    LAS float* sc_ct = sc_rt + 256;
    LAS float* sc_in = sc_rt + 512;
    LAS float* sc_em = sc_rt + 768;
    LAS float* sc_n0 = sc_rt + 1024;
    if (wid < 2) { const int d = wid; int t0, t1; float li0, li1, b0, b1;
        ml_gate_scan(gates, base, d, h, p->ml_b_i[l * 12 + d * 6 + h], p->ml_b_f[l * 12 + d * 6 + h], lane, t0, t1, li0, li1, b0, b1);
        const int sq = ((b * 6 + h) * 2 + d) * NCH + ml_pos(c, d);
        const float m0 = ((const float*)(p->ws + WS_M0))[sq];
        const float ct0 = li0 - b0, ct1 = li1 - b1;
        float pm = fmaxf(ct0, ct1);
#pragma unroll
        for (int o = 1; o < 64; o <<= 1) { const float v = __shfl_up(pm, o); if (lane >= o) pm = fmaxf(pm, v); }
        float pe = __shfl_up(pm, 1); if (lane == 0) pe = -INFINITY;
        const float pm0 = fmaxf(pe, ct0), pm1 = pm;
        const float mt0 = fmaxf(b0 + m0, b0 + pm0), mt1 = fmaxf(b1 + m0, b1 + pm1);
        sc_rt[d * 128 + t0] = b0 - mt0; sc_rt[d * 128 + t1] = b1 - mt1;
        sc_ct[d * 128 + t0] = ct0; sc_ct[d * 128 + t1] = ct1;
        sc_in[d * 128 + t0] = __expf(b0 + m0 - mt0); sc_in[d * 128 + t1] = __expf(b1 + m0 - mt1);
        sc_em[d * 128 + t0] = __expf(-mt0); sc_em[d * 128 + t1] = __expf(-mt1);
        const float* n0 = (const float*)(p->ws + WS_NST) + (size_t)sq * 128;
        sc_n0[d * 128 + 2 * lane] = n0[2 * lane]; sc_n0[d * 128 + 2 * lane + 1] = n0[2 * lane + 1]; }
    stage_conv(T0, proj + (size_t)base * PLD + OFF_MQ + h * 128, PLD, lo, hi, p->ml_conv_w + (size_t)l * 4608 + h * 128, p->ml_conv_b + l * 1536 + h * 128, 1.f, tid);
    stage_conv(T1, proj + (size_t)base * PLD + OFF_MK + h * 128, PLD, lo, hi, p->ml_conv_w + (size_t)l * 4608 + 768 + h * 128, p->ml_conv_b + l * 1536 + 768 + h * 128, QSCALE, tid);
    stage_plain(T2, proj + (size_t)base * PLD + OFF_MV + h * 128, PLD, tid);
    __syncthreads();
    const int t = 16 * wid + fr;
    bf16x8 Qf[4];
#pragma unroll
    for (int ks = 0; ks < 4; ++ks) Qf[ks] = frag_row(T0, 16 * wid, 32 * ks, lane);
    float nq[2] = {0.f, 0.f};
#pragma unroll
    for (int ks = 0; ks < 4; ++ks) { const u32x4 qv = __builtin_bit_cast(u32x4, Qf[ks]); float q[8]; unpack8(qv, q);
#pragma unroll
        for (int e = 0; e < 8; ++e) { const int k = 32 * ks + 8 * fq + e; nq[0] += q[e] * sc_n0[k]; nq[1] += q[e] * sc_n0[128 + k]; } }
#pragma unroll
    for (int d = 0; d < 2; ++d) { nq[d] += __shfl_xor(nq[d], 16); nq[d] += __shfl_xor(nq[d], 32); }
    f32x4 hs[8];
#pragma unroll
    for (int i = 0; i < 8; ++i) hs[i] = (f32x4){0.f, 0.f, 0.f, 0.f};
#pragma unroll 1
    for (int d = 0; d < 2; ++d) {
        const int sq = ((b * 6 + h) * 2 + d) * NCH + ml_pos(c, d);
        const float nqd = d ? nq[1] : nq[0];
        if (d) __syncthreads();
        stage_plain(T3, (const u16*)(p->ws + WS_CST) + (size_t)sq * 16384, 128, tid);
        __syncthreads();
        const float rt = sc_rt[d * 128 + t], inter = sc_in[d * 128 + t], em = sc_em[d * 128 + t];
        f32x4 S[8]; float den = 0.f;
#pragma unroll
        for (int n = 0; n < 8; ++n) { S[n] = (f32x4){0.f, 0.f, 0.f, 0.f};
            const bool need = d ? (n >= wid) : (n <= wid);
            if (need) {
#pragma unroll
                for (int ks = 0; ks < 4; ++ks) S[n] = MFMA16(frag_row(T1, 16 * n, 32 * ks, lane), Qf[ks], S[n]);
#pragma unroll
                for (int j = 0; j < 4; ++j) { const int s = 16 * n + 4 * fq + j; const bool valid = d ? (s >= t) : (s <= t);
                    const float w = valid ? __expf(rt + sc_ct[d * 128 + s]) : 0.f; const float pv = S[n][j] * w; S[n][j] = pv; den += pv; }
            }
            __builtin_amdgcn_sched_barrier(0); }
        den += __shfl_xor(den, 16); den += __shfl_xor(den, 32);
        den += inter * nqd;
        bf16x8 Pf[4];
#pragma unroll
        for (int nn = 0; nn < 4; ++nn) { u32x4 o; o.x = pk2(S[2 * nn][0], S[2 * nn][1]); o.y = pk2(S[2 * nn][2], S[2 * nn][3]); o.z = pk2(S[2 * nn + 1][0], S[2 * nn + 1][1]); o.w = pk2(S[2 * nn + 1][2], S[2 * nn + 1][3]); Pf[nn] = __builtin_bit_cast(bf16x8, o); }
        const float inv = 1.f / fmaxf(fabsf(den), em);
#pragma unroll
        for (int nd = 0; nd < 8; ++nd) {
            f32x4 a1 = {0.f, 0.f, 0.f, 0.f}, a2 = {0.f, 0.f, 0.f, 0.f};
#pragma unroll
            for (int nn = 0; nn < 4; ++nn) a1 = MFMA16(frag_tr_perm(T2, 32 * nn, 16 * nd, lane), Pf[nn], a1);
#pragma unroll
            for (int ks = 0; ks < 4; ++ks) a2 = MFMA16(frag_row(T3, 16 * nd, 32 * ks, lane), Qf[ks], a2);
            hs[nd] += (a1 + a2 * inter) * inv;
            __builtin_amdgcn_sched_barrier(0);
        }
    }
    float ss = 0.f;
#pragma unroll
    for (int nd = 0; nd < 8; ++nd) ss += (hs[nd][0] * hs[nd][0] + hs[nd][1] * hs[nd][1]) + (hs[nd][2] * hs[nd][2] + hs[nd][3] * hs[nd][3]);
    ss += __shfl_xor(ss, 16); ss += __shfl_xor(ss, 32);
    const float rstd = rsqrtf(ss * (1.f / 128.f) + EPSN);
    const float* og = p->ml_out_gain + l * 768 + h * 128;
    const u16* mo = proj + (size_t)(base + t) * PLD + OFF_MO + h * 128;
    u16* yr = Y + (size_t)(base + t) * DM + 1280 + h * 128;
#pragma unroll
    for (int nd = 0; nd < 8; ++nd) { const int v0 = 16 * nd + 4 * fq; const u32x2 ov = *(const u32x2*)(mo + v0); const f32x4 gn = *(const f32x4*)(og + v0);
        const float y0 = hs[nd][0] * rstd * gn[0] * sigmoidf_(bf_lo(ov.x)), y1 = hs[nd][1] * rstd * gn[1] * sigmoidf_(bf_hi(ov.x));
        const float y2 = hs[nd][2] * rstd * gn[2] * sigmoidf_(bf_lo(ov.y)), y3 = hs[nd][3] * rstd * gn[3] * sigmoidf_(bf_hi(ov.y));
        u32x2 o; o.x = pk2(y0, y1); o.y = pk2(y2, y3); *(u32x2*)(yr + v0) = o; }
    __syncthreads();
}

constexpr int N_ATT = 1560, N_ML = 2 * NCH * 6  , N_GM = 260 * 4;

__global__ void __launch_bounds__(512, 2) fwd_megakernel(Params p_unused) {
    const KP kp = (KP)__builtin_amdgcn_kernarg_segment_ptr();
#define PP launder(kp)
    extern __shared__ __attribute__((aligned(16))) unsigned char smem[];
    LAS unsigned char* lds = (LAS unsigned char*)smem;
    cg::grid_group grid = cg::this_grid();
    const int bid = blockIdx.x, G = gridDim.x;
    phase_prep(PP, lds);
    grid.sync();
    for (int l = 0; l < 2; ++l) {
        const int stage = l;
        const int Mres = l == 0 ? MROWS : RLAT;
        phase_norm(PP, l, 0, stage, MROWS);
        grid.sync();
        { EpiProj E; E.O = (u16*)(PP->ws + WS_R); E.gates = (float*)(PP->ws + WS_GATES);
          run_gemm(lds, (const u16*)(PP->ws + WS_XN), (const u16*)(PP->ws + WS_WIN + l * SZ_WIN), MROWS, NPROJ, DM, E); }
        grid.sync();
        for (int it = bid; it < N_ATT + N_ML + N_GM; it += G) {
            if (it < N_ATT) attn_item(PP, l, it, lds);
            else if (it < N_ATT + N_ML) ml1_item(PP, l, it - N_ATT, lds);
            else gmlp_item(PP, l, it - N_ATT - N_ML, lds);
        }
        grid.sync();
        phase_scan(PP);
        grid.sync();
        for (int it = bid; it < N_ML; it += G) ml3_item(PP, l, it, lds);
        grid.sync();
        { EpiRes E; E.p = PP; E.stage = stage; E.gate0 = (const float*)(PP->ws + WS_MOD) + (size_t)l * 3 * 12288 + 2 * DM;
          run_gemm(lds, (const u16*)(PP->ws + WS_Y), (const u16*)(PP->ws + WS_WOUT + l * SZ_WOUT), Mres, DM, DM, E); }
        grid.sync();
        phase_norm(PP, l, 1, 1, Mres);
        grid.sync();
        { EpiSqRelu E; E.O = (u16*)(PP->ws + WS_R);
          run_gemm(lds, (const u16*)(PP->ws + WS_XN), (const u16*)(PP->ws + WS_WFF1 + l * SZ_WFF), Mres, DFF, DM, E); }
        grid.sync();
        { EpiRes E; E.p = PP; E.stage = 1; E.gate0 = (const float*)(PP->ws + WS_MOD) + (size_t)l * 3 * 12288 + 5 * DM;
          run_gemm(lds, (const u16*)(PP->ws + WS_R), (const u16*)(PP->ws + WS_WFF2 + l * SZ_WFF), Mres, DM, DFF, E); }
        grid.sync();
    }
    phase_final(PP);
#undef PP
}

extern "C" void kernel_launch(void* const* d_in, const int* in_sizes, int n_in, void* d_out, int out_size, void* d_ws, size_t ws_size, hipStream_t stream) {
    static int grid_blocks = 0;
    if (grid_blocks == 0) {
        if (n_in != 22 || ws_size < WS_END || out_size != RLAT * DM) { fprintf(stderr, "kernel_launch: unexpected shapes (n_in %d ws %zu need %zu out %d)\n", n_in, ws_size, (size_t)WS_END, out_size); grid_blocks = -1; return; }
        int dev = 0, cus = 0, per_cu = 0;
        hipGetDevice(&dev);
        hipDeviceGetAttribute(&cus, hipDeviceAttributeMultiprocessorCount, dev);
        if (hipFuncSetAttribute((const void*)fwd_megakernel, hipFuncAttributeMaxDynamicSharedMemorySize, LDS_BYTES) != hipSuccess) { fprintf(stderr, "kernel_launch: hipFuncSetAttribute failed\n"); grid_blocks = -1; return; }
        hipOccupancyMaxActiveBlocksPerMultiprocessor(&per_cu, (const void*)fwd_megakernel, 512, LDS_BYTES);
        if (per_cu < 1) { fprintf(stderr, "kernel_launch: occupancy query says %d blocks per CU\n", per_cu); per_cu = 1; }
        (void)hipGetLastError();
        grid_blocks = cus * 1;
    }
    if (grid_blocks < 0) return;
    Params p{};
    const float** pp = (const float**)&p;
    for (int i = 0; i < 22; ++i) pp[i] = (const float*)d_in[i];
    p.out = (float*)d_out; p.ws = (unsigned char*)d_ws;
    void* args[] = {&p};
    hipError_t e = hipLaunchCooperativeKernel((const void*)fwd_megakernel, dim3(grid_blocks), dim3(512), args, LDS_BYTES, stream);
    if (e != hipSuccess) fprintf(stderr, "cooperative launch failed: %s (grid %d)\n", hipGetErrorString(e), grid_blocks);
}
```

```cpp
#include <hip/hip_runtime.h>
#include <hip/hip_cooperative_groups.h>
#include <cstdio>
namespace cg = cooperative_groups;
namespace pg8 {
#define PG8_LAS __attribute__((address_space(3)))
typedef unsigned short bf16_t;
typedef short bf16x8 __attribute__((ext_vector_type(8)));
typedef float f32x4 __attribute__((ext_vector_type(4)));
typedef unsigned u32x4 __attribute__((ext_vector_type(4)));
constexpr int BM = 256, BK = 64, HALF = 128, HTB = HALF * BK * 2  , STAGE_BYTES = 8 * HTB, NXCD = 8, WGM = 8;

__host__ __device__ __forceinline__ int lds_byte(int r, int c) { const int st = (r >> 4) * 2 + (c >> 5), rr = r & 15, cc = c & 31, ob = rr * 64 + cc * 2; return st * 1024 + (ob ^ (((ob >> 9) & 1) << 5)); }
__host__ __device__ __forceinline__ void stage_rc(int b, int& R, int& C) { const int st = b / 1024, sb = b % 1024, swz = sb ^ (((sb >> 9) & 1) << 5); R = (st >> 1) * 16 + swz / 64; C = (st & 1) * 32 + (swz % 64) / 2; }
__host__ __device__ __forceinline__ int perm32(int rho) { const int n = rho >> 4, i = rho & 15; return 8 * (i >> 2) + 4 * n + (i & 3); }

struct Unit { int pm, pn, koff, nt; };
struct Gemm { const bf16_t* A; const bf16_t* Bt; int M, N, K; };

struct StaticOrder {
    int nM, nN, nwg, G, c, ntf;
    __host__ __device__ void init(int M, int N, int K, int G_, int c_) { nM = M / BM; nN = N / BM; nwg = nM * nN; G = G_; c = c_; ntf = K / BK; }
    __host__ __device__ bool next(int i, Unit& u) const {
        const long L = (long)i * G + c; if (L >= nwg) return false;
        int wgid = (int)L; { const int q = nwg / NXCD, r = nwg % NXCD, xcd = wgid % NXCD, off = wgid / NXCD; wgid = (xcd < r ? xcd * (q + 1) : r * (q + 1) + (xcd - r) * q) + off; }
        const int nig = WGM * nN, gid = wgid / nig, fm = gid * WGM, gsz = (nM - fm) < WGM ? (nM - fm) : WGM;
        u.pm = fm + ((wgid % nig) % gsz); u.pn = (wgid % nig) / gsz; u.koff = 0; u.nt = ntf; return true;
    }
    __device__ __forceinline__ void a_ready(const Unit&) const {}
    __device__ __forceinline__ void done(const Unit&) const {}
};
template <class Epi, class Sched, bool STAMP = false>
__device__ __forceinline__ void gemm_phase(PG8_LAS unsigned char* lds, const Gemm g, const Sched& S, const Epi& E, unsigned long long* stamps) {
    int tid_ = threadIdx.x; asm volatile("" : "+v"(tid_)); const int tid = tid_, wid = __builtin_amdgcn_readfirstlane(tid >> 6), lane = tid & 63, wr = wid >> 2, wc = wid & 3, fr = lane & 15, fq = lane >> 4;
    const int K = g.K;
    int ts_lo = 0, ts_hi = 0, nts = 0; const unsigned long long rt_entry = STAMP ? (unsigned long long)wall_clock64() : 0ull;
#define PG8_STAMP() do { if (STAMP && wid == 0 && nts < 64) { const unsigned long long _c = (unsigned long long)clock64(); \
        ts_lo = (lane == nts) ? (int)(unsigned)_c : ts_lo; ts_hi = (lane == nts) ? (int)(unsigned)(_c >> 32) : ts_hi; ++nts; } } while (0)
    PG8_STAMP();
    unsigned voffA[2], voffB[2];
#pragma unroll
    for (int i = 0; i < 2; ++i) { int R, C; stage_rc(tid * 16 + i * 8192, R, C); const int Rb = Epi::PERM ? ((R & ~31) + perm32(R & 31)) : R;
        voffA[i] = (unsigned)(R * K + C) * 2u; voffB[i] = (unsigned)(Rb * K + C) * 2u; }
    const size_t kstep = (size_t)(BK * 2);
    const size_t hstep = (size_t)HALF * K * 2;
    const size_t tstep = 2 * hstep;
    const unsigned ldsw = (unsigned)wid * 1024u;
    const int aoff = lds_byte(wr * 64 + fr, fq * 8), boff = lds_byte(wc * 32 + fr, fq * 8);
#define PG8_SA(b, h) (((b) * 2 + (h)) * HTB)
#define PG8_SB(b, h) ((4 + (b) * 2 + (h)) * HTB)
#define PG8_STAGE(bufoff, gbase, voff) do { _Pragma("unroll") for (int _i = 0; _i < 2; ++_i) \
        __builtin_amdgcn_global_load_lds((const unsigned*)((const char*)(gbase) + (voff)[_i]), (PG8_LAS unsigned*)(lds + (bufoff) + ldsw + _i * 8192), 16, 0, 0); } while (0)
#define PG8_LDA(dst, b, h) do { _Pragma("unroll") for (int m = 0; m < 4; ++m) _Pragma("unroll") for (int k = 0; k < 2; ++k) dst[m][k] = *(const PG8_LAS bf16x8*)(lds + PG8_SA(b, h) + aoff + m * 2048 + k * 1024); } while (0)
#define PG8_LDB(dst, b, h) do { _Pragma("unroll") for (int n = 0; n < 2; ++n) _Pragma("unroll") for (int k = 0; k < 2; ++k) dst[n][k] = *(const PG8_LAS bf16x8*)(lds + PG8_SB(b, h) + boff + n * 2048 + k * 1024); } while (0)
#define PG8_MMA(ai, bj, At, Bt) do { __builtin_amdgcn_s_setprio(1); _Pragma("unroll") for (int m = 0; m < 4; ++m) _Pragma("unroll") for (int n = 0; n < 2; ++n) _Pragma("unroll") for (int k = 0; k < 2; ++k) \
        acc[ai][bj][m][n] = __builtin_amdgcn_mfma_f32_16x16x32_bf16(Bt[n][k], At[m][k], acc[ai][bj][m][n], 0, 0, 0); __builtin_amdgcn_s_setprio(0); } while (0)
#define PG8_WAIT_V(n) asm volatile("s_waitcnt vmcnt(" #n ")" ::: "memory")
#define PG8_WAIT_L(n) asm volatile("s_waitcnt lgkmcnt(" #n ")" ::: "memory")
#define PG8_BAR __builtin_amdgcn_s_barrier()
#define PG8_SCHED __builtin_amdgcn_sched_barrier(0)
    Unit cur, nxt; int ui = 0;
    if (!S.next(0, cur)) return;
    f32x4 acc[2][2][4][2];
#pragma unroll
    for (int a = 0; a < 2; ++a)
#pragma unroll
        for (int b = 0; b < 2; ++b)
#pragma unroll
            for (int m = 0; m < 4; ++m)
#pragma unroll
                for (int n = 0; n < 2; ++n) acc[a][b][m][n] = (f32x4){0.f, 0.f, 0.f, 0.f};
    bf16x8 At[4][2], B0[2][2], B1[2][2];
    const char* cA = (const char*)g.A + (size_t)cur.pm * tstep + (size_t)cur.koff * 2; const char* cB = (const char*)g.Bt + (size_t)cur.pn * tstep + (size_t)cur.koff * 2;
    S.a_ready(cur);
    PG8_STAGE(PG8_SB(0, 0), cB, voffB); PG8_STAGE(PG8_SA(0, 0), cA, voffA); PG8_STAGE(PG8_SB(0, 1), cB + hstep, voffB); PG8_STAGE(PG8_SA(0, 1), cA + hstep, voffA);
    if (wr == 1) PG8_BAR;
    PG8_WAIT_V(4); PG8_BAR;
    PG8_STAGE(PG8_SB(1, 0), cB + kstep, voffB); PG8_STAGE(PG8_SA(1, 0), cA + kstep, voffA); PG8_STAGE(PG8_SB(1, 1), cB + hstep + kstep, voffB);
    PG8_WAIT_V(6); PG8_BAR;
    PG8_STAMP();
    for (;;) {
        const bool has_next = S.next(ui + 1, nxt);
        const char* nA = has_next ? (const char*)g.A + (size_t)nxt.pm * tstep + (size_t)nxt.koff * 2 : cA; const char* nB = has_next ? (const char*)g.Bt + (size_t)nxt.pn * tstep + (size_t)nxt.koff * 2 : cB;
        const int nt = cur.nt;
        for (int t = 0; t < nt; t += 2) {
            const bool last = (t == nt - 2);
            const char* a1 = cA + (size_t)(t + 1) * kstep;
            const char* a2 = last ? nA : cA + (size_t)(t + 2) * kstep; const char* b2 = last ? nB : cB + (size_t)(t + 2) * kstep;
            const char* a3 = a2 + kstep; const char* b3 = b2 + kstep;
            if (last && has_next) S.a_ready(nxt);
            PG8_LDB(B0, 0, 0); PG8_SCHED; PG8_LDA(At, 0, 0); PG8_STAGE(PG8_SA(1, 1), a1 + hstep, voffA);
            PG8_WAIT_L(8); PG8_BAR; PG8_WAIT_L(0); PG8_MMA(0, 0, At, B0); PG8_BAR; PG8_SCHED;
            PG8_LDB(B1, 0, 1); PG8_STAGE(PG8_SB(0, 0), b2, voffB);
            PG8_BAR; PG8_WAIT_L(0); PG8_MMA(0, 1, At, B1); PG8_BAR;
            PG8_LDA(At, 0, 1); PG8_STAGE(PG8_SA(0, 0), a2, voffA);
            PG8_BAR; PG8_WAIT_L(0); PG8_MMA(1, 0, At, B0); PG8_BAR; PG8_SCHED;
            PG8_STAGE(PG8_SB(0, 1), b2 + hstep, voffB);
            PG8_WAIT_V(6); PG8_BAR; PG8_MMA(1, 1, At, B1); PG8_BAR;
            PG8_LDB(B0, 1, 0); PG8_SCHED; PG8_LDA(At, 1, 0); PG8_STAGE(PG8_SA(0, 1), a2 + hstep, voffA);
            PG8_WAIT_L(8); PG8_BAR; PG8_WAIT_L(0); PG8_MMA(0, 0, At, B0); PG8_BAR; PG8_SCHED;
            PG8_LDB(B1, 1, 1); PG8_STAGE(PG8_SB(1, 0), b3, voffB);
            PG8_BAR; PG8_WAIT_L(0); PG8_MMA(0, 1, At, B1); PG8_BAR;
            PG8_LDA(At, 1, 1); PG8_STAGE(PG8_SA(1, 0), a3, voffA);
            PG8_BAR; PG8_WAIT_L(0); PG8_MMA(1, 0, At, B0); PG8_BAR; PG8_SCHED;
            PG8_STAGE(PG8_SB(1, 1), b3 + hstep, voffB);
            PG8_WAIT_V(6); PG8_BAR; PG8_MMA(1, 1, At, B1); PG8_BAR;
        }
        PG8_STAMP();
        if constexpr (!Epi::AFTER_DRAIN) { E(acc, cur, wr, wc, fr, fq); S.done(cur); }
        PG8_STAMP();
        if (!has_next) break;
#pragma unroll
        for (int a = 0; a < 2; ++a)
#pragma unroll
            for (int b = 0; b < 2; ++b)
#pragma unroll
                for (int m = 0; m < 4; ++m)
#pragma unroll
                    for (int n = 0; n < 2; ++n) acc[a][b][m][n] = (f32x4){0.f, 0.f, 0.f, 0.f};
        cur = nxt; cA = nA; cB = nB; ++ui;
    }
    PG8_WAIT_V(0);
    if (wr == 0) PG8_BAR;
    PG8_BAR;
    if constexpr (Epi::AFTER_DRAIN) { E.fused(acc, cur, wr, wc, fr, fq, lds, wid, lane); S.done(cur); }
    PG8_STAMP();
    if (STAMP && wid == 0) { stamps[lane] = lane < nts ? (((unsigned long long)(unsigned)ts_hi << 32) | (unsigned)ts_lo) : 0ull;
        if (lane == 62) stamps[62] = rt_entry; if (lane == 63) stamps[63] = (unsigned long long)wall_clock64(); }
#undef PG8_STAMP
#undef PG8_SA
#undef PG8_SB
#undef PG8_STAGE
#undef PG8_LDA
#undef PG8_LDB
#undef PG8_MMA
#undef PG8_WAIT_V
#undef PG8_WAIT_L
#undef PG8_BAR
#undef PG8_SCHED
}
}

#define LAS __attribute__((address_space(3)))
typedef unsigned short u16;
typedef short s16x4 __attribute__((ext_vector_type(4)));
typedef unsigned u32x2 __attribute__((ext_vector_type(2)));
typedef __bf16 bf2_t __attribute__((ext_vector_type(2)));
typedef float f2_t __attribute__((ext_vector_type(2)));
using pg8::bf16x8; using pg8::f32x4; using pg8::u32x4;

constexpr int DM = 2048, SEQ = 16384, RLAT = 32768, LCTX = 256, MROWS = 33280, DFF = 8192;
constexpr int PLD = 5376, NPROJ = 5632, NIN = 5400;
constexpr int OFF_GU = 0, OFF_GV = 512, OFF_AQ = 1024, OFF_AK = 1792, OFF_AV = 2048, OFF_MQ = 2304, OFF_MK = 3072, OFF_MV = 3840, OFF_MO = 4608;
constexpr int NCH = 130;
constexpr int NSEQ = 24;
constexpr float EPSN = 1e-6f;
constexpr float LOG2E = 1.4426950408889634f;
constexpr float QSCALE = 0.08838834764831845f;

constexpr size_t WS_WIN = 0;
constexpr size_t SZ_WIN = (size_t)NPROJ * DM * 2;
constexpr size_t WS_WOUT = WS_WIN + 2 * SZ_WIN;
constexpr size_t SZ_WOUT = (size_t)DM * DM * 2;
constexpr size_t WS_WFF1 = WS_WOUT + 2 * SZ_WOUT;
constexpr size_t SZ_WFF = (size_t)DFF * DM * 2;
constexpr size_t WS_WFF2 = WS_WFF1 + 2 * SZ_WFF;
constexpr size_t WS_MOD = WS_WFF2 + 2 * SZ_WFF;
constexpr size_t WS_ROPE = WS_MOD + 2 * 3 * 12288 * 4;
constexpr size_t WS_XC = WS_ROPE + 320 * 32 * 8;
constexpr size_t WS_GATES = WS_XC + (size_t)512 * DM * 4;
constexpr size_t WS_NST = WS_GATES + (size_t)MROWS * 32 * 4;
constexpr size_t WS_GSC = WS_NST + (size_t)NSEQ * NCH * 128 * 4;
constexpr size_t WS_MLS = WS_GSC + 16384;
constexpr size_t WS_M0 = WS_MLS + 16384;
constexpr size_t WS_SS = WS_M0 + 16384;
constexpr size_t WS_BIASP = WS_SS + (size_t)4 * MROWS * 4;
constexpr size_t WS_BIASF = WS_BIASP + (size_t)2 * 3 * NPROJ * 4;
constexpr size_t WS_GS = WS_BIASF + (size_t)2 * 3 * DFF * 4;
constexpr size_t WS_CTR = WS_GS + (size_t)2 * 2 * 3 * DM * 4;
constexpr size_t WS_BAR = WS_CTR + 256;
constexpr size_t WS_XN = WS_BAR + 16384;
constexpr size_t WS_R = WS_XN + (size_t)MROWS * DM * 2;
constexpr size_t SZ_PROJ = (size_t)MROWS * PLD * 2;
constexpr size_t WS_Y = WS_R + SZ_PROJ;
constexpr size_t SZ_H = (size_t)MROWS * DFF * 2;
constexpr size_t WS_CST = WS_R + SZ_H;
constexpr size_t WS_END = WS_CST + (size_t)NSEQ * NCH * 16384 * 2;

constexpr int LDS_BYTES = 163840;
constexpr int TSTR = 320;
constexpr int TILE_B = 128 * TSTR;
constexpr int SC_OFF = 3 * TILE_B;

struct Params {
    const float *x, *c, *ctx, *c_ctx, *w_ada, *b_ada, *g_mix, *g_ffn, *w_in, *gm_v_gain, *gm_w_s, *gm_b_s, *attn_sink,
        *ml_conv_w, *ml_conv_b, *ml_b_i, *ml_b_f, *ml_out_gain, *w_out, *w_ff1, *w_ff2, *g_final;
    float* out; unsigned char* ws;
};

#define DI __device__ __forceinline__
typedef const __attribute__((address_space(4))) Params* KP;
DI int tid_l() { int t = threadIdx.x; asm volatile("" : "+v"(t)); return t; }
DI KP launder(KP p) { asm volatile("" : "+s"(p)); return p; }
DI unsigned pk2(float lo, float hi) { bf2_t v = __builtin_convertvector((f2_t){lo, hi}, bf2_t); return __builtin_bit_cast(unsigned, v); }
DI float bf_lo(unsigned u) { return __uint_as_float(u << 16); }
DI float bf_hi(unsigned u) { return __uint_as_float(u & 0xffff0000u); }
DI float wave_sum(float v) {
#pragma unroll
    for (int o = 1; o < 64; o <<= 1) v += __shfl_xor(v, o);
    return v;
}
DI float wave_max(float v) {
#pragma unroll
    for (int o = 1; o < 64; o <<= 1) v = fmaxf(v, __shfl_xor(v, o));
    return v;
}
DI float gelu_tanh(float x) {
    const float u = 0.7978845608028654f * (x + 0.044715f * x * x * x);
    const float e = __expf(2.f * u);
    const float t = 1.f - 2.f * __builtin_amdgcn_rcpf(e + 1.f);
    return 0.5f * x * (1.f + t);
}
DI float sigmoidf_(float x) { return __builtin_amdgcn_rcpf(1.f + __builtin_amdgcn_exp2f(-LOG2E * x)); }
DI float log_sigmoid(float x) { return fminf(x, 0.f) - log1pf(__expf(-fabsf(x))); }
DI void unpack8(const u32x4 v, float* f) { f[0] = bf_lo(v.x); f[1] = bf_hi(v.x); f[2] = bf_lo(v.y); f[3] = bf_hi(v.y); f[4] = bf_lo(v.z); f[5] = bf_hi(v.z); f[6] = bf_lo(v.w); f[7] = bf_hi(v.w); }
DI u32x4 pack8(const float* f) { u32x4 o; o.x = pk2(f[0], f[1]); o.y = pk2(f[2], f[3]); o.z = pk2(f[4], f[5]); o.w = pk2(f[6], f[7]); return o; }
#define MFMA16(a, b, c) __builtin_amdgcn_mfma_f32_16x16x32_bf16((a), (b), (c), 0, 0, 0)

DI int toff(int row, int ch) { return row * TSTR + 16 * ch; }
DI bf16x8 frag_row(const LAS unsigned char* tile, int idx0, int k0, int lane) {
    return *(const LAS bf16x8*)(tile + toff(idx0 + (lane & 15), (k0 >> 3) + (lane >> 4)));
}
DI bf16x8 tr_pair(const LAS unsigned char* p, const LAS unsigned char* p2) {
    s16x4 a = __builtin_amdgcn_ds_read_tr16_b64_v4i16((LAS s16x4*)p);
    s16x4 b = __builtin_amdgcn_ds_read_tr16_b64_v4i16((LAS s16x4*)p2);
    return (bf16x8){a[0], a[1], a[2], a[3], b[0], b[1], b[2], b[3]};
}
DI bf16x8 frag_tr(const LAS unsigned char* tile, int k0, int idx0, int lane) {
    const int i = lane & 15, q = lane >> 4, row = k0 + 8 * q + (i >> 2), ch = (idx0 >> 3) + ((i & 3) >> 1), sub = 8 * (i & 1);
    return tr_pair(tile + toff(row, ch) + sub, tile + toff(row + 4, ch) + sub);
}
DI bf16x8 frag_tr_perm(const LAS unsigned char* tile, int k0, int idx0, int lane) {
    const int i = lane & 15, q = lane >> 4, row = k0 + 4 * q + (i >> 2), ch = (idx0 >> 3) + ((i & 3) >> 1), sub = 8 * (i & 1);
    const LAS unsigned char* a = tile + toff(row, ch) + sub;
    return tr_pair(a, a + 16 * TSTR);
}

DI const float* xrow_in(KP p, int stage, int row) {
    if (row < RLAT) return (stage ? (const float*)p->out : p->x) + (size_t)row * DM;
    return (stage ? (const float*)(p->ws + WS_XC) : p->ctx) + (size_t)(row - RLAT) * DM;
}
DI float* xrow_out(KP p, int row) {
    if (row < RLAT) return p->out + (size_t)row * DM;
    return (float*)(p->ws + WS_XC) + (size_t)(row - RLAT) * DM;
}
DI int mod_index(int row) { return row < SEQ ? 0 : (row < RLAT ? 1 : 2); }
DI float row_rstd(const float* ss, int row) { return rsqrtf(ss[row] * (1.f / DM) + EPSN); }

DI void transpose_item(const float* W, int K, int N, u16* WT, LAS float* scr  , int item, int nblk, int lane) {
    const int kb = item / nblk, nb = item % nblk, k0 = 64 * kb, n0 = 64 * nb;
    const int c4 = lane & 15, rr = lane >> 4;
    const bool ok = n0 + 4 * c4 < N;
    f32x4 v[16];
#pragma unroll
    for (int i = 0; i < 16; ++i) v[i] = ok ? *(const f32x4*)(W + (size_t)(k0 + 4 * i + rr) * N + n0 + 4 * c4) : (f32x4){0.f, 0.f, 0.f, 0.f};
#pragma unroll
    for (int i = 0; i < 16; ++i) { LAS float* d = scr + (4 * i + rr) * 65 + 4 * c4; d[0] = v[i].x; d[1] = v[i].y; d[2] = v[i].z; d[3] = v[i].w; }
    asm volatile("s_waitcnt lgkmcnt(0)" ::: "memory"); __builtin_amdgcn_wave_barrier();
    const int c = lane & 7;
#pragma unroll
    for (int j = 0; j < 8; ++j) { const int nn = (lane >> 3) + 8 * j; const LAS float* q = scr + (8 * c) * 65 + nn;
        u32x4 o; o.x = pk2(q[0 * 65], q[1 * 65]); o.y = pk2(q[2 * 65], q[3 * 65]); o.z = pk2(q[4 * 65], q[5 * 65]); o.w = pk2(q[6 * 65], q[7 * 65]);
        *(u32x4*)(WT + (size_t)(n0 + nn) * K + k0 + 8 * c) = o; }
    asm volatile("s_waitcnt lgkmcnt(0)" ::: "memory"); __builtin_amdgcn_wave_barrier();
}

DI void phase_prep(KP p, LAS unsigned char* lds) {
    const int tid = tid_l(), lane = tid & 63, wave = tid >> 6, bid = blockIdx.x, G = gridDim.x;
    { float* SS = (float*)(p->ws + WS_SS);
      for (int i = bid * 512 + tid; i < 3 * MROWS; i += G * 512) SS[i] = 0.f;
      if (bid == 0 && tid < 64) ((unsigned*)(p->ws + WS_CTR))[tid] = 0u; }
    { const f32x4* src = (const f32x4*)p->ctx; f32x4* dst = (f32x4*)(p->ws + WS_XC);
      for (int i = bid * 512 + tid; i < 512 * DM / 4; i += G * 512) dst[i] = src[i]; }
    {
        LAS float* sv = (LAS float*)lds;
        LAS float* red = (LAS float*)(lds + 3 * 2048 * 4);
        for (int i = tid; i < 3 * 2048; i += 512) { const int v = i >> 11, k = i & 2047; const float x = v == 0 ? p->c[k] : (v == 1 ? p->c[2048 + k] : p->c_ctx[k]); sv[i] = x * sigmoidf_(x); }
        __syncthreads();
        float* MOD = (float*)(p->ws + WS_MOD);
        for (int it = bid; it < 2 * 384; it += G) {
            const int l = it / 384, n0 = (it % 384) * 32, j = tid & 7, kk = tid >> 3;
            const float* w = p->w_ada + (size_t)l * 2048 * 12288 + n0 + 4 * j;
            f32x4 a0 = {0, 0, 0, 0}, a1 = a0, a2 = a0;
#pragma unroll 16
            for (int k = kk; k < 2048; k += 64) { const f32x4 wv = *(const f32x4*)(w + (size_t)k * 12288); a0 += wv * sv[k]; a1 += wv * sv[2048 + k]; a2 += wv * sv[4096 + k]; }
            LAS float* r = red + (kk * 8 + j) * 12;
            *(LAS f32x4*)(r) = a0; *(LAS f32x4*)(r + 4) = a1; *(LAS f32x4*)(r + 8) = a2;
            __syncthreads();
            if (tid < 96) { const int v = tid >> 5, cc = tid & 31, jj = cc >> 2, e = cc & 3; float sum = 0.f;
                for (int q = 0; q < 64; ++q) sum += red[(q * 8 + jj) * 12 + v * 4 + e];
                MOD[(size_t)(l * 3 + v) * 12288 + n0 + cc] = sum + p->b_ada[l * 12288 + n0 + cc]; }
            __syncthreads();
        }
    }
    {
        f2_t* ROPE = (f2_t*)(p->ws + WS_ROPE);
        for (int i = bid * 512 + tid; i < 320 * 32; i += G * 512) { const int pos = i >> 5, f = i & 31; const int pa = pos < 256 ? pos : pos - 256;
            const float freq = 1.0f / powf(10000.0f, (float)(2 * f) / 64.0f); const float ang = (float)pa * freq; ROPE[i] = (f2_t){cosf(ang), sinf(ang)}; }
    }
    {
        LAS float* scr = (LAS float*)(lds + wave * 16640);
        const int gw = bid * 8 + wave, NGW = G * 8;
        constexpr int I_IN = 32 * 88, I_OUT = 32 * 32, I_F1 = 32 * 128, I_F2 = 128 * 32, I_L = I_IN + I_OUT + I_F1 + I_F2;
        for (int it = gw; it < 2 * I_L; it += NGW) {
            const int l = it / I_L; int r = it % I_L;
            if (r < I_IN) { transpose_item(p->w_in + (size_t)l * DM * NIN, DM, NIN, (u16*)(p->ws + WS_WIN + l * SZ_WIN), scr, r, 88, lane); continue; } r -= I_IN;
            if (r < I_OUT) { transpose_item(p->w_out + (size_t)l * DM * DM, DM, DM, (u16*)(p->ws + WS_WOUT + l * SZ_WOUT), scr, r, 32, lane); continue; } r -= I_OUT;
            if (r < I_F1) { transpose_item(p->w_ff1 + (size_t)l * DM * DFF, DM, DFF, (u16*)(p->ws + WS_WFF1 + l * SZ_WFF), scr, r, 128, lane); continue; } r -= I_F1;
            transpose_item(p->w_ff2 + (size_t)l * DFF * DM, DFF, DM, (u16*)(p->ws + WS_WFF2 + l * SZ_WFF), scr, r, 32, lane);
        }
    }
}

DI void phase_prep2(KP p, LAS unsigned char* lds) {
    const int tid = tid_l(), lane = tid & 63, wave = tid >> 6, bid = blockIdx.x, G = gridDim.x;
    const float* MOD = (const float*)(p->ws + WS_MOD);
    { float* GS = (float*)(p->ws + WS_GS);
      for (int i = bid * 512 + tid; i < 2 * 2 * 3 * DM; i += G * 512) { const int k = i & 2047, cls = (i >> 11) % 3, which = (i / (3 * DM)) & 1, l = i / (6 * DM);
          GS[i] = (which ? p->g_ffn : p->g_mix)[l * DM + k] * (1.f + MOD[(size_t)(l * 3 + cls) * 12288 + (which * 3 + 1) * DM + k]); } }
    LAS float* sh = (LAS float*)lds;
    const int gw = bid * 8 + wave, NGW = G * 8;
    for (int l = 0; l < 2; ++l) {
        __syncthreads();
        for (int i = tid; i < 6 * DM; i += 512) { const int k = i & 2047, cls = (i >> 11) % 3, which = i / (3 * DM); sh[i] = MOD[(size_t)(l * 3 + cls) * 12288 + (which * 3) * DM + k]; }
        __syncthreads();
        for (int r = gw; r < NPROJ + DFF; r += NGW) {
            const bool isf = r >= NPROJ; const int n = isf ? r - NPROJ : r;
            const u16* wrow = isf ? (const u16*)(p->ws + WS_WFF1 + l * SZ_WFF) + (size_t)n * DM : (const u16*)(p->ws + WS_WIN + l * SZ_WIN) + (size_t)n * DM;
            const LAS float* s0 = sh + (isf ? 3 * DM : 0);
            float a0 = 0.f, a1 = 0.f, a2 = 0.f;
#pragma unroll
            for (int j = 0; j < 4; ++j) { const int k = 8 * (lane + 64 * j); float w[8]; unpack8(*(const u32x4*)(wrow + k), w);
#pragma unroll
                for (int e = 0; e < 8; ++e) { a0 += w[e] * s0[k + e]; a1 += w[e] * s0[DM + k + e]; a2 += w[e] * s0[2 * DM + k + e]; } }
            a0 = wave_sum(a0); a1 = wave_sum(a1); a2 = wave_sum(a2);
            if (lane == 0) { float* B = isf ? (float*)(p->ws + WS_BIASF) + (size_t)l * 3 * DFF : (float*)(p->ws + WS_BIASP) + (size_t)l * 3 * NPROJ; const int N = isf ? DFF : NPROJ;
                B[n] = a0; B[N + n] = a1; B[2 * N + n] = a2; }
        }
    }
}

DI void phase_norm0(KP p) {
    const int tid = tid_l(), lane = tid & 63, gw = blockIdx.x * 8 + (tid >> 6), NGW = gridDim.x * 8;
    const float* gain = p->g_mix;
    u16* XN = (u16*)(p->ws + WS_XN);
    float* SS = (float*)(p->ws + WS_SS) + 3 * MROWS;
    f32x4 v[8], nx[8];
    if (gw < MROWS) { const float* xr = xrow_in(p, 0, gw);
#pragma unroll
        for (int j = 0; j < 8; ++j) v[j] = *(const f32x4*)(xr + 4 * lane + 256 * j); }
    for (int row = gw; row < MROWS; row += NGW) {
        const int nrow = row + NGW;
        if (nrow < MROWS) { const float* xr = xrow_in(p, 0, nrow);
#pragma unroll
            for (int j = 0; j < 8; ++j) nx[j] = *(const f32x4*)(xr + 4 * lane + 256 * j); }
        const float* md = (const float*)(p->ws + WS_MOD) + (size_t)mod_index(row) * 12288;
        float sum = 0.f;
#pragma unroll
        for (int j = 0; j < 8; ++j) sum += (v[j].x * v[j].x + v[j].y * v[j].y) + (v[j].z * v[j].z + v[j].w * v[j].w);
        sum = wave_sum(sum);
        if (lane == 0) SS[row] = sum;
#pragma unroll
        for (int j = 0; j < 8; ++j) { const int c = 4 * lane + 256 * j;
            const f32x4 g = *(const f32x4*)(gain + c), sc = *(const f32x4*)(md + DM + c);
            const f32x4 y = (v[j] * g) * (sc + 1.f);
            u32x2 o; o.x = pk2(y.x, y.y); o.y = pk2(y.z, y.w);
            *(u32x2*)(XN + (size_t)row * DM + c) = o; }
#pragma unroll
        for (int j = 0; j < 8; ++j) v[j] = nx[j];
    }
}
DI void phase_ctx_norm(KP p, const float* gs  , float* ss, int nsp) {
    const int tid = tid_l(), lane = tid & 63, gw = blockIdx.x * 8 + (tid >> 6), NGW = gridDim.x * 8;
    u16* XN = (u16*)(p->ws + WS_XN);
    for (int row = RLAT + gw; row < MROWS; row += NGW) {
        float* xr = (float*)(p->ws + WS_XC) + (size_t)(row - RLAT) * DM;
        const float* part = (const float*)(p->ws + WS_CST) + (size_t)(row - RLAT) * DM;
        f32x4 v[8]; float sum = 0.f;
#pragma unroll
        for (int j = 0; j < 8; ++j) v[j] = *(const f32x4*)(xr + 4 * lane + 256 * j);
        for (int ks = 0; ks < nsp; ++ks) {
#pragma unroll
            for (int j = 0; j < 8; ++j) v[j] += *(const f32x4*)(part + (size_t)ks * 512 * DM + 4 * lane + 256 * j); }
#pragma unroll
        for (int j = 0; j < 8; ++j) { *(f32x4*)(xr + 4 * lane + 256 * j) = v[j]; sum += (v[j].x * v[j].x + v[j].y * v[j].y) + (v[j].z * v[j].z + v[j].w * v[j].w); }
        sum = wave_sum(sum);
        if (lane == 0) ss[row] = sum;
#pragma unroll
        for (int j = 0; j < 8; ++j) { const int c = 4 * lane + 256 * j; const f32x4 y = v[j] * *(const f32x4*)(gs + c);
            u32x2 o; o.x = pk2(y.x, y.y); o.y = pk2(y.z, y.w); *(u32x2*)(XN + (size_t)row * DM + c) = o; }
    }
}
DI void phase_final(KP p) {
    const int tid = tid_l(), lane = tid & 63, gw = blockIdx.x * 8 + (tid >> 6), NGW = gridDim.x * 8;
    f32x4 v[8], nx[8];
    if (gw < RLAT) { const float* xr = p->out + (size_t)gw * DM;
#pragma unroll
        for (int j = 0; j < 8; ++j) v[j] = *(const f32x4*)(xr + 4 * lane + 256 * j); }
    for (int row = gw; row < RLAT; row += NGW) {
        const int nrow = row + NGW;
        if (nrow < RLAT) { const float* xn = p->out + (size_t)nrow * DM;
#pragma unroll
            for (int j = 0; j < 8; ++j) nx[j] = *(const f32x4*)(xn + 4 * lane + 256 * j); }
        float* xr = p->out + (size_t)row * DM;
        float sum = 0.f;
#pragma unroll
        for (int j = 0; j < 8; ++j) sum += (v[j].x * v[j].x + v[j].y * v[j].y) + (v[j].z * v[j].z + v[j].w * v[j].w);
        const float rstd = rsqrtf(wave_sum(sum) * (1.f / DM) + EPSN);
#pragma unroll
        for (int j = 0; j < 8; ++j) { const int c = 4 * lane + 256 * j; const f32x4 g = *(const f32x4*)(p->g_final + c); *(f32x4*)(xr + c) = v[j] * rstd * g; }
#pragma unroll
        for (int j = 0; j < 8; ++j) v[j] = nx[j];
    }
}

struct EpiProj {
    static constexpr bool PERM = true, AFTER_DRAIN = false;
    u16* O; float* gates; const float* ss; const float* bias0;
    __device__ __forceinline__ void operator()(const f32x4 (&acc)[2][2][4][2], const pg8::Unit& u, int wr, int wc, int fr, int fq) const {
        const int row0 = u.pm * 256 + wr * 64 + fr;
        const float* bias = bias0 + (size_t)mod_index(u.pm * 256) * NPROJ + u.pn * 256 + wc * 32 + 8 * fq;
        float rs[2][4];
#pragma unroll
        for (int ai = 0; ai < 2; ++ai)
#pragma unroll
            for (int m = 0; m < 4; ++m) rs[ai][m] = row_rstd(ss, row0 + ai * 128 + m * 16);
        {
            const int col0 = u.pn * 256 + wc * 32 + 8 * fq;
#pragma unroll
            for (int bj = 0; bj < 2; ++bj) { const f32x4 b0 = *(const f32x4*)(bias + bj * 128), b1 = *(const f32x4*)(bias + bj * 128 + 4);
#pragma unroll
                for (int ai = 0; ai < 2; ++ai)
#pragma unroll
                    for (int m = 0; m < 4; ++m) { const f32x4 v0 = acc[ai][bj][m][0] * rs[ai][m] + b0, v1 = acc[ai][bj][m][1] * rs[ai][m] + b1;
                        u32x4 o; o.x = pk2(v0[0], v0[1]); o.y = pk2(v0[2], v0[3]); o.z = pk2(v1[0], v1[1]); o.w = pk2(v1[2], v1[3]);
                        *(u32x4*)(O + (size_t)(row0 + ai * 128 + m * 16) * PLD + col0 + bj * 128) = o; } }
        }
    }
};
struct EpiRes {
    static constexpr bool PERM = false, AFTER_DRAIN = false;
    KP p; int stage; const float* gate0;
    const float* gs0; float* ssn;
    int ntfull;
    __device__ __forceinline__ void operator()(const f32x4 (&acc)[2][2][4][2], const pg8::Unit& u, int wr, int wc, int fr, int fq) const {
        const int row0 = u.pm * 256 + wr * 64 + fr, col0 = u.pn * 256 + wc * 32 + 4 * fq, cls = mod_index(u.pm * 256);
        const float* gate = gate0 + (size_t)cls * 12288 + col0;
        if (u.nt != ntfull) {
#pragma unroll
            for (int ai = 0; ai < 2; ++ai)
#pragma unroll
                for (int m = 0; m < 4; ++m) { float* xo = (float*)(p->ws + WS_CST) + ((size_t)(u.koff / 512) * 512 + (row0 + ai * 128 + m * 16 - RLAT)) * DM + col0;
#pragma unroll
                    for (int bj = 0; bj < 2; ++bj)
#pragma unroll
                        for (int n = 0; n < 2; ++n) { const int co = bj * 128 + n * 16; *(f32x4*)(xo + co) = *(const f32x4*)(gate + co) * acc[ai][bj][m][n]; } }
            return;
        }
        const float* gs = gs0 ? gs0 + cls * DM + col0 : nullptr;
        u16* XN = (u16*)(p->ws + WS_XN);
#pragma unroll
        for (int ai = 0; ai < 2; ++ai)
#pragma unroll
            for (int m = 0; m < 4; ++m) { const int row = row0 + ai * 128 + m * 16; const float* xi = xrow_in(p, stage, row) + col0; float* xo = xrow_out(p, row) + col0;
                float sq = 0.f;
#pragma unroll
                for (int bj = 0; bj < 2; ++bj)
#pragma unroll
                    for (int n = 0; n < 2; ++n) { const int co = bj * 128 + n * 16;
                        const f32x4 v = *(const f32x4*)(xi + co) + *(const f32x4*)(gate + co) * acc[ai][bj][m][n];
                        *(f32x4*)(xo + co) = v;
                        if (gs) { const f32x4 y = v * *(const f32x4*)(gs + co); u32x2 o; o.x = pk2(y.x, y.y); o.y = pk2(y.z, y.w);
                            *(u32x2*)(XN + (size_t)row * DM + col0 + co) = o; sq += (v.x * v.x + v.y * v.y) + (v.z * v.z + v.w * v.w); } }
                if (gs) { sq += __shfl_xor(sq, 16); sq += __shfl_xor(sq, 32); if (fq == 0) atomicAdd(ssn + row, sq); } }
    }
};
struct EpiSqRelu {
    static constexpr bool PERM = true, AFTER_DRAIN = false;
    u16* O; const float* ss; const float* bias0;
    __device__ __forceinline__ void operator()(const f32x4 (&acc)[2][2][4][2], const pg8::Unit& u, int wr, int wc, int fr, int fq) const {
        const int row0 = u.pm * 256 + wr * 64 + fr, col0 = u.pn * 256 + wc * 32 + 8 * fq;
        const float* bias = bias0 + (size_t)mod_index(u.pm * 256) * DFF + col0;
        float rs[2][4];
#pragma unroll
        for (int ai = 0; ai < 2; ++ai)
#pragma unroll
            for (int m = 0; m < 4; ++m) rs[ai][m] = row_rstd(ss, row0 + ai * 128 + m * 16);
#pragma unroll
        for (int bj = 0; bj < 2; ++bj) { const f32x4 b0 = *(const f32x4*)(bias + bj * 128), b1 = *(const f32x4*)(bias + bj * 128 + 4);
#pragma unroll
            for (int ai = 0; ai < 2; ++ai)
#pragma unroll
                for (int m = 0; m < 4; ++m) { f32x4 v0 = acc[ai][bj][m][0] * rs[ai][m] + b0, v1 = acc[ai][bj][m][1] * rs[ai][m] + b1;
#pragma unroll
                    for (int e = 0; e < 4; ++e) { const float a = fmaxf(v0[e], 0.f), b = fmaxf(v1[e], 0.f); v0[e] = a * a; v1[e] = b * b; }
                    u32x4 o; o.x = pk2(v0[0], v0[1]); o.y = pk2(v0[2], v0[3]); o.z = pk2(v1[0], v1[1]); o.w = pk2(v1[2], v1[3]);
                    *(u32x4*)(O + (size_t)(row0 + ai * 128 + m * 16) * DFF + col0 + bj * 128) = o; } }
    }
};
template <class Epi> DI void run_gemm(LAS unsigned char* lds, const u16* A, const u16* Bt, int M, int N, int K, const Epi& E) {
    pg8::Gemm g; g.A = A; g.Bt = Bt; g.M = M; g.N = N; g.K = K;
    pg8::StaticOrder S; S.init(M, N, K, (int)gridDim.x, (int)blockIdx.x);
    pg8::gemm_phase<Epi, pg8::StaticOrder, false>(lds, g, S, E, nullptr);
}
struct SplitOrder : pg8::StaticOrder {
    int nsp, ksp, ntsp, pm0, nctx;
    __device__ __forceinline__ bool next(int i, pg8::Unit& u) const {
        const long L = (long)i * G + c;
        if (L < nwg) return pg8::StaticOrder::next(i, u);
        const int q = (int)(L - nwg); if (q >= nctx) return false;
        const int tile = q % (2 * nN), ks = q / (2 * nN);
        u.pm = pm0 + tile / nN; u.pn = tile % nN; u.koff = ks * ksp; u.nt = ntsp; return true;
    }
};
template <class Epi> DI void run_gemm_split(LAS unsigned char* lds, const u16* A, const u16* Bt, int Mlat, int N, int K, int nsp, const Epi& E) {
    pg8::Gemm g; g.A = A; g.Bt = Bt; g.M = Mlat; g.N = N; g.K = K;
    SplitOrder S; S.init(Mlat, N, K, (int)gridDim.x, (int)blockIdx.x);
    S.nsp = nsp; S.ksp = nsp ? K / nsp : K; S.ntsp = S.ksp / 64; S.pm0 = Mlat / 256; S.nctx = nsp ? 2 * (N / 256) * nsp : 0;
    pg8::gemm_phase<Epi, SplitOrder, false>(lds, g, S, E, nullptr);
}


DI void stage_plain(LAS unsigned char* T, const u16* src, int ld, int tid) {
#pragma unroll
    for (int i = 0; i < 4; ++i) { const int id = tid + 512 * i, row = id >> 4, ch = id & 15;
        *(LAS u32x4*)(T + toff(row, ch)) = *(const u32x4*)(src + (size_t)row * ld + ch * 8); }
}
DI void stage_rope(LAS unsigned char* T, const u16* src, int ld, int pos0, float scale, const f2_t* ROPE, int tid) {
#pragma unroll
    for (int i = 0; i < 2; ++i) { const int task = tid + 512 * i, row = task >> 3, pp = task & 7, cq = pp & 3, half = pp >> 2, chA = half * 8 + cq;
        const int pos = pos0 + row, pa = half ? 256 + (pos & 63) : (pos >> 6);
        const u32x4 ra = *(const u32x4*)(src + (size_t)row * ld + chA * 8), rb = *(const u32x4*)(src + (size_t)row * ld + (chA + 4) * 8);
        float x1[8], x2[8], o1[8], o2[8]; unpack8(ra, x1); unpack8(rb, x2);
        const f2_t* tb = ROPE + pa * 32 + cq * 8;
#pragma unroll
        for (int e = 0; e < 8; ++e) { const f2_t cs = tb[e]; o1[e] = (x1[e] * cs.x - x2[e] * cs.y) * scale; o2[e] = (x1[e] * cs.y + x2[e] * cs.x) * scale; }
        *(LAS u32x4*)(T + toff(row, chA)) = pack8(o1); *(LAS u32x4*)(T + toff(row, chA + 4)) = pack8(o2); }
}
DI void stage_conv(LAS unsigned char* T, const u16* src, int ld, int lo, int hi, const float* cw  , const float* cb, float scale, int tid, u16* gdst = nullptr  ) {
#pragma unroll
    for (int i = 0; i < 4; ++i) { const int id = tid + 512 * i, row = id >> 4, ch = id & 15;
        float xm[8], x0[8], xp[8], y[8];
        const u32x4 z = {0u, 0u, 0u, 0u};
        const bool okm = row - 1 >= lo, okp = row + 1 < hi;
        const u32x4 r0 = *(const u32x4*)(src + (size_t)row * ld + ch * 8);
        u32x4 rm = *(const u32x4*)(src + (ptrdiff_t)(okm ? row - 1 : row) * ld + ch * 8);
        u32x4 rp = *(const u32x4*)(src + (ptrdiff_t)(okp ? row + 1 : row) * ld + ch * 8);
        rm = okm ? rm : z; rp = okp ? rp : z;
        unpack8(rm, xm); unpack8(r0, x0); unpack8(rp, xp);
#pragma unroll
        for (int e = 0; e < 8; ++e) { const int c = ch * 8 + e; const float v = cb[c] + xm[e] * cw[c] + x0[e] * cw[1536 + c] + xp[e] * cw[3072 + c]; y[e] = v * sigmoidf_(v) * scale; }
        const u32x4 pk = pack8(y);
        *(LAS u32x4*)(T + toff(row, ch)) = pk;
        if (gdst) *(u32x4*)(gdst + (size_t)row * 768 + ch * 8) = pk; }
}

DI void gate_item(KP p, int l, int it, LAS unsigned char* lds) {
    const int tid = tid_l(), lane = tid & 63, wid = tid >> 6, fr = lane & 15, fq = lane >> 4;
    const int r0 = it * 128, srow = tid >> 4, sch = tid & 15;
    const u16* xa = (const u16*)(p->ws + WS_XN) + (size_t)(r0 + srow) * DM + sch * 8;
    const u16* wg = (const u16*)(p->ws + WS_WIN + l * SZ_WIN) + (size_t)(PLD + (tid >> 4)) * DM + sch * 8;
    LAS unsigned char* T0 = lds; LAS unsigned char* T1 = lds + TILE_B;
    u32x4 ar[4], wreg;
#pragma unroll
    for (int i = 0; i < 4; ++i) ar[i] = *(const u32x4*)(xa + (size_t)(32 * i) * DM);
    wreg = *(const u32x4*)wg;
    f32x4 acc0 = {0.f, 0.f, 0.f, 0.f}, acc1 = {0.f, 0.f, 0.f, 0.f};
    for (int kc = 0; kc < 16; ++kc) {
        __syncthreads();
#pragma unroll
        for (int i = 0; i < 4; ++i) *(LAS u32x4*)(T0 + toff(srow + 32 * i, sch)) = ar[i];
        *(LAS u32x4*)(T1 + toff(srow, sch)) = wreg;
        if (kc < 15) {
#pragma unroll
            for (int i = 0; i < 4; ++i) ar[i] = *(const u32x4*)(xa + (size_t)(32 * i) * DM + (kc + 1) * 128);
            wreg = *(const u32x4*)(wg + (kc + 1) * 128); }
        __syncthreads();
#pragma unroll
        for (int ks = 0; ks < 4; ++ks) { const bf16x8 xf = frag_row(T0, 16 * wid, 32 * ks, lane);
            acc0 = MFMA16(frag_row(T1, 0, 32 * ks, lane), xf, acc0); acc1 = MFMA16(frag_row(T1, 16, 32 * ks, lane), xf, acc1); }
    }
    const int row = r0 + 16 * wid + fr;
    const float rs = row_rstd((const float*)(p->ws + WS_SS) + (l == 0 ? 3 : 1) * MROWS, row);
    const float* bias = (const float*)(p->ws + WS_BIASP) + (size_t)(l * 3 + mod_index(row)) * NPROJ + PLD + 4 * fq;
    float* gp = (float*)(p->ws + WS_GATES) + (size_t)row * 32 + 4 * fq;
    *(f32x4*)gp = acc0 * rs + *(const f32x4*)bias; *(f32x4*)(gp + 16) = acc1 * rs + *(const f32x4*)(bias + 16);
    __syncthreads();
}

DI void gmlp_item(KP p, int l, int it, LAS unsigned char* lds) {
    const int tid = tid_l(), lane = tid & 63, wid = tid >> 6, fr = lane & 15, fq = lane >> 4;
    const int n = it >> 2, g = it & 3, r0 = n * 128;
    const u16* proj = (const u16*)(p->ws + WS_R);
    u16* Y = (u16*)(p->ws + WS_Y);
    LAS unsigned char* T0 = lds; LAS unsigned char* T1 = lds + TILE_B;
    { const float* ws = p->gm_w_s + (size_t)(l * 4 + g) * 16384;
#pragma unroll
      for (int i = 0; i < 8; ++i) { const int f = tid + 512 * i, row = f >> 5, c4 = f & 31; const f32x4 v = *(const f32x4*)(ws + (size_t)f * 4);
          u32x2 o; o.x = pk2(v.x, v.y); o.y = pk2(v.z, v.w); *(LAS u32x2*)(T0 + toff(row, c4 >> 1) + 8 * (c4 & 1)) = o; } }
    { const float* vg = p->gm_v_gain + l * 512 + g * 128;
#pragma unroll
      for (int i = 0; i < 4; ++i) { const int id = tid + 512 * i, row = id >> 4, ch = id & 15;
          float v[8]; unpack8(*(const u32x4*)(proj + (size_t)(r0 + row) * PLD + OFF_GV + g * 128 + ch * 8), v);
          float ss = 0.f;
#pragma unroll
          for (int e = 0; e < 8; ++e) { v[e] = gelu_tanh(v[e]); ss += v[e] * v[e]; }
          ss += __shfl_xor(ss, 1); ss += __shfl_xor(ss, 2); ss += __shfl_xor(ss, 4); ss += __shfl_xor(ss, 8);
          const float rstd = rsqrtf(ss * (1.f / 128.f) + EPSN);
#pragma unroll
          for (int e = 0; e < 8; ++e) v[e] = v[e] * rstd * vg[ch * 8 + e];
          *(LAS u32x4*)(T1 + toff(row, ch)) = pack8(v); } }
    __syncthreads();
    const int cb = 32 * (wid >> 1), pb = 64 * (wid & 1);
    f32x4 acc[2][4];
#pragma unroll
    for (int a = 0; a < 2; ++a)
#pragma unroll
        for (int b = 0; b < 4; ++b) acc[a][b] = (f32x4){0.f, 0.f, 0.f, 0.f};
#pragma unroll
    for (int ks = 0; ks < 4; ++ks) {
        bf16x8 af[2], bfg[4];
#pragma unroll
        for (int a = 0; a < 2; ++a) af[a] = frag_tr(T1, 32 * ks, cb + 16 * a, lane);
#pragma unroll
        for (int b = 0; b < 4; ++b) bfg[b] = frag_row(T0, pb + 16 * b, 32 * ks, lane);
#pragma unroll
        for (int a = 0; a < 2; ++a)
#pragma unroll
            for (int b = 0; b < 4; ++b) acc[a][b] = MFMA16(af[a], bfg[b], acc[a][b]);
    }
    const float* bs = p->gm_b_s + (l * 4 + g) * 128;
#pragma unroll
    for (int a = 0; a < 2; ++a)
#pragma unroll
        for (int b = 0; b < 4; ++b) { const int pp = pb + 16 * b + fr, c0 = cb + 16 * a + 4 * fq; const float bias = bs[pp];
            const u32x2 uu = *(const u32x2*)(proj + (size_t)(r0 + pp) * PLD + OFF_GU + g * 128 + c0);
            const float u0 = gelu_tanh(bf_lo(uu.x)), u1 = gelu_tanh(bf_hi(uu.x)), u2 = gelu_tanh(bf_lo(uu.y)), u3 = gelu_tanh(bf_hi(uu.y));
            u32x2 o; o.x = pk2(u0 * (acc[a][b][0] + bias), u1 * (acc[a][b][1] + bias)); o.y = pk2(u2 * (acc[a][b][2] + bias), u3 * (acc[a][b][3] + bias));
            *(u32x2*)(Y + (size_t)(r0 + pp) * DM + g * 128 + c0) = o; }
    __syncthreads();
}

DI void rope_item(KP p, int it) {
    const int tid = tid_l();
    u16* proj = (u16*)(p->ws + WS_R);
    const f2_t* ROPE = (const f2_t*)(p->ws + WS_ROPE);
    const float qs = QSCALE * LOG2E;
    const int row0 = it * 128;
    if (it < 256) {
        const int pos0 = (it & 127) * 128;
#pragma unroll 2
        for (int i = 0; i < 16; ++i) { const int task = tid + 512 * i, hh = task >> 10, row = (task >> 3) & 127, pp = task & 7, cq = pp & 3, half = pp >> 2, chA = half * 8 + cq;
            const int pos = pos0 + row, pa = half ? 256 + (pos & 63) : (pos >> 6);
            u16* src = proj + (size_t)(row0 + row) * PLD + OFF_AQ + hh * 128;
            const float scale = hh < 6 ? qs : 1.f;
            const u32x4 ra = *(const u32x4*)(src + chA * 8), rb = *(const u32x4*)(src + (chA + 4) * 8);
            float x1[8], x2[8], o1[8], o2[8]; unpack8(ra, x1); unpack8(rb, x2);
            const f2_t* tb = ROPE + pa * 32 + cq * 8;
#pragma unroll
            for (int e = 0; e < 8; ++e) { const f2_t cs = tb[e]; o1[e] = (x1[e] * cs.x - x2[e] * cs.y) * scale; o2[e] = (x1[e] * cs.y + x2[e] * cs.x) * scale; }
            *(u32x4*)(src + chA * 8) = pack8(o1); *(u32x4*)(src + (chA + 4) * 8) = pack8(o2); }
    } else {
#pragma unroll 2
        for (int i = 0; i < 24; ++i) { const int id = tid + 512 * i, row = id / 96, ch = id % 96; float v[8];
            u16* src = proj + (size_t)(row0 + row) * PLD + OFF_AQ + ch * 8;
            unpack8(*(const u32x4*)src, v);
#pragma unroll
            for (int e = 0; e < 8; ++e) v[e] *= qs;
            *(u32x4*)src = pack8(v); }
    }
}

DI void attn_tile(int kt, bool isctx, int b, int nb, bool& valid, int& krow0, int& jloc) {
    jloc = 0; valid = true;
    if (kt < 2) { krow0 = RLAT + b * LCTX + kt * 128; return; }
    jloc = kt - 3; const int kb = nb + jloc; krow0 = b * SEQ + kb * 128;
    valid = !isctx && kb >= 0 && kb <= 127 && kt < 5;
    if (!valid) krow0 = 0;
}
DI void attn_item(KP p, int l, int it, LAS unsigned char* lds) {
    const int tid = tid_l(), lane = tid & 63, wid = tid >> 6, fr = lane & 15, fq = lane >> 4;
    const u16* proj = (const u16*)(p->ws + WS_R);
    u16* Y = (u16*)(p->ws + WS_Y);
    LAS unsigned char* T0 = lds; LAS unsigned char* T1 = lds + TILE_B; LAS unsigned char* T2 = lds + 2 * TILE_B;
    int b, nb, hq, qrow0; bool isctx;
    if (it < 1536) { hq = it % 6; nb = (it / 6) & 127; b = it / 768; qrow0 = b * SEQ + nb * 128; isctx = false; }
    else { const int r = it - 1536; hq = r % 6; const int cbk = (r / 6) & 1; b = r / 12; nb = 0; qrow0 = RLAT + b * LCTX + cbk * 128; isctx = true; }
    const int kvh = hq / 3;
    const int srow = tid >> 4, sch = tid & 15;
    u32x4 kr[4], vr[4];
    { const u16* ks = proj + (size_t)(RLAT + b * LCTX) * PLD + OFF_AK + kvh * 128 + sch * 8; const u16* vs = proj + (size_t)(RLAT + b * LCTX) * PLD + OFF_AV + kvh * 128 + sch * 8;
#pragma unroll
      for (int i = 0; i < 4; ++i) { kr[i] = *(const u32x4*)(ks + (size_t)(srow + 32 * i) * PLD); vr[i] = *(const u32x4*)(vs + (size_t)(srow + 32 * i) * PLD); } }
    stage_plain(T0, proj + (size_t)qrow0 * PLD + OFF_AQ + hq * 128, PLD, tid);
    __syncthreads();
    bf16x8 Qf[4];
#pragma unroll
    for (int ks = 0; ks < 4; ++ks) Qf[ks] = frag_row(T0, 16 * wid, 32 * ks, lane);
    float m = p->attn_sink[l * 6 + hq] * LOG2E, lsum = 1.f;
    f32x4 O[8];
#pragma unroll
    for (int i = 0; i < 8; ++i) O[i] = (f32x4){0.f, 0.f, 0.f, 0.f};
    const int rin = 16 * wid + fr;
    for (int kt = 0; kt < 5; ++kt) {
        bool valid; int krow0, jloc; attn_tile(kt, isctx, b, nb, valid, krow0, jloc);
        if (!valid) continue;
        __syncthreads();
#pragma unroll
        for (int i = 0; i < 4; ++i) { *(LAS u32x4*)(T1 + toff(srow + 32 * i, sch)) = kr[i]; *(LAS u32x4*)(T2 + toff(srow + 32 * i, sch)) = vr[i]; }
        {
          int kn = kt + 1; bool vn; int rn, jn; attn_tile(kn, isctx, b, nb, vn, rn, jn);
          if (!vn && kn < 4) { ++kn; attn_tile(kn, isctx, b, nb, vn, rn, jn); }
          if (vn) { const u16* ks = proj + (size_t)rn * PLD + OFF_AK + kvh * 128 + sch * 8; const u16* vs = proj + (size_t)rn * PLD + OFF_AV + kvh * 128 + sch * 8;
#pragma unroll
              for (int i = 0; i < 4; ++i) { kr[i] = *(const u32x4*)(ks + (size_t)(srow + 32 * i) * PLD); vr[i] = *(const u32x4*)(vs + (size_t)(srow + 32 * i) * PLD); } } }
        __syncthreads();
        const bool local = kt >= 2;
        f32x4 S[8];
#pragma unroll
        for (int n = 0; n < 8; ++n) S[n] = (f32x4){0.f, 0.f, 0.f, 0.f};
        {
            bf16x8 kf[2][8];
#pragma unroll
            for (int n = 0; n < 8; ++n) kf[0][n] = frag_row(T1, 16 * n, 0, lane);
#pragma unroll
            for (int ks = 0; ks < 4; ++ks) {
                if (ks < 3) {
#pragma unroll
                    for (int n = 0; n < 8; ++n) kf[(ks + 1) & 1][n] = frag_row(T1, 16 * n, 32 * (ks + 1), lane);
                }
#pragma unroll
                for (int n = 0; n < 8; ++n) S[n] = MFMA16(kf[ks & 1][n], Qf[ks], S[n]);
            }
        }
        if (local && jloc != 0) {
#pragma unroll
            for (int n = 0; n < 8; ++n)
#pragma unroll
                for (int j = 0; j < 4; ++j) { const int dk = 16 * n + 4 * fq + j - rin; const bool keep = jloc < 0 ? dk >= 0 : dk <= 0; S[n][j] = keep ? S[n][j] : -INFINITY; }
        }
        float mx = -INFINITY;
#pragma unroll
        for (int n = 0; n < 8; ++n) mx = fmaxf(fmaxf(mx, fmaxf(S[n][0], S[n][1])), fmaxf(S[n][2], S[n][3]));
        mx = fmaxf(mx, __shfl_xor(mx, 16)); mx = fmaxf(mx, __shfl_xor(mx, 32));
        const float mnew = fmaxf(m, mx), alpha = __builtin_amdgcn_exp2f(m - mnew);
        float rs = 0.f;
#pragma unroll
        for (int n = 0; n < 8; ++n)
#pragma unroll
            for (int j = 0; j < 4; ++j) { const float e = __builtin_amdgcn_exp2f(S[n][j] - mnew); S[n][j] = e; rs += e; }
        rs += __shfl_xor(rs, 16); rs += __shfl_xor(rs, 32);
        lsum = lsum * alpha + rs; m = mnew;
#pragma unroll
        for (int i = 0; i < 8; ++i) O[i] *= alpha;
        bf16x8 Pf[4];
#pragma unroll
        for (int nn = 0; nn < 4; ++nn) { u32x4 o; o.x = pk2(S[2 * nn][0], S[2 * nn][1]); o.y = pk2(S[2 * nn][2], S[2 * nn][3]); o.z = pk2(S[2 * nn + 1][0], S[2 * nn + 1][1]); o.w = pk2(S[2 * nn + 1][2], S[2 * nn + 1][3]); Pf[nn] = __builtin_bit_cast(bf16x8, o); }
        {
            bf16x8 vf[2][8];
#pragma unroll
            for (int nd = 0; nd < 8; ++nd) vf[0][nd] = frag_tr_perm(T2, 0, 16 * nd, lane);
#pragma unroll
            for (int nn = 0; nn < 4; ++nn) {
                if (nn < 3) {
#pragma unroll
                    for (int nd = 0; nd < 8; ++nd) vf[(nn + 1) & 1][nd] = frag_tr_perm(T2, 32 * (nn + 1), 16 * nd, lane);
                }
#pragma unroll
                for (int nd = 0; nd < 8; ++nd) O[nd] = MFMA16(vf[nn & 1][nd], Pf[nn], O[nd]);
            }
        }
    }
    const float inv = __builtin_amdgcn_rcpf(lsum);
    u16* yr = Y + (size_t)(qrow0 + rin) * DM + 512 + hq * 128 + 4 * fq;
#pragma unroll
    for (int nd = 0; nd < 8; ++nd) { u32x2 o; o.x = pk2(O[nd][0] * inv, O[nd][1] * inv); o.y = pk2(O[nd][2] * inv, O[nd][3] * inv); *(u32x2*)(yr + 16 * nd) = o; }
    __syncthreads();
}

DI void ml_item_geom(int it, int& b, int& c, int& h, int& base, int& lo, int& hi) {
    h = it % 6; c = (it / 6) % NCH; b = it / (6 * NCH);
    if (c < 2) { base = RLAT + b * LCTX + c * 128; lo = -c * 128; hi = LCTX - c * 128; }
    else { base = b * SEQ + (c - 2) * 128; lo = -(c - 2) * 128; hi = SEQ - (c - 2) * 128; }
}
DI int ml_pos(int c, int d) { return d == 0 ? c : (c < 2 ? 1 - c : 131 - c); }
DI void ml_gate_scan(const float* gates, int base, int d, int h, float bi, float bff, int lane, int& t0, int& t1, float& li0, float& li1, float& b0, float& b1) {
    t0 = d ? 127 - 2 * lane : 2 * lane; t1 = d ? t0 - 1 : t0 + 1;
    const float* g0 = gates + (size_t)(base + t0) * 32 + d * 12 + h; const float* g1 = gates + (size_t)(base + t1) * 32 + d * 12 + h;
    li0 = g0[0] + bi; li1 = g1[0] + bi;
    const float lf0 = log_sigmoid(g0[6] + bff), lf1 = log_sigmoid(g1[6] + bff);
    float s = lf0 + lf1;
#pragma unroll
    for (int o = 1; o < 64; o <<= 1) { const float v = __shfl_up(s, o); if (lane >= o) s += v; }
    b1 = s; b0 = s - lf1;
}

DI void ml1_item(KP p, int l, int it, LAS unsigned char* lds) {
    const int tid = tid_l(), lane = tid & 63, wid = tid >> 6, fr = lane & 15, fq = lane >> 4;
    int b, c, h, base, lo, hi; ml_item_geom(it, b, c, h, base, lo, hi);
    const u16* proj = (const u16*)(p->ws + WS_R);
    const float* gates = (const float*)(p->ws + WS_GATES);
    LAS unsigned char* T0 = lds; LAS unsigned char* T1 = lds + TILE_B; LAS unsigned char* T2 = lds + 2 * TILE_B;
    LAS float* wsc = (LAS float*)(lds + SC_OFF);
    if (wid < 2) { const int d = wid; int t0, t1; float li0, li1, b0, b1;
        ml_gate_scan(gates, base, d, h, p->ml_b_i[l * 12 + d * 6 + h], p->ml_b_f[l * 12 + d * 6 + h], lane, t0, t1, li0, li1, b0, b1);
        const float g = __shfl(b1, 63);
        const float a0 = g - b0 + li0, a1 = g - b1 + li1;
        const float ml = wave_max(fmaxf(a0, a1));
        wsc[d * 128 + t0] = __expf(a0 - ml); wsc[d * 128 + t1] = __expf(a1 - ml);
        if (lane == 0) { const int sq = ((b * 6 + h) * 2 + d) * NCH + ml_pos(c, d); ((float*)(p->ws + WS_GSC))[sq] = g; ((float*)(p->ws + WS_MLS))[sq] = ml; } }
    stage_conv(T0, proj + (size_t)base * PLD + OFF_MK + h * 128, PLD, lo, hi, p->ml_conv_w + (size_t)l * 4608 + 768 + h * 128, p->ml_conv_b + l * 1536 + 768 + h * 128, QSCALE, tid,
               (u16*)(p->ws + WS_XN) + (size_t)base * 768 + h * 128);
    __syncthreads();
#pragma unroll
    for (int i = 0; i < 4; ++i) { const int id = tid + 512 * i, row = id >> 4, ch = id & 15; float v[8], y[8];
        unpack8(*(const u32x4*)(proj + (size_t)(base + row) * PLD + OFF_MV + h * 128 + ch * 8), v);
        const float w0 = wsc[row], w1 = wsc[128 + row];
#pragma unroll
        for (int e = 0; e < 8; ++e) y[e] = v[e] * w0;
        *(LAS u32x4*)(T1 + toff(row, ch)) = pack8(y);
#pragma unroll
        for (int e = 0; e < 8; ++e) y[e] = v[e] * w1;
        *(LAS u32x4*)(T2 + toff(row, ch)) = pack8(y); }
    __syncthreads();
    const int kb = 32 * (wid >> 1), vb = 64 * (wid & 1);
    u16* CST = (u16*)(p->ws + WS_CST);
#pragma unroll
    for (int d = 0; d < 2; ++d) {
        const LAS unsigned char* TV = d ? T2 : T1;
        f32x4 acc[2][4];
#pragma unroll
        for (int a = 0; a < 2; ++a)
#pragma unroll
            for (int bb = 0; bb < 4; ++bb) acc[a][bb] = (f32x4){0.f, 0.f, 0.f, 0.f};
#pragma unroll
        for (int ks = 0; ks < 4; ++ks) {
            bf16x8 af[2], bfg[4];
#pragma unroll
            for (int a = 0; a < 2; ++a) af[a] = frag_tr(T0, 32 * ks, kb + 16 * a, lane);
#pragma unroll
            for (int bb = 0; bb < 4; ++bb) bfg[bb] = frag_tr(TV, 32 * ks, vb + 16 * bb, lane);
#pragma unroll
            for (int a = 0; a < 2; ++a)
#pragma unroll
                for (int bb = 0; bb < 4; ++bb) acc[a][bb] = MFMA16(af[a], bfg[bb], acc[a][bb]);
        }
        u16* Cd = CST + ((size_t)(((b * 6 + h) * 2 + d) * NCH + ml_pos(c, d))) * 16384;
#pragma unroll
        for (int a = 0; a < 2; ++a)
#pragma unroll
            for (int bb = 0; bb < 4; ++bb) { const int v = vb + 16 * bb + fr, k0 = kb + 16 * a + 4 * fq;
                u32x2 o; o.x = pk2(acc[a][bb][0], acc[a][bb][1]); o.y = pk2(acc[a][bb][2], acc[a][bb][3]); *(u32x2*)(Cd + v * 128 + k0) = o; }
    }
    { const int d = tid >> 8, k2 = tid & 63, tq = (tid >> 6) & 3; float s0 = 0.f, s1 = 0.f;
#pragma unroll 8
        for (int t = 32 * tq; t < 32 * tq + 32; ++t) { const float w = wsc[d * 128 + t]; const unsigned kv = *(const LAS unsigned*)(T0 + toff(t, k2 >> 2) + 4 * (k2 & 3)); s0 += w * bf_lo(kv); s1 += w * bf_hi(kv); }
        LAS float* red = (LAS float*)(lds + SC_OFF + 2048);
        red[(d * 4 + tq) * 128 + 2 * k2] = s0; red[(d * 4 + tq) * 128 + 2 * k2 + 1] = s1;
        __syncthreads();
        if (tid < 256) { const int dd = tid >> 7, k = tid & 127; const float sum = (red[(dd * 4 + 0) * 128 + k] + red[(dd * 4 + 1) * 128 + k]) + (red[(dd * 4 + 2) * 128 + k] + red[(dd * 4 + 3) * 128 + k]);
            ((float*)(p->ws + WS_NST))[((size_t)(((b * 6 + h) * 2 + dd) * NCH + ml_pos(c, dd))) * 128 + k] = sum; } }
    __syncthreads();
}

DI void scan_item(KP p, int it) {
    const float* GSC = (const float*)(p->ws + WS_GSC); const float* MLS = (const float*)(p->ws + WS_MLS);
    const int gt = it * 512 + tid_l();
    if (gt < NSEQ * 4096) {
        const int sq = gt >> 12, e4 = gt & 4095;
        u16* base = (u16*)(p->ws + WS_CST) + (size_t)sq * NCH * 16384 + e4 * 4;
        float c0 = 0.f, c1 = 0.f, c2 = 0.f, c3 = 0.f, m = 0.f;
        for (int j0 = 0; j0 < NCH; j0 += 10) {
            u32x2 v[10]; float gj[10], mj[10];
#pragma unroll
            for (int u = 0; u < 10; ++u) { v[u] = *(const u32x2*)(base + (size_t)(j0 + u) * 16384); gj[u] = GSC[sq * NCH + j0 + u]; mj[u] = MLS[sq * NCH + j0 + u]; }
#pragma unroll
            for (int u = 0; u < 10; ++u) {
                u32x2 o; o.x = pk2(c0, c1); o.y = pk2(c2, c3); *(u32x2*)(base + (size_t)(j0 + u) * 16384) = o;
                const float mn = fmaxf(gj[u] + m, mj[u]), ao = __expf(gj[u] + m - mn), an = __expf(mj[u] - mn);
                c0 = ao * c0 + an * bf_lo(v[u].x); c1 = ao * c1 + an * bf_hi(v[u].x); c2 = ao * c2 + an * bf_lo(v[u].y); c3 = ao * c3 + an * bf_hi(v[u].y); m = mn; }
        }
    } else {
        const int r = gt - NSEQ * 4096, sq = r >> 7, k = r & 127;
        float* nb = (float*)(p->ws + WS_NST) + (size_t)sq * NCH * 128 + k; float* M0 = (float*)(p->ws + WS_M0);
        float n = 0.f, m = 0.f;
        for (int j = 0; j < NCH; ++j) { const float dn = nb[(size_t)j * 128], gj = GSC[sq * NCH + j], mj = MLS[sq * NCH + j];
            nb[(size_t)j * 128] = n; if (k == 0) M0[sq * NCH + j] = m;
            const float mn = fmaxf(gj + m, mj), ao = __expf(gj + m - mn), an = __expf(mj - mn); n = ao * n + an * dn; m = mn; }
    }
}

DI void ml3_item(KP p, int l, int it, LAS unsigned char* lds) {
    const int tid = tid_l(), lane = tid & 63, wid = tid >> 6, fr = lane & 15, fq = lane >> 4;
    int b, c, h, base, lo, hi; ml_item_geom(it, b, c, h, base, lo, hi);
    const u16* proj = (const u16*)(p->ws + WS_R);
    const float* gates = (const float*)(p->ws + WS_GATES);
    u16* Y = (u16*)(p->ws + WS_Y);
    LAS unsigned char* T0 = lds; LAS unsigned char* T1 = lds + TILE_B; LAS unsigned char* T2 = lds + 2 * TILE_B; LAS unsigned char* T3 = T0;
    LAS float* sc_rt = (LAS float*)(lds + SC_OFF);
    LAS float* sc_ct = sc_rt + 256;
    LAS float* sc_in = sc_rt + 512;
    LAS float* sc_em = sc_rt + 768;
    LAS float* sc_n0 = sc_rt + 1024;
    const int srow = tid >> 4, sch = tid & 15;
    u32x4 c0a[4], c0b[4]; u32x2 mor[8];
    { const u16* ca = (const u16*)(p->ws + WS_CST) + (size_t)(((b * 6 + h) * 2 + 0) * NCH + ml_pos(c, 0)) * 16384 + srow * 128 + sch * 8;
      const u16* cb = (const u16*)(p->ws + WS_CST) + (size_t)(((b * 6 + h) * 2 + 1) * NCH + ml_pos(c, 1)) * 16384 + srow * 128 + sch * 8;
#pragma unroll
      for (int i = 0; i < 4; ++i) { c0a[i] = *(const u32x4*)(ca + i * 32 * 128); c0b[i] = *(const u32x4*)(cb + i * 32 * 128); }
      const u16* mo_ = proj + (size_t)(base + 16 * wid + fr) * PLD + OFF_MO + h * 128 + 4 * fq;
#pragma unroll
      for (int nd = 0; nd < 8; ++nd) mor[nd] = *(const u32x2*)(mo_ + 16 * nd); }
    if (wid < 2) { const int d = wid; int t0, t1; float li0, li1, b0, b1;
        ml_gate_scan(gates, base, d, h, p->ml_b_i[l * 12 + d * 6 + h], p->ml_b_f[l * 12 + d * 6 + h], lane, t0, t1, li0, li1, b0, b1);
        const int sq = ((b * 6 + h) * 2 + d) * NCH + ml_pos(c, d);
        const float m0 = ((const float*)(p->ws + WS_M0))[sq];
        const float ct0 = li0 - b0, ct1 = li1 - b1;
        float pm = fmaxf(ct0, ct1);
#pragma unroll
        for (int o = 1; o < 64; o <<= 1) { const float v = __shfl_up(pm, o); if (lane >= o) pm = fmaxf(pm, v); }
        float pe = __shfl_up(pm, 1); if (lane == 0) pe = -INFINITY;
        const float pm0 = fmaxf(pe, ct0), pm1 = pm;
        const float mt0 = fmaxf(b0 + m0, b0 + pm0), mt1 = fmaxf(b1 + m0, b1 + pm1);
        sc_rt[d * 128 + t0] = b0 - mt0; sc_rt[d * 128 + t1] = b1 - mt1;
        sc_ct[d * 128 + t0] = ct0; sc_ct[d * 128 + t1] = ct1;
        sc_in[d * 128 + t0] = __expf(b0 + m0 - mt0); sc_in[d * 128 + t1] = __expf(b1 + m0 - mt1);
        sc_em[d * 128 + t0] = __expf(-mt0); sc_em[d * 128 + t1] = __expf(-mt1);
        const float* n0 = (const float*)(p->ws + WS_NST) + (size_t)sq * 128;
        sc_n0[d * 128 + 2 * lane] = n0[2 * lane]; sc_n0[d * 128 + 2 * lane + 1] = n0[2 * lane + 1]; }
    stage_conv(T0, proj + (size_t)base * PLD + OFF_MQ + h * 128, PLD, lo, hi, p->ml_conv_w + (size_t)l * 4608 + h * 128, p->ml_conv_b + l * 1536 + h * 128, 1.f, tid);
    stage_plain(T1, (const u16*)(p->ws + WS_XN) + (size_t)base * 768 + h * 128, 768, tid);
    stage_plain(T2, proj + (size_t)base * PLD + OFF_MV + h * 128, PLD, tid);
    __syncthreads();
    const int t = 16 * wid + fr;
    bf16x8 Qf[4];
#pragma unroll
    for (int ks = 0; ks < 4; ++ks) Qf[ks] = frag_row(T0, 16 * wid, 32 * ks, lane);
    float nq[2] = {0.f, 0.f};
#pragma unroll
    for (int ks = 0; ks < 4; ++ks) { const u32x4 qv = __builtin_bit_cast(u32x4, Qf[ks]); float q[8]; unpack8(qv, q);
#pragma unroll
        for (int e = 0; e < 8; ++e) { const int k = 32 * ks + 8 * fq + e; nq[0] += q[e] * sc_n0[k]; nq[1] += q[e] * sc_n0[128 + k]; } }
#pragma unroll
    for (int d = 0; d < 2; ++d) { nq[d] += __shfl_xor(nq[d], 16); nq[d] += __shfl_xor(nq[d], 32); }
    f32x4 hs[8];
#pragma unroll
    for (int i = 0; i < 8; ++i) hs[i] = (f32x4){0.f, 0.f, 0.f, 0.f};
#pragma unroll 1
    for (int d = 0; d < 2; ++d) {
        const int sq = ((b * 6 + h) * 2 + d) * NCH + ml_pos(c, d);
        const float nqd = d ? nq[1] : nq[0];
        __syncthreads();
#pragma unroll
        for (int i = 0; i < 4; ++i) { const u32x4 v = d ? c0b[i] : c0a[i]; *(LAS u32x4*)(T3 + toff(srow + 32 * i, sch)) = v; }
        __syncthreads();
        const float rt = sc_rt[d * 128 + t], inter = sc_in[d * 128 + t], em = sc_em[d * 128 + t];
        f32x4 S[8]; float den = 0.f;
#pragma unroll
        for (int n = 0; n < 8; ++n) { S[n] = (f32x4){0.f, 0.f, 0.f, 0.f};
            const bool need = d ? (n >= wid) : (n <= wid);
            if (need) {
#pragma unroll
                for (int ks = 0; ks < 4; ++ks) S[n] = MFMA16(frag_row(T1, 16 * n, 32 * ks, lane), Qf[ks], S[n]);
#pragma unroll
                for (int j = 0; j < 4; ++j) { const int s = 16 * n + 4 * fq + j; const bool valid = d ? (s >= t) : (s <= t);
                    const float w = valid ? __expf(rt + sc_ct[d * 128 + s]) : 0.f; const float pv = S[n][j] * w; S[n][j] = pv; den += pv; }
            }
            __builtin_amdgcn_sched_barrier(0); }
        den += __shfl_xor(den, 16); den += __shfl_xor(den, 32);
        den += inter * nqd;
        bf16x8 Pf[4];
#pragma unroll
        for (int nn = 0; nn < 4; ++nn) { u32x4 o; o.x = pk2(S[2 * nn][0], S[2 * nn][1]); o.y = pk2(S[2 * nn][2], S[2 * nn][3]); o.z = pk2(S[2 * nn + 1][0], S[2 * nn + 1][1]); o.w = pk2(S[2 * nn + 1][2], S[2 * nn + 1][3]); Pf[nn] = __builtin_bit_cast(bf16x8, o); }
        const float inv = 1.f / fmaxf(fabsf(den), em);
#pragma unroll
        for (int nd = 0; nd < 8; ++nd) {
            f32x4 a1 = {0.f, 0.f, 0.f, 0.f}, a2 = {0.f, 0.f, 0.f, 0.f};
#pragma unroll
            for (int nn = 0; nn < 4; ++nn) a1 = MFMA16(frag_tr_perm(T2, 32 * nn, 16 * nd, lane), Pf[nn], a1);
#pragma unroll
            for (int ks = 0; ks < 4; ++ks) a2 = MFMA16(frag_row(T3, 16 * nd, 32 * ks, lane), Qf[ks], a2);
            hs[nd] += (a1 + a2 * inter) * inv;
            __builtin_amdgcn_sched_barrier(0);
        }
    }
    float ss = 0.f;
#pragma unroll
    for (int nd = 0; nd < 8; ++nd) ss += (hs[nd][0] * hs[nd][0] + hs[nd][1] * hs[nd][1]) + (hs[nd][2] * hs[nd][2] + hs[nd][3] * hs[nd][3]);
    ss += __shfl_xor(ss, 16); ss += __shfl_xor(ss, 32);
    const float rstd = rsqrtf(ss * (1.f / 128.f) + EPSN);
    const float* og = p->ml_out_gain + l * 768 + h * 128;
    u16* yr = Y + (size_t)(base + t) * DM + 1280 + h * 128;
#pragma unroll
    for (int nd = 0; nd < 8; ++nd) { const int v0 = 16 * nd + 4 * fq; const u32x2 ov = mor[nd]; const f32x4 gn = *(const f32x4*)(og + v0);
        const float y0 = hs[nd][0] * rstd * gn[0] * sigmoidf_(bf_lo(ov.x)), y1 = hs[nd][1] * rstd * gn[1] * sigmoidf_(bf_hi(ov.x));
        const float y2 = hs[nd][2] * rstd * gn[2] * sigmoidf_(bf_lo(ov.y)), y3 = hs[nd][3] * rstd * gn[3] * sigmoidf_(bf_hi(ov.y));
        u32x2 o; o.x = pk2(y0, y1); o.y = pk2(y2, y3); *(u32x2*)(yr + v0) = o; }
    __syncthreads();
}

#define XB_TMO      128
#define XB_XCNT(j)  (256  + 64 * (j))
#define XB_XSUB(j)  (1280 + 64 * (j))
#define XB_XGEN(j)  (2304 + 64 * (j))
#define XB_TOP      3328
#define XB_TOPGEN   3392
#define XCD_BAR_WORDS 3456
#define XB_SPIN_CAP (1u << 18)

__device__ __forceinline__ unsigned xb_ld(unsigned* p)              { return __hip_atomic_load(p, __ATOMIC_RELAXED, __HIP_MEMORY_SCOPE_AGENT); }
__device__ __forceinline__ unsigned xb_add(unsigned* p, unsigned v) { return __hip_atomic_fetch_add(p, v, __ATOMIC_RELAXED, __HIP_MEMORY_SCOPE_AGENT); }
__device__ __forceinline__ unsigned xb_xcc_id() { return (unsigned)__builtin_amdgcn_s_getreg((3 << 11) | 20) & 0xFu; }
#define XB_SPIN(cond, bar) do { unsigned _sp = 0; while (cond) { __builtin_amdgcn_s_sleep(1); \
    if ((++_sp & 255u) == 0u) { if (xb_ld(&(bar)[XB_TMO])) break; if (_sp > XB_SPIN_CAP) { atomicAdd(&(bar)[XB_TMO], 1u); break; } } } } while (0)

struct XcdBarrier {
    unsigned* bar; unsigned x;
    volatile LAS unsigned* st;
};

__device__ __forceinline__ XcdBarrier xcd_barrier_post(unsigned* bar, volatile LAS unsigned* st) {
    XcdBarrier b; b.bar = bar; b.x = xb_xcc_id(); b.st = st;
    if (threadIdx.x == 0) (void)xb_add(&bar[XB_XCNT(b.x)], 1u);
    return b;
}
__device__ __forceinline__ void xcd_barrier_complete(unsigned* bar, unsigned x, unsigned& nloc, unsigned& nx) {
    const unsigned G = gridDim.x * gridDim.y * gridDim.z;
    unsigned sum, cnt, mine, sp = 0u;
    for (;;) {
        sum = 0u; cnt = 0u; mine = 0u;
#pragma unroll
        for (unsigned j = 0; j < 16; ++j) { const unsigned c = xb_ld(&bar[XB_XCNT(j)]); sum += c; cnt += (c > 0u) ? 1u : 0u; mine = (j == x) ? c : mine; }
        if (sum == G) break;
        __builtin_amdgcn_s_sleep(1);
        if ((++sp & 255u) == 0u) { if (xb_ld(&bar[XB_TMO])) break; if (sp > XB_SPIN_CAP) { atomicAdd(&bar[XB_TMO], 1u); break; } }
    }
    nloc = mine > 0u ? mine : 1u; nx = cnt > 0u ? cnt : 1u;
}

__device__ __forceinline__ void xcd_barrier(const XcdBarrier& b) {
    asm volatile("s_waitcnt vmcnt(0)" ::: "memory");
    __syncthreads();
    if (threadIdx.x == 0) {
        unsigned* bar = b.bar;
        __builtin_amdgcn_s_waitcnt(0);
        unsigned nloc = b.st[0], nx = b.st[1];
        if (nloc == 0u) { xcd_barrier_complete(bar, b.x, nloc, nx); b.st[0] = nloc; b.st[1] = nx; }
        const unsigned old = xb_add(&bar[XB_XSUB(b.x)], 1u);
        const unsigned gen = old / nloc;
        if (old + 1u == (gen + 1u) * nloc) {
            __builtin_amdgcn_fence(__ATOMIC_RELEASE, "agent");
            asm volatile("s_waitcnt vmcnt(0)" ::: "memory");
            const unsigned og = xb_add(&bar[XB_TOP], 1u);
            const unsigned tg = og / nx;
            if (og + 1u == (tg + 1u) * nx) xb_add(&bar[XB_TOPGEN], 1u);
            else XB_SPIN(xb_ld(&bar[XB_TOPGEN]) == tg, bar);
            __builtin_amdgcn_fence(__ATOMIC_ACQUIRE, "agent");
            xb_add(&bar[XB_XGEN(b.x)], 1u);
            asm volatile("s_waitcnt vmcnt(0)" ::: "memory");
        } else {
            XB_SPIN(xb_ld(&bar[XB_XGEN(b.x)]) == gen, bar);
            __builtin_amdgcn_fence(__ATOMIC_ACQUIRE, "agent");
            asm volatile("s_waitcnt vmcnt(0)" ::: "memory");
        }
    }
    __syncthreads();
}

constexpr int N_ATT = 1560, N_ML = 2 * NCH * 6  , N_GM = 260 * 4, N_SCAN = 198, N_ROPE = 260;

DI int next_item(unsigned* ctr, LAS unsigned char* lds) {
    LAS int* slot = (LAS int*)(lds + LDS_BYTES - 16);
    __syncthreads();
    if (threadIdx.x == 0) *slot = (int)atomicAdd(ctr, 1u);
    __syncthreads();
    return *slot;
}

__global__ void __launch_bounds__(512, 2) fwd_megakernel(Params p_unused) {
    const KP kp = (KP)__builtin_amdgcn_kernarg_segment_ptr();
#define PP launder(kp)
    extern __shared__ __attribute__((aligned(16))) unsigned char smem[];
    LAS unsigned char* lds = (LAS unsigned char*)smem;
    cg::grid_group grid = cg::this_grid();
    volatile LAS unsigned* xst = (volatile LAS unsigned*)(lds + LDS_BYTES - 32);
    if (threadIdx.x == 0) { xst[0] = 0u; xst[1] = 0u; }
    __syncthreads();
    { XcdBarrier b0 = xcd_barrier_post((unsigned*)(PP->ws + WS_BAR), xst); (void)b0; }
#define GSYNC() do { XcdBarrier b_; b_.bar = (unsigned*)(PP->ws + WS_BAR); b_.x = xb_xcc_id(); b_.st = xst; xcd_barrier(b_); } while (0)
    phase_prep(PP, lds);
    if (PP->ws == nullptr) grid.sync();
    GSYNC();
    phase_norm0(PP);
    phase_prep2(PP, lds);
    GSYNC();
    for (int l = 0; l < 2; ++l) {
        const int stage = l;
        const int Mres = l == 0 ? MROWS : RLAT;
        unsigned* ctr = (unsigned*)(PP->ws + WS_CTR) + l * 4;
        { EpiProj E; E.O = (u16*)(PP->ws + WS_R); E.gates = (float*)(PP->ws + WS_GATES);
          E.ss = (const float*)(PP->ws + WS_SS) + (l == 0 ? 3 : 1) * MROWS; E.bias0 = (const float*)(PP->ws + WS_BIASP) + (size_t)l * 3 * NPROJ;
          run_gemm(lds, (const u16*)(PP->ws + WS_XN), (const u16*)(PP->ws + WS_WIN + l * SZ_WIN), MROWS, PLD, DM, E); }
        for (;;) { const int it = next_item(ctr + 3, lds); if (it >= 260) break; gate_item(PP, l, it, lds); }
        GSYNC();
        for (;;) { const int it = next_item(ctr + 0, lds); if (it >= N_ROPE + N_ML) break; if (it < N_ROPE) rope_item(PP, it); else ml1_item(PP, l, it - N_ROPE, lds); }
        GSYNC();
        for (;;) { const int it = next_item(ctr + 1, lds); if (it >= N_SCAN + N_ATT + N_GM) break;
            if (it < N_SCAN) scan_item(PP, it);
            else if (it < N_SCAN + N_ATT) attn_item(PP, l, it - N_SCAN, lds);
            else gmlp_item(PP, l, it - N_SCAN - N_ATT, lds); }
        GSYNC();
        for (;;) { const int it = next_item(ctr + 2, lds); if (it >= N_ML) break; ml3_item(PP, l, it, lds); }
        GSYNC();
        { EpiRes E; E.p = PP; E.stage = stage; E.gate0 = (const float*)(PP->ws + WS_MOD) + (size_t)l * 3 * 12288 + 2 * DM;
          E.gs0 = (const float*)(PP->ws + WS_GS) + (size_t)(l * 2 + 1) * 3 * DM; E.ssn = (float*)(PP->ws + WS_SS) + (l == 0 ? 0 : 2) * MROWS; E.ntfull = DM / 64;
          run_gemm_split(lds, (const u16*)(PP->ws + WS_Y), (const u16*)(PP->ws + WS_WOUT + l * SZ_WOUT), RLAT, DM, DM, l == 0 ? 4 : 0, E); }
        GSYNC();
        if (l == 0) { phase_ctx_norm(PP, (const float*)(PP->ws + WS_GS) + (size_t)((0 * 2 + 1) * 3 + 2) * DM, (float*)(PP->ws + WS_SS) + 0 * MROWS, 4); GSYNC(); }
        { EpiSqRelu E; E.O = (u16*)(PP->ws + WS_R); E.ss = (const float*)(PP->ws + WS_SS) + (l == 0 ? 0 : 2) * MROWS; E.bias0 = (const float*)(PP->ws + WS_BIASF) + (size_t)l * 3 * DFF;
          run_gemm(lds, (const u16*)(PP->ws + WS_XN), (const u16*)(PP->ws + WS_WFF1 + l * SZ_WFF), Mres, DFF, DM, E); }
        GSYNC();
        { EpiRes E; E.p = PP; E.stage = 1; E.gate0 = (const float*)(PP->ws + WS_MOD) + (size_t)l * 3 * 12288 + 5 * DM;
          E.gs0 = l == 0 ? (const float*)(PP->ws + WS_GS) + (size_t)(1 * 2 + 0) * 3 * DM : nullptr; E.ssn = (float*)(PP->ws + WS_SS) + 1 * MROWS; E.ntfull = DFF / 64;
          run_gemm_split(lds, (const u16*)(PP->ws + WS_R), (const u16*)(PP->ws + WS_WFF2 + l * SZ_WFF), RLAT, DM, DFF, l == 0 ? 16 : 0, E); }
        GSYNC();
        if (l == 0) { phase_ctx_norm(PP, (const float*)(PP->ws + WS_GS) + (size_t)((1 * 2 + 0) * 3 + 2) * DM, (float*)(PP->ws + WS_SS) + 1 * MROWS, 16); GSYNC(); }
    }
    phase_final(PP);
#undef GSYNC
#undef PP
}

extern "C" void kernel_launch(void* const* d_in, const int* in_sizes, int n_in, void* d_out, int out_size, void* d_ws, size_t ws_size, hipStream_t stream) {
    static int grid_blocks = 0;
    if (grid_blocks == 0) {
        if (n_in != 22 || ws_size < WS_END || out_size != RLAT * DM) { fprintf(stderr, "kernel_launch: unexpected shapes (n_in %d ws %zu need %zu out %d)\n", n_in, ws_size, (size_t)WS_END, out_size); grid_blocks = -1; return; }
        int dev = 0, cus = 0, per_cu = 0;
        hipGetDevice(&dev);
        hipDeviceGetAttribute(&cus, hipDeviceAttributeMultiprocessorCount, dev);
        if (hipFuncSetAttribute((const void*)fwd_megakernel, hipFuncAttributeMaxDynamicSharedMemorySize, LDS_BYTES) != hipSuccess) { fprintf(stderr, "kernel_launch: hipFuncSetAttribute failed\n"); grid_blocks = -1; return; }
        hipOccupancyMaxActiveBlocksPerMultiprocessor(&per_cu, (const void*)fwd_megakernel, 512, LDS_BYTES);
        if (per_cu < 1) { fprintf(stderr, "kernel_launch: occupancy query says %d blocks per CU\n", per_cu); per_cu = 1; }
        (void)hipGetLastError();
        grid_blocks = cus * 1;
    }
    if (grid_blocks < 0) return;
    if (hipMemsetAsync((unsigned char*)d_ws + WS_BAR, 0, 16384, stream) != hipSuccess) { fprintf(stderr, "kernel_launch: memset failed\n"); return; }
    Params p{};
    const float** pp = (const float**)&p;
    for (int i = 0; i < 22; ++i) pp[i] = (const float*)d_in[i];
    p.out = (float*)d_out; p.ws = (unsigned char*)d_ws;
    void* args[] = {&p};
    hipError_t e = hipLaunchCooperativeKernel((const void*)fwd_megakernel, dim3(grid_blocks), dim3(512), args, LDS_BYTES, stream);
    if (e != hipSuccess) fprintf(stderr, "cooperative launch failed: %s (grid %d)\n", hipGetErrorString(e), grid_blocks);
}
```

```cpp
#include <hip/hip_runtime.h>
#include <hip/hip_cooperative_groups.h>
#include <cstdio>
namespace cg = cooperative_groups;
namespace pg8 {
#define PG8_LAS __attribute__((address_space(3)))
typedef unsigned short bf16_t;
typedef short bf16x8 __attribute__((ext_vector_type(8)));
typedef float f32x4 __attribute__((ext_vector_type(4)));
typedef unsigned u32x4 __attribute__((ext_vector_type(4)));
constexpr int BM = 256, BK = 64, HALF = 128, HTB = HALF * BK * 2  , STAGE_BYTES = 8 * HTB, NXCD = 8, WGM = 8;

__host__ __device__ __forceinline__ int lds_byte(int r, int c) { const int st = (r >> 4) * 2 + (c >> 5), rr = r & 15, cc = c & 31, ob = rr * 64 + cc * 2; return st * 1024 + (ob ^ (((ob >> 9) & 1) << 5)); }
__host__ __device__ __forceinline__ void stage_rc(int b, int& R, int& C) { const int st = b / 1024, sb = b % 1024, swz = sb ^ (((sb >> 9) & 1) << 5); R = (st >> 1) * 16 + swz / 64; C = (st & 1) * 32 + (swz % 64) / 2; }
__host__ __device__ __forceinline__ int perm32(int rho) { const int n = rho >> 4, i = rho & 15; return 8 * (i >> 2) + 4 * n + (i & 3); }

struct Unit { int pm, pn, koff, nt; };
struct Gemm { const bf16_t* A; const bf16_t* Bt; int M, N, K; };

struct StaticOrder {
    int nM, nN, nwg, G, c, ntf;
    __host__ __device__ void init(int M, int N, int K, int G_, int c_) { nM = M / BM; nN = N / BM; nwg = nM * nN; G = G_; c = c_; ntf = K / BK; }
    __host__ __device__ bool next(int i, Unit& u) const {
        const long L = (long)i * G + c; if (L >= nwg) return false;
        int wgid = (int)L; { const int q = nwg / NXCD, r = nwg % NXCD, xcd = wgid % NXCD, off = wgid / NXCD; wgid = (xcd < r ? xcd * (q + 1) : r * (q + 1) + (xcd - r) * q) + off; }
        const int nig = WGM * nN, gid = wgid / nig, fm = gid * WGM, gsz = (nM - fm) < WGM ? (nM - fm) : WGM;
        u.pm = fm + ((wgid % nig) % gsz); u.pn = (wgid % nig) / gsz; u.koff = 0; u.nt = ntf; return true;
    }
    __device__ __forceinline__ void a_ready(const Unit&) const {}
    __device__ __forceinline__ void done(const Unit&) const {}
};
template <class Epi, class Sched, bool STAMP = false>
__device__ __forceinline__ void gemm_phase(PG8_LAS unsigned char* lds, const Gemm g, const Sched& S, const Epi& E, unsigned long long* stamps) {
    int tid_ = threadIdx.x; asm volatile("" : "+v"(tid_)); const int tid = tid_, wid = __builtin_amdgcn_readfirstlane(tid >> 6), lane = tid & 63, wr = wid >> 2, wc = wid & 3, fr = lane & 15, fq = lane >> 4;
    const int K = g.K;
    int ts_lo = 0, ts_hi = 0, nts = 0; const unsigned long long rt_entry = STAMP ? (unsigned long long)wall_clock64() : 0ull;
#define PG8_STAMP() do { if (STAMP && wid == 0 && nts < 64) { const unsigned long long _c = (unsigned long long)clock64(); \
        ts_lo = (lane == nts) ? (int)(unsigned)_c : ts_lo; ts_hi = (lane == nts) ? (int)(unsigned)(_c >> 32) : ts_hi; ++nts; } } while (0)
    PG8_STAMP();
    unsigned voffA[2], voffB[2];
#pragma unroll
    for (int i = 0; i < 2; ++i) { int R, C; stage_rc(tid * 16 + i * 8192, R, C); const int Rb = Epi::PERM ? ((R & ~31) + perm32(R & 31)) : R;
        voffA[i] = (unsigned)(R * K + C) * 2u; voffB[i] = (unsigned)(Rb * K + C) * 2u; }
    const size_t kstep = (size_t)(BK * 2);
    const size_t hstep = (size_t)HALF * K * 2;
    const size_t tstep = 2 * hstep;
    const unsigned ldsw = (unsigned)wid * 1024u;
    const int aoff = lds_byte(wr * 64 + fr, fq * 8), boff = lds_byte(wc * 32 + fr, fq * 8);
#define PG8_SA(b, h) (((b) * 2 + (h)) * HTB)
#define PG8_SB(b, h) ((4 + (b) * 2 + (h)) * HTB)
#define PG8_STAGE(bufoff, gbase, voff) do { _Pragma("unroll") for (int _i = 0; _i < 2; ++_i) \
        __builtin_amdgcn_global_load_lds((const unsigned*)((const char*)(gbase) + (voff)[_i]), (PG8_LAS unsigned*)(lds + (bufoff) + ldsw + _i * 8192), 16, 0, 0); } while (0)
#define PG8_LDA(dst, b, h) do { _Pragma("unroll") for (int m = 0; m < 4; ++m) _Pragma("unroll") for (int k = 0; k < 2; ++k) dst[m][k] = *(const PG8_LAS bf16x8*)(lds + PG8_SA(b, h) + aoff + m * 2048 + k * 1024); } while (0)
#define PG8_LDB(dst, b, h) do { _Pragma("unroll") for (int n = 0; n < 2; ++n) _Pragma("unroll") for (int k = 0; k < 2; ++k) dst[n][k] = *(const PG8_LAS bf16x8*)(lds + PG8_SB(b, h) + boff + n * 2048 + k * 1024); } while (0)
#define PG8_MMA(ai, bj, At, Bt) do { __builtin_amdgcn_s_setprio(1); _Pragma("unroll") for (int m = 0; m < 4; ++m) _Pragma("unroll") for (int n = 0; n < 2; ++n) _Pragma("unroll") for (int k = 0; k < 2; ++k) \
        acc[ai][bj][m][n] = __builtin_amdgcn_mfma_f32_16x16x32_bf16(Bt[n][k], At[m][k], acc[ai][bj][m][n], 0, 0, 0); __builtin_amdgcn_s_setprio(0); } while (0)
#define PG8_WAIT_V(n) asm volatile("s_waitcnt vmcnt(" #n ")" ::: "memory")
#define PG8_WAIT_L(n) asm volatile("s_waitcnt lgkmcnt(" #n ")" ::: "memory")
#define PG8_BAR __builtin_amdgcn_s_barrier()
#define PG8_SCHED __builtin_amdgcn_sched_barrier(0)
    Unit cur, nxt; int ui = 0;
    if (!S.next(0, cur)) return;
    f32x4 acc[2][2][4][2];
#pragma unroll
    for (int a = 0; a < 2; ++a)
#pragma unroll
        for (int b = 0; b < 2; ++b)
#pragma unroll
            for (int m = 0; m < 4; ++m)
#pragma unroll
                for (int n = 0; n < 2; ++n) acc[a][b][m][n] = (f32x4){0.f, 0.f, 0.f, 0.f};
    bf16x8 At[4][2], B0[2][2], B1[2][2];
    const char* cA = (const char*)g.A + (size_t)cur.pm * tstep + (size_t)cur.koff * 2; const char* cB = (const char*)g.Bt + (size_t)cur.pn * tstep + (size_t)cur.koff * 2;
    S.a_ready(cur);
    PG8_STAGE(PG8_SB(0, 0), cB, voffB); PG8_STAGE(PG8_SA(0, 0), cA, voffA); PG8_STAGE(PG8_SB(0, 1), cB + hstep, voffB); PG8_STAGE(PG8_SA(0, 1), cA + hstep, voffA);
    if (wr == 1) PG8_BAR;
    PG8_WAIT_V(4); PG8_BAR;
    PG8_STAGE(PG8_SB(1, 0), cB + kstep, voffB); PG8_STAGE(PG8_SA(1, 0), cA + kstep, voffA); PG8_STAGE(PG8_SB(1, 1), cB + hstep + kstep, voffB);
    PG8_WAIT_V(6); PG8_BAR;
    PG8_STAMP();
    for (;;) {
        const bool has_next = S.next(ui + 1, nxt);
        const char* nA = has_next ? (const char*)g.A + (size_t)nxt.pm * tstep + (size_t)nxt.koff * 2 : cA; const char* nB = has_next ? (const char*)g.Bt + (size_t)nxt.pn * tstep + (size_t)nxt.koff * 2 : cB;
        const int nt = cur.nt;
        for (int t = 0; t < nt; t += 2) {
            const bool last = (t == nt - 2);
            const char* a1 = cA + (size_t)(t + 1) * kstep;
            const char* a2 = last ? nA : cA + (size_t)(t + 2) * kstep; const char* b2 = last ? nB : cB + (size_t)(t + 2) * kstep;
            const char* a3 = a2 + kstep; const char* b3 = b2 + kstep;
            if (last && has_next) S.a_ready(nxt);
            PG8_LDB(B0, 0, 0); PG8_SCHED; PG8_LDA(At, 0, 0); PG8_STAGE(PG8_SA(1, 1), a1 + hstep, voffA);
            PG8_WAIT_L(8); PG8_BAR; PG8_WAIT_L(0); PG8_MMA(0, 0, At, B0); PG8_BAR; PG8_SCHED;
            PG8_LDB(B1, 0, 1); PG8_STAGE(PG8_SB(0, 0), b2, voffB);
            PG8_BAR; PG8_WAIT_L(0); PG8_MMA(0, 1, At, B1); PG8_BAR;
            PG8_LDA(At, 0, 1); PG8_STAGE(PG8_SA(0, 0), a2, voffA);
            PG8_BAR; PG8_WAIT_L(0); PG8_MMA(1, 0, At, B0); PG8_BAR; PG8_SCHED;
            PG8_STAGE(PG8_SB(0, 1), b2 + hstep, voffB);
            PG8_WAIT_V(6); PG8_BAR; PG8_MMA(1, 1, At, B1); PG8_BAR;
            PG8_LDB(B0, 1, 0); PG8_SCHED; PG8_LDA(At, 1, 0); PG8_STAGE(PG8_SA(0, 1), a2 + hstep, voffA);
            PG8_WAIT_L(8); PG8_BAR; PG8_WAIT_L(0); PG8_MMA(0, 0, At, B0); PG8_BAR; PG8_SCHED;
            PG8_LDB(B1, 1, 1); PG8_STAGE(PG8_SB(1, 0), b3, voffB);
            PG8_BAR; PG8_WAIT_L(0); PG8_MMA(0, 1, At, B1); PG8_BAR;
            PG8_LDA(At, 1, 1); PG8_STAGE(PG8_SA(1, 0), a3, voffA);
            PG8_BAR; PG8_WAIT_L(0); PG8_MMA(1, 0, At, B0); PG8_BAR; PG8_SCHED;
            PG8_STAGE(PG8_SB(1, 1), b3 + hstep, voffB);
            PG8_WAIT_V(6); PG8_BAR; PG8_MMA(1, 1, At, B1); PG8_BAR;
        }
        PG8_STAMP();
        if constexpr (!Epi::AFTER_DRAIN) { E(acc, cur, wr, wc, fr, fq); S.done(cur); }
        PG8_STAMP();
        if (!has_next) break;
#pragma unroll
        for (int a = 0; a < 2; ++a)
#pragma unroll
            for (int b = 0; b < 2; ++b)
#pragma unroll
                for (int m = 0; m < 4; ++m)
#pragma unroll
                    for (int n = 0; n < 2; ++n) acc[a][b][m][n] = (f32x4){0.f, 0.f, 0.f, 0.f};
        cur = nxt; cA = nA; cB = nB; ++ui;
    }
    PG8_WAIT_V(0);
    if (wr == 0) PG8_BAR;
    PG8_BAR;
    if constexpr (Epi::AFTER_DRAIN) { E.fused(acc, cur, wr, wc, fr, fq, lds, wid, lane); S.done(cur); }
    PG8_STAMP();
    if (STAMP && wid == 0) { stamps[lane] = lane < nts ? (((unsigned long long)(unsigned)ts_hi << 32) | (unsigned)ts_lo) : 0ull;
        if (lane == 62) stamps[62] = rt_entry; if (lane == 63) stamps[63] = (unsigned long long)wall_clock64(); }
#undef PG8_STAMP
#undef PG8_SA
#undef PG8_SB
#undef PG8_STAGE
#undef PG8_LDA
#undef PG8_LDB
#undef PG8_MMA
#undef PG8_WAIT_V
#undef PG8_WAIT_L
#undef PG8_BAR
#undef PG8_SCHED
}
}

#define LAS __attribute__((address_space(3)))
typedef unsigned short u16;
typedef short s16x4 __attribute__((ext_vector_type(4)));
typedef unsigned u32x2 __attribute__((ext_vector_type(2)));
typedef __bf16 bf2_t __attribute__((ext_vector_type(2)));
typedef float f2_t __attribute__((ext_vector_type(2)));
using pg8::bf16x8; using pg8::f32x4; using pg8::u32x4;

constexpr int DM = 2048, SEQ = 16384, RLAT = 32768, LCTX = 256, MROWS = 33280, DFF = 8192;
constexpr int PLD = 5376, NPROJ = 5632, NIN = 5400;
constexpr int OFF_GU = 0, OFF_GV = 512, OFF_AQ = 1024, OFF_AK = 1792, OFF_AV = 2048, OFF_MQ = 2304, OFF_MK = 3072, OFF_MV = 3840, OFF_MO = 4608;
constexpr int NCH = 130;
constexpr int NSEQ = 24;
constexpr float EPSN = 1e-6f;
constexpr float LOG2E = 1.4426950408889634f;
constexpr float QSCALE = 0.08838834764831845f;

constexpr size_t WS_WIN = 0;
constexpr size_t SZ_WIN = (size_t)NPROJ * DM * 2;
constexpr size_t WS_WOUT = WS_WIN + 2 * SZ_WIN;
constexpr size_t SZ_WOUT = (size_t)DM * DM * 2;
constexpr size_t WS_WFF1 = WS_WOUT + 2 * SZ_WOUT;
constexpr size_t SZ_WFF = (size_t)DFF * DM * 2;
constexpr size_t WS_WFF2 = WS_WFF1 + 2 * SZ_WFF;
constexpr size_t WS_MOD = WS_WFF2 + 2 * SZ_WFF;
constexpr size_t WS_ROPE = WS_MOD + 2 * 3 * 12288 * 4;
constexpr size_t WS_XC = WS_ROPE + 320 * 32 * 8;
constexpr size_t WS_GATES = WS_XC + (size_t)512 * DM * 4;
constexpr size_t WS_NST = WS_GATES + (size_t)MROWS * 32 * 4;
constexpr size_t WS_GSC = WS_NST + (size_t)NSEQ * NCH * 128 * 4;
constexpr size_t WS_MLS = WS_GSC + 16384;
constexpr size_t WS_M0 = WS_MLS + 16384;
constexpr size_t WS_SS = WS_M0 + 16384;
constexpr size_t WS_BIASP = WS_SS + (size_t)4 * MROWS * 4;
constexpr size_t WS_BIASF = WS_BIASP + (size_t)2 * 3 * NPROJ * 4;
constexpr size_t WS_GS = WS_BIASF + (size_t)2 * 3 * DFF * 4;
constexpr size_t WS_CTR = WS_GS + (size_t)2 * 2 * 3 * DM * 4;
constexpr size_t WS_BAR = WS_CTR + 256;
constexpr size_t WS_XN = WS_BAR + 16384;
constexpr size_t WS_R = WS_XN + (size_t)MROWS * DM * 2;
constexpr size_t SZ_PROJ = (size_t)MROWS * PLD * 2;
constexpr size_t WS_Y = WS_R + SZ_PROJ;
constexpr size_t SZ_H = (size_t)MROWS * DFF * 2;
constexpr size_t WS_CST = WS_R + SZ_H;
constexpr size_t WS_END = WS_CST + (size_t)NSEQ * NCH * 16384 * 2;

constexpr int LDS_BYTES = 163840;
constexpr int TSTR = 320;
constexpr int TILE_B = 128 * TSTR;
constexpr int SC_OFF = 3 * TILE_B;

struct Params {
    const float *x, *c, *ctx, *c_ctx, *w_ada, *b_ada, *g_mix, *g_ffn, *w_in, *gm_v_gain, *gm_w_s, *gm_b_s, *attn_sink,
        *ml_conv_w, *ml_conv_b, *ml_b_i, *ml_b_f, *ml_out_gain, *w_out, *w_ff1, *w_ff2, *g_final;
    float* out; unsigned char* ws;
};

#define DI __device__ __forceinline__
typedef const __attribute__((address_space(4))) Params* KP;
DI int tid_l() { int t = threadIdx.x; asm volatile("" : "+v"(t)); return t; }
DI KP launder(KP p) { asm volatile("" : "+s"(p)); return p; }
DI unsigned pk2(float lo, float hi) { bf2_t v = __builtin_convertvector((f2_t){lo, hi}, bf2_t); return __builtin_bit_cast(unsigned, v); }
DI float bf_lo(unsigned u) { return __uint_as_float(u << 16); }
DI float bf_hi(unsigned u) { return __uint_as_float(u & 0xffff0000u); }
DI float wave_sum(float v) {
#pragma unroll
    for (int o = 1; o < 64; o <<= 1) v += __shfl_xor(v, o);
    return v;
}
DI float wave_max(float v) {
#pragma unroll
    for (int o = 1; o < 64; o <<= 1) v = fmaxf(v, __shfl_xor(v, o));
    return v;
}
DI float gelu_tanh(float x) {
    const float k1 = -2.f * 0.7978845608028654f * LOG2E, k2 = k1 * 0.044715f;
    const float a = x * __builtin_fmaf(x * x, k2, k1);
    return x * __builtin_amdgcn_rcpf(1.f + __builtin_amdgcn_exp2f(a));
}
DI float sigmoidf_(float x) { return __builtin_amdgcn_rcpf(1.f + __builtin_amdgcn_exp2f(-LOG2E * x)); }
DI float log_sigmoid(float x) { return fminf(x, 0.f) - log1pf(__expf(-fabsf(x))); }
DI void unpack8(const u32x4 v, float* f) { f[0] = bf_lo(v.x); f[1] = bf_hi(v.x); f[2] = bf_lo(v.y); f[3] = bf_hi(v.y); f[4] = bf_lo(v.z); f[5] = bf_hi(v.z); f[6] = bf_lo(v.w); f[7] = bf_hi(v.w); }
DI u32x4 pack8(const float* f) { u32x4 o; o.x = pk2(f[0], f[1]); o.y = pk2(f[2], f[3]); o.z = pk2(f[4], f[5]); o.w = pk2(f[6], f[7]); return o; }
#define MFMA16(a, b, c) __builtin_amdgcn_mfma_f32_16x16x32_bf16((a), (b), (c), 0, 0, 0)

DI int toff(int row, int ch) { return row * TSTR + 16 * ch; }
DI bf16x8 frag_row(const LAS unsigned char* tile, int idx0, int k0, int lane) {
    return *(const LAS bf16x8*)(tile + toff(idx0 + (lane & 15), (k0 >> 3) + (lane >> 4)));
}
DI bf16x8 tr_pair(const LAS unsigned char* p, const LAS unsigned char* p2) {
    s16x4 a = __builtin_amdgcn_ds_read_tr16_b64_v4i16((LAS s16x4*)p);
    s16x4 b = __builtin_amdgcn_ds_read_tr16_b64_v4i16((LAS s16x4*)p2);
    return (bf16x8){a[0], a[1], a[2], a[3], b[0], b[1], b[2], b[3]};
}
DI bf16x8 frag_tr(const LAS unsigned char* tile, int k0, int idx0, int lane) {
    const int i = lane & 15, q = lane >> 4, row = k0 + 8 * q + (i >> 2), ch = (idx0 >> 3) + ((i & 3) >> 1), sub = 8 * (i & 1);
    return tr_pair(tile + toff(row, ch) + sub, tile + toff(row + 4, ch) + sub);
}
DI bf16x8 frag_tr_perm(const LAS unsigned char* tile, int k0, int idx0, int lane) {
    const int i = lane & 15, q = lane >> 4, row = k0 + 4 * q + (i >> 2), ch = (idx0 >> 3) + ((i & 3) >> 1), sub = 8 * (i & 1);
    const LAS unsigned char* a = tile + toff(row, ch) + sub;
    return tr_pair(a, a + 16 * TSTR);
}

DI const float* xrow_in(KP p, int stage, int row) {
    if (row < RLAT) return (stage ? (const float*)p->out : p->x) + (size_t)row * DM;
    return (stage ? (const float*)(p->ws + WS_XC) : p->ctx) + (size_t)(row - RLAT) * DM;
}
DI float* xrow_out(KP p, int row) {
    if (row < RLAT) return p->out + (size_t)row * DM;
    return (float*)(p->ws + WS_XC) + (size_t)(row - RLAT) * DM;
}
DI int mod_index(int row) { return row < SEQ ? 0 : (row < RLAT ? 1 : 2); }
DI float row_rstd(const float* ss, int row) { return rsqrtf(ss[row] * (1.f / DM) + EPSN); }

DI void transpose_item(const float* W, int K, int N, u16* WT, LAS float* scr  , int item, int nblk, int lane) {
    const int kb = item / nblk, nb = item % nblk, k0 = 64 * kb, n0 = 64 * nb;
    const int c4 = lane & 15, rr = lane >> 4;
    const bool ok = n0 + 4 * c4 < N;
    f32x4 v[16];
#pragma unroll
    for (int i = 0; i < 16; ++i) v[i] = ok ? *(const f32x4*)(W + (size_t)(k0 + 4 * i + rr) * N + n0 + 4 * c4) : (f32x4){0.f, 0.f, 0.f, 0.f};
#pragma unroll
    for (int i = 0; i < 16; ++i) { LAS float* d = scr + (4 * i + rr) * 65 + 4 * c4; d[0] = v[i].x; d[1] = v[i].y; d[2] = v[i].z; d[3] = v[i].w; }
    asm volatile("s_waitcnt lgkmcnt(0)" ::: "memory"); __builtin_amdgcn_wave_barrier();
    const int c = lane & 7;
#pragma unroll
    for (int j = 0; j < 8; ++j) { const int nn = (lane >> 3) + 8 * j; const LAS float* q = scr + (8 * c) * 65 + nn;
        u32x4 o; o.x = pk2(q[0 * 65], q[1 * 65]); o.y = pk2(q[2 * 65], q[3 * 65]); o.z = pk2(q[4 * 65], q[5 * 65]); o.w = pk2(q[6 * 65], q[7 * 65]);
        *(u32x4*)(WT + (size_t)(n0 + nn) * K + k0 + 8 * c) = o; }
    asm volatile("s_waitcnt lgkmcnt(0)" ::: "memory"); __builtin_amdgcn_wave_barrier();
}

DI void phase_prep(KP p, LAS unsigned char* lds) {
    const int tid = tid_l(), lane = tid & 63, wave = tid >> 6, bid = blockIdx.x, G = gridDim.x;
    { float* SS = (float*)(p->ws + WS_SS);
      for (int i = bid * 512 + tid; i < 3 * MROWS; i += G * 512) SS[i] = 0.f;
      if (bid == 0 && tid < 64) ((unsigned*)(p->ws + WS_CTR))[tid] = 0u; }
    { const f32x4* src = (const f32x4*)p->ctx; f32x4* dst = (f32x4*)(p->ws + WS_XC);
      for (int i = bid * 512 + tid; i < 512 * DM / 4; i += G * 512) dst[i] = src[i]; }
    {
        LAS float* sv = (LAS float*)lds;
        LAS float* red = (LAS float*)(lds + 3 * 2048 * 4);
        for (int i = tid; i < 3 * 2048; i += 512) { const int v = i >> 11, k = i & 2047; const float x = v == 0 ? p->c[k] : (v == 1 ? p->c[2048 + k] : p->c_ctx[k]); sv[i] = x * sigmoidf_(x); }
        __syncthreads();
        float* MOD = (float*)(p->ws + WS_MOD);
        for (int it = bid; it < 2 * 384; it += G) {
            const int l = it / 384, n0 = (it % 384) * 32, j = tid & 7, kk = tid >> 3;
            const float* w = p->w_ada + (size_t)l * 2048 * 12288 + n0 + 4 * j;
            f32x4 a0 = {0, 0, 0, 0}, a1 = a0, a2 = a0;
#pragma unroll 16
            for (int k = kk; k < 2048; k += 64) { const f32x4 wv = *(const f32x4*)(w + (size_t)k * 12288); a0 += wv * sv[k]; a1 += wv * sv[2048 + k]; a2 += wv * sv[4096 + k]; }
            LAS float* r = red + (kk * 8 + j) * 12;
            *(LAS f32x4*)(r) = a0; *(LAS f32x4*)(r + 4) = a1; *(LAS f32x4*)(r + 8) = a2;
            __syncthreads();
            if (tid < 96) { const int v = tid >> 5, cc = tid & 31, jj = cc >> 2, e = cc & 3; float sum = 0.f;
                for (int q = 0; q < 64; ++q) sum += red[(q * 8 + jj) * 12 + v * 4 + e];
                MOD[(size_t)(l * 3 + v) * 12288 + n0 + cc] = sum + p->b_ada[l * 12288 + n0 + cc]; }
            __syncthreads();
        }
    }
    {
        f2_t* ROPE = (f2_t*)(p->ws + WS_ROPE);
        for (int i = bid * 512 + tid; i < 320 * 32; i += G * 512) { const int pos = i >> 5, f = i & 31; const int pa = pos < 256 ? pos : pos - 256;
            const float freq = 1.0f / powf(10000.0f, (float)(2 * f) / 64.0f); const float ang = (float)pa * freq; ROPE[i] = (f2_t){cosf(ang), sinf(ang)}; }
    }
    {
        LAS float* scr = (LAS float*)(lds + wave * 16640);
        const int gw = bid * 8 + wave, NGW = G * 8;
        constexpr int I_IN = 32 * 88, I_OUT = 32 * 32, I_F1 = 32 * 128, I_F2 = 128 * 32, I_L = I_IN + I_OUT + I_F1 + I_F2;
        for (int it = gw; it < 2 * I_L; it += NGW) {
            const int l = it / I_L; int r = it % I_L;
            if (r < I_IN) { transpose_item(p->w_in + (size_t)l * DM * NIN, DM, NIN, (u16*)(p->ws + WS_WIN + l * SZ_WIN), scr, r, 88, lane); continue; } r -= I_IN;
            if (r < I_OUT) { transpose_item(p->w_out + (size_t)l * DM * DM, DM, DM, (u16*)(p->ws + WS_WOUT + l * SZ_WOUT), scr, r, 32, lane); continue; } r -= I_OUT;
            if (r < I_F1) { transpose_item(p->w_ff1 + (size_t)l * DM * DFF, DM, DFF, (u16*)(p->ws + WS_WFF1 + l * SZ_WFF), scr, r, 128, lane); continue; } r -= I_F1;
            transpose_item(p->w_ff2 + (size_t)l * DFF * DM, DFF, DM, (u16*)(p->ws + WS_WFF2 + l * SZ_WFF), scr, r, 32, lane);
        }
    }
}

DI void phase_prep2(KP p, LAS unsigned char* lds) {
    const int tid = tid_l(), lane = tid & 63, wave = tid >> 6, bid = blockIdx.x, G = gridDim.x;
    const float* MOD = (const float*)(p->ws + WS_MOD);
    { float* GS = (float*)(p->ws + WS_GS);
      for (int i = bid * 512 + tid; i < 2 * 2 * 3 * DM; i += G * 512) { const int k = i & 2047, cls = (i >> 11) % 3, which = (i / (3 * DM)) & 1, l = i / (6 * DM);
          GS[i] = (which ? p->g_ffn : p->g_mix)[l * DM + k] * (1.f + MOD[(size_t)(l * 3 + cls) * 12288 + (which * 3 + 1) * DM + k]); } }
    LAS float* sh = (LAS float*)lds;
    const int gw = bid * 8 + wave, NGW = G * 8;
    for (int l = 0; l < 2; ++l) {
        __syncthreads();
        for (int i = tid; i < 6 * DM; i += 512) { const int k = i & 2047, cls = (i >> 11) % 3, which = i / (3 * DM); sh[i] = MOD[(size_t)(l * 3 + cls) * 12288 + (which * 3) * DM + k]; }
        __syncthreads();
        for (int r = gw; r < NPROJ + DFF; r += NGW) {
            const bool isf = r >= NPROJ; const int n = isf ? r - NPROJ : r;
            const u16* wrow = isf ? (const u16*)(p->ws + WS_WFF1 + l * SZ_WFF) + (size_t)n * DM : (const u16*)(p->ws + WS_WIN + l * SZ_WIN) + (size_t)n * DM;
            const LAS float* s0 = sh + (isf ? 3 * DM : 0);
            float a0 = 0.f, a1 = 0.f, a2 = 0.f;
#pragma unroll
            for (int j = 0; j < 4; ++j) { const int k = 8 * (lane + 64 * j); float w[8]; unpack8(*(const u32x4*)(wrow + k), w);
#pragma unroll
                for (int e = 0; e < 8; ++e) { a0 += w[e] * s0[k + e]; a1 += w[e] * s0[DM + k + e]; a2 += w[e] * s0[2 * DM + k + e]; } }
            a0 = wave_sum(a0); a1 = wave_sum(a1); a2 = wave_sum(a2);
            if (lane == 0) { float* B = isf ? (float*)(p->ws + WS_BIASF) + (size_t)l * 3 * DFF : (float*)(p->ws + WS_BIASP) + (size_t)l * 3 * NPROJ; const int N = isf ? DFF : NPROJ;
                B[n] = a0; B[N + n] = a1; B[2 * N + n] = a2; }
        }
    }
}

DI void phase_norm0(KP p) {
    const int tid = tid_l(), lane = tid & 63, gw = blockIdx.x * 8 + (tid >> 6), NGW = gridDim.x * 8;
    const float* gain = p->g_mix;
    u16* XN = (u16*)(p->ws + WS_XN);
    float* SS = (float*)(p->ws + WS_SS) + 3 * MROWS;
    f32x4 v[8], nx[8];
    if (gw < MROWS) { const float* xr = xrow_in(p, 0, gw);
#pragma unroll
        for (int j = 0; j < 8; ++j) v[j] = *(const f32x4*)(xr + 4 * lane + 256 * j); }
    for (int row = gw; row < MROWS; row += NGW) {
        const int nrow = row + NGW;
        if (nrow < MROWS) { const float* xr = xrow_in(p, 0, nrow);
#pragma unroll
            for (int j = 0; j < 8; ++j) nx[j] = *(const f32x4*)(xr + 4 * lane + 256 * j); }
        const float* md = (const float*)(p->ws + WS_MOD) + (size_t)mod_index(row) * 12288;
        float sum = 0.f;
#pragma unroll
        for (int j = 0; j < 8; ++j) sum += (v[j].x * v[j].x + v[j].y * v[j].y) + (v[j].z * v[j].z + v[j].w * v[j].w);
        sum = wave_sum(sum);
        if (lane == 0) SS[row] = sum;
#pragma unroll
        for (int j = 0; j < 8; ++j) { const int c = 4 * lane + 256 * j;
            const f32x4 g = *(const f32x4*)(gain + c), sc = *(const f32x4*)(md + DM + c);
            const f32x4 y = (v[j] * g) * (sc + 1.f);
            u32x2 o; o.x = pk2(y.x, y.y); o.y = pk2(y.z, y.w);
            *(u32x2*)(XN + (size_t)row * DM + c) = o; }
#pragma unroll
        for (int j = 0; j < 8; ++j) v[j] = nx[j];
    }
}
DI void phase_ctx_norm(KP p, const float* gs  , float* ss, int nsp) {
    const int tid = tid_l(), lane = tid & 63, gw = blockIdx.x * 8 + (tid >> 6), NGW = gridDim.x * 8;
    u16* XN = (u16*)(p->ws + WS_XN);
    for (int row = RLAT + gw; row < MROWS; row += NGW) {
        float* xr = (float*)(p->ws + WS_XC) + (size_t)(row - RLAT) * DM;
        const float* part = (const float*)(p->ws + WS_CST) + (size_t)(row - RLAT) * DM;
        f32x4 v[8]; float sum = 0.f;
#pragma unroll
        for (int j = 0; j < 8; ++j) v[j] = *(const f32x4*)(xr + 4 * lane + 256 * j);
        for (int ks = 0; ks < nsp; ++ks) {
#pragma unroll
            for (int j = 0; j < 8; ++j) v[j] += *(const f32x4*)(part + (size_t)ks * 512 * DM + 4 * lane + 256 * j); }
#pragma unroll
        for (int j = 0; j < 8; ++j) { *(f32x4*)(xr + 4 * lane + 256 * j) = v[j]; sum += (v[j].x * v[j].x + v[j].y * v[j].y) + (v[j].z * v[j].z + v[j].w * v[j].w); }
        sum = wave_sum(sum);
        if (lane == 0) ss[row] = sum;
#pragma unroll
        for (int j = 0; j < 8; ++j) { const int c = 4 * lane + 256 * j; const f32x4 y = v[j] * *(const f32x4*)(gs + c);
            u32x2 o; o.x = pk2(y.x, y.y); o.y = pk2(y.z, y.w); *(u32x2*)(XN + (size_t)row * DM + c) = o; }
    }
}
DI void phase_final(KP p) {
    const int tid = tid_l(), lane = tid & 63, gw = blockIdx.x * 8 + (tid >> 6), NGW = gridDim.x * 8;
    f32x4 v[8], nx[8];
    if (gw < RLAT) { const float* xr = p->out + (size_t)gw * DM;
#pragma unroll
        for (int j = 0; j < 8; ++j) v[j] = *(const f32x4*)(xr + 4 * lane + 256 * j); }
    for (int row = gw; row < RLAT; row += NGW) {
        const int nrow = row + NGW;
        if (nrow < RLAT) { const float* xn = p->out + (size_t)nrow * DM;
#pragma unroll
            for (int j = 0; j < 8; ++j) nx[j] = *(const f32x4*)(xn + 4 * lane + 256 * j); }
        float* xr = p->out + (size_t)row * DM;
        float sum = 0.f;
#pragma unroll
        for (int j = 0; j < 8; ++j) sum += (v[j].x * v[j].x + v[j].y * v[j].y) + (v[j].z * v[j].z + v[j].w * v[j].w);
        const float rstd = rsqrtf(wave_sum(sum) * (1.f / DM) + EPSN);
#pragma unroll
        for (int j = 0; j < 8; ++j) { const int c = 4 * lane + 256 * j; const f32x4 g = *(const f32x4*)(p->g_final + c); *(f32x4*)(xr + c) = v[j] * rstd * g; }
#pragma unroll
        for (int j = 0; j < 8; ++j) v[j] = nx[j];
    }
}

struct EpiProj {
    static constexpr bool PERM = true, AFTER_DRAIN = false;
    u16* O; float* gates; const float* ss; const float* bias0;
    __device__ __forceinline__ void operator()(const f32x4 (&acc)[2][2][4][2], const pg8::Unit& u, int wr, int wc, int fr, int fq) const {
        const int row0 = u.pm * 256 + wr * 64 + fr;
        const float* bias = bias0 + (size_t)mod_index(u.pm * 256) * NPROJ + u.pn * 256 + wc * 32 + 8 * fq;
        float rs[2][4];
#pragma unroll
        for (int ai = 0; ai < 2; ++ai)
#pragma unroll
            for (int m = 0; m < 4; ++m) rs[ai][m] = row_rstd(ss, row0 + ai * 128 + m * 16);
        {
            const int col0 = u.pn * 256 + wc * 32 + 8 * fq;
#pragma unroll
            for (int bj = 0; bj < 2; ++bj) { const f32x4 b0 = *(const f32x4*)(bias + bj * 128), b1 = *(const f32x4*)(bias + bj * 128 + 4);
#pragma unroll
                for (int ai = 0; ai < 2; ++ai)
#pragma unroll
                    for (int m = 0; m < 4; ++m) { const f32x4 v0 = acc[ai][bj][m][0] * rs[ai][m] + b0, v1 = acc[ai][bj][m][1] * rs[ai][m] + b1;
                        u32x4 o; o.x = pk2(v0[0], v0[1]); o.y = pk2(v0[2], v0[3]); o.z = pk2(v1[0], v1[1]); o.w = pk2(v1[2], v1[3]);
                        *(u32x4*)(O + (size_t)(row0 + ai * 128 + m * 16) * PLD + col0 + bj * 128) = o; } }
        }
    }
};
struct EpiRes {
    static constexpr bool PERM = false, AFTER_DRAIN = false;
    KP p; int stage; const float* gate0;
    const float* gs0; float* ssn;
    int ntfull;
    __device__ __forceinline__ void operator()(const f32x4 (&acc)[2][2][4][2], const pg8::Unit& u, int wr, int wc, int fr, int fq) const {
        const int row0 = u.pm * 256 + wr * 64 + fr, col0 = u.pn * 256 + wc * 32 + 4 * fq, cls = mod_index(u.pm * 256);
        const float* gate = gate0 + (size_t)cls * 12288 + col0;
        if (u.nt != ntfull) {
#pragma unroll
            for (int ai = 0; ai < 2; ++ai)
#pragma unroll
                for (int m = 0; m < 4; ++m) { float* xo = (float*)(p->ws + WS_CST) + ((size_t)(u.koff / 512) * 512 + (row0 + ai * 128 + m * 16 - RLAT)) * DM + col0;
#pragma unroll
                    for (int bj = 0; bj < 2; ++bj)
#pragma unroll
                        for (int n = 0; n < 2; ++n) { const int co = bj * 128 + n * 16; *(f32x4*)(xo + co) = *(const f32x4*)(gate + co) * acc[ai][bj][m][n]; } }
            return;
        }
        const float* gs = gs0 ? gs0 + cls * DM + col0 : nullptr;
        u16* XN = (u16*)(p->ws + WS_XN);
#pragma unroll
        for (int ai = 0; ai < 2; ++ai)
#pragma unroll
            for (int m = 0; m < 4; ++m) { const int row = row0 + ai * 128 + m * 16; const float* xi = xrow_in(p, stage, row) + col0; float* xo = xrow_out(p, row) + col0;
                float sq = 0.f;
#pragma unroll
                for (int bj = 0; bj < 2; ++bj)
#pragma unroll
                    for (int n = 0; n < 2; ++n) { const int co = bj * 128 + n * 16;
                        const f32x4 v = *(const f32x4*)(xi + co) + *(const f32x4*)(gate + co) * acc[ai][bj][m][n];
                        *(f32x4*)(xo + co) = v;
                        if (gs) { const f32x4 y = v * *(const f32x4*)(gs + co); u32x2 o; o.x = pk2(y.x, y.y); o.y = pk2(y.z, y.w);
                            *(u32x2*)(XN + (size_t)row * DM + col0 + co) = o; sq += (v.x * v.x + v.y * v.y) + (v.z * v.z + v.w * v.w); } }
                if (gs) { sq += __shfl_xor(sq, 16); sq += __shfl_xor(sq, 32); if (fq == 0) atomicAdd(ssn + row, sq); } }
    }
};
struct EpiSqRelu {
    static constexpr bool PERM = true, AFTER_DRAIN = false;
    u16* O; const float* ss; const float* bias0;
    __device__ __forceinline__ void operator()(const f32x4 (&acc)[2][2][4][2], const pg8::Unit& u, int wr, int wc, int fr, int fq) const {
        const int row0 = u.pm * 256 + wr * 64 + fr, col0 = u.pn * 256 + wc * 32 + 8 * fq;
        const float* bias = bias0 + (size_t)mod_index(u.pm * 256) * DFF + col0;
        float rs[2][4];
#pragma unroll
        for (int ai = 0; ai < 2; ++ai)
#pragma unroll
            for (int m = 0; m < 4; ++m) rs[ai][m] = row_rstd(ss, row0 + ai * 128 + m * 16);
#pragma unroll
        for (int bj = 0; bj < 2; ++bj) { const f32x4 b0 = *(const f32x4*)(bias + bj * 128), b1 = *(const f32x4*)(bias + bj * 128 + 4);
#pragma unroll
            for (int ai = 0; ai < 2; ++ai)
#pragma unroll
                for (int m = 0; m < 4; ++m) { f32x4 v0 = acc[ai][bj][m][0] * rs[ai][m] + b0, v1 = acc[ai][bj][m][1] * rs[ai][m] + b1;
#pragma unroll
                    for (int e = 0; e < 4; ++e) { const float a = fmaxf(v0[e], 0.f), b = fmaxf(v1[e], 0.f); v0[e] = a * a; v1[e] = b * b; }
                    u32x4 o; o.x = pk2(v0[0], v0[1]); o.y = pk2(v0[2], v0[3]); o.z = pk2(v1[0], v1[1]); o.w = pk2(v1[2], v1[3]);
                    *(u32x4*)(O + (size_t)(row0 + ai * 128 + m * 16) * DFF + col0 + bj * 128) = o; } }
    }
};
template <class Epi> DI void run_gemm(LAS unsigned char* lds, const u16* A, const u16* Bt, int M, int N, int K, const Epi& E) {
    pg8::Gemm g; g.A = A; g.Bt = Bt; g.M = M; g.N = N; g.K = K;
    pg8::StaticOrder S; S.init(M, N, K, (int)gridDim.x, (int)blockIdx.x);
    pg8::gemm_phase<Epi, pg8::StaticOrder, false>(lds, g, S, E, nullptr);
}
struct SplitOrder : pg8::StaticOrder {
    int nsp, ksp, ntsp, pm0, nctx;
    __device__ __forceinline__ bool next(int i, pg8::Unit& u) const {
        const long L = (long)i * G + c;
        if (L < nwg) return pg8::StaticOrder::next(i, u);
        const int q = (int)(L - nwg); if (q >= nctx) return false;
        const int tile = q % (2 * nN), ks = q / (2 * nN);
        u.pm = pm0 + tile / nN; u.pn = tile % nN; u.koff = ks * ksp; u.nt = ntsp; return true;
    }
};
template <class Epi> DI void run_gemm_split(LAS unsigned char* lds, const u16* A, const u16* Bt, int Mlat, int N, int K, int nsp, const Epi& E) {
    pg8::Gemm g; g.A = A; g.Bt = Bt; g.M = Mlat; g.N = N; g.K = K;
    SplitOrder S; S.init(Mlat, N, K, (int)gridDim.x, (int)blockIdx.x);
    S.nsp = nsp; S.ksp = nsp ? K / nsp : K; S.ntsp = S.ksp / 64; S.pm0 = Mlat / 256; S.nctx = nsp ? 2 * (N / 256) * nsp : 0;
    pg8::gemm_phase<Epi, SplitOrder, false>(lds, g, S, E, nullptr);
}


DI void stage_plain(LAS unsigned char* T, const u16* src, int ld, int tid) {
#pragma unroll
    for (int i = 0; i < 4; ++i) { const int id = tid + 512 * i, row = id >> 4, ch = id & 15;
        *(LAS u32x4*)(T + toff(row, ch)) = *(const u32x4*)(src + (size_t)row * ld + ch * 8); }
}
DI void stage_rope(LAS unsigned char* T, const u16* src, int ld, int pos0, float scale, const f2_t* ROPE, int tid) {
#pragma unroll
    for (int i = 0; i < 2; ++i) { const int task = tid + 512 * i, row = task >> 3, pp = task & 7, cq = pp & 3, half = pp >> 2, chA = half * 8 + cq;
        const int pos = pos0 + row, pa = half ? 256 + (pos & 63) : (pos >> 6);
        const u32x4 ra = *(const u32x4*)(src + (size_t)row * ld + chA * 8), rb = *(const u32x4*)(src + (size_t)row * ld + (chA + 4) * 8);
        float x1[8], x2[8], o1[8], o2[8]; unpack8(ra, x1); unpack8(rb, x2);
        const f2_t* tb = ROPE + pa * 32 + cq * 8;
#pragma unroll
        for (int e = 0; e < 8; ++e) { const f2_t cs = tb[e]; o1[e] = (x1[e] * cs.x - x2[e] * cs.y) * scale; o2[e] = (x1[e] * cs.y + x2[e] * cs.x) * scale; }
        *(LAS u32x4*)(T + toff(row, chA)) = pack8(o1); *(LAS u32x4*)(T + toff(row, chA + 4)) = pack8(o2); }
}
DI void stage_conv(LAS unsigned char* T, const u16* src, int ld, int lo, int hi, const float* cw  , const float* cb, float scale, int tid, u16* gdst = nullptr  ) {
#pragma unroll
    for (int i = 0; i < 4; ++i) { const int id = tid + 512 * i, row = id >> 4, ch = id & 15;
        float xm[8], x0[8], xp[8], y[8];
        const u32x4 z = {0u, 0u, 0u, 0u};
        const bool okm = row - 1 >= lo, okp = row + 1 < hi;
        const u32x4 r0 = *(const u32x4*)(src + (size_t)row * ld + ch * 8);
        u32x4 rm = *(const u32x4*)(src + (ptrdiff_t)(okm ? row - 1 : row) * ld + ch * 8);
        u32x4 rp = *(const u32x4*)(src + (ptrdiff_t)(okp ? row + 1 : row) * ld + ch * 8);
        rm = okm ? rm : z; rp = okp ? rp : z;
        unpack8(rm, xm); unpack8(r0, x0); unpack8(rp, xp);
#pragma unroll
        for (int e = 0; e < 8; ++e) { const int c = ch * 8 + e; const float v = cb[c] + xm[e] * cw[c] + x0[e] * cw[1536 + c] + xp[e] * cw[3072 + c]; y[e] = v * sigmoidf_(v) * scale; }
        const u32x4 pk = pack8(y);
        *(LAS u32x4*)(T + toff(row, ch)) = pk;
        if (gdst) *(u32x4*)(gdst + (size_t)row * 768 + ch * 8) = pk; }
}

DI void gate_item(KP p, int l, int it, LAS unsigned char* lds) {
    const int tid = tid_l(), lane = tid & 63, wid = tid >> 6, fr = lane & 15, fq = lane >> 4;
    const int r0 = it * 128, srow = tid >> 4, sch = tid & 15;
    const u16* xa = (const u16*)(p->ws + WS_XN) + (size_t)(r0 + srow) * DM + sch * 8;
    const u16* wg = (const u16*)(p->ws + WS_WIN + l * SZ_WIN) + (size_t)(PLD + (tid >> 4)) * DM + sch * 8;
    LAS unsigned char* T0 = lds; LAS unsigned char* T1 = lds + TILE_B;
    u32x4 ar[4], wreg;
#pragma unroll
    for (int i = 0; i < 4; ++i) ar[i] = *(const u32x4*)(xa + (size_t)(32 * i) * DM);
    wreg = *(const u32x4*)wg;
    f32x4 acc0 = {0.f, 0.f, 0.f, 0.f}, acc1 = {0.f, 0.f, 0.f, 0.f};
    for (int kc = 0; kc < 16; ++kc) {
        __syncthreads();
#pragma unroll
        for (int i = 0; i < 4; ++i) *(LAS u32x4*)(T0 + toff(srow + 32 * i, sch)) = ar[i];
        *(LAS u32x4*)(T1 + toff(srow, sch)) = wreg;
        if (kc < 15) {
#pragma unroll
            for (int i = 0; i < 4; ++i) ar[i] = *(const u32x4*)(xa + (size_t)(32 * i) * DM + (kc + 1) * 128);
            wreg = *(const u32x4*)(wg + (kc + 1) * 128); }
        __syncthreads();
#pragma unroll
        for (int ks = 0; ks < 4; ++ks) { const bf16x8 xf = frag_row(T0, 16 * wid, 32 * ks, lane);
            acc0 = MFMA16(frag_row(T1, 0, 32 * ks, lane), xf, acc0); acc1 = MFMA16(frag_row(T1, 16, 32 * ks, lane), xf, acc1); }
    }
    const int row = r0 + 16 * wid + fr;
    const float rs = row_rstd((const float*)(p->ws + WS_SS) + (l == 0 ? 3 : 1) * MROWS, row);
    const float* bias = (const float*)(p->ws + WS_BIASP) + (size_t)(l * 3 + mod_index(row)) * NPROJ + PLD + 4 * fq;
    float* gp = (float*)(p->ws + WS_GATES) + (size_t)row * 32 + 4 * fq;
    *(f32x4*)gp = acc0 * rs + *(const f32x4*)bias; *(f32x4*)(gp + 16) = acc1 * rs + *(const f32x4*)(bias + 16);
    __syncthreads();
}

DI void gmlp_item(KP p, int l, int it, LAS unsigned char* lds) {
    const int tid = tid_l(), lane = tid & 63, wid = tid >> 6, fr = lane & 15, fq = lane >> 4;
    const int n = it >> 2, g = it & 3, r0 = n * 128;
    if (l == 1 && n >= 256) return;
    const u16* proj = (const u16*)(p->ws + WS_R);
    u16* Y = (u16*)(p->ws + WS_Y);
    LAS unsigned char* T0 = lds; LAS unsigned char* T1 = lds + TILE_B;
    { const float* ws = p->gm_w_s + (size_t)(l * 4 + g) * 16384;
#pragma unroll
      for (int i = 0; i < 8; ++i) { const int f = tid + 512 * i, row = f >> 5, c4 = f & 31; const f32x4 v = *(const f32x4*)(ws + (size_t)f * 4);
          u32x2 o; o.x = pk2(v.x, v.y); o.y = pk2(v.z, v.w); *(LAS u32x2*)(T0 + toff(row, c4 >> 1) + 8 * (c4 & 1)) = o; } }
    { const float* vg = p->gm_v_gain + l * 512 + g * 128;
#pragma unroll
      for (int i = 0; i < 4; ++i) { const int id = tid + 512 * i, row = id >> 4, ch = id & 15;
          float v[8]; unpack8(*(const u32x4*)(proj + (size_t)(r0 + row) * PLD + OFF_GV + g * 128 + ch * 8), v);
          float ss = 0.f;
#pragma unroll
          for (int e = 0; e < 8; ++e) { v[e] = gelu_tanh(v[e]); ss += v[e] * v[e]; }
          ss += __shfl_xor(ss, 1); ss += __shfl_xor(ss, 2); ss += __shfl_xor(ss, 4); ss += __shfl_xor(ss, 8);
          const float rstd = rsqrtf(ss * (1.f / 128.f) + EPSN);
#pragma unroll
          for (int e = 0; e < 8; ++e) v[e] = v[e] * rstd * vg[ch * 8 + e];
          *(LAS u32x4*)(T1 + toff(row, ch)) = pack8(v); } }
    __syncthreads();
    const int cb = 32 * (wid >> 1), pb = 64 * (wid & 1);
    f32x4 acc[2][4];
#pragma unroll
    for (int a = 0; a < 2; ++a)
#pragma unroll
        for (int b = 0; b < 4; ++b) acc[a][b] = (f32x4){0.f, 0.f, 0.f, 0.f};
#pragma unroll
    for (int ks = 0; ks < 4; ++ks) {
        bf16x8 af[2], bfg[4];
#pragma unroll
        for (int a = 0; a < 2; ++a) af[a] = frag_tr(T1, 32 * ks, cb + 16 * a, lane);
#pragma unroll
        for (int b = 0; b < 4; ++b) bfg[b] = frag_row(T0, pb + 16 * b, 32 * ks, lane);
#pragma unroll
        for (int a = 0; a < 2; ++a)
#pragma unroll
            for (int b = 0; b < 4; ++b) acc[a][b] = MFMA16(af[a], bfg[b], acc[a][b]);
    }
    const float* bs = p->gm_b_s + (l * 4 + g) * 128;
#pragma unroll
    for (int a = 0; a < 2; ++a)
#pragma unroll
        for (int b = 0; b < 4; ++b) { const int pp = pb + 16 * b + fr, c0 = cb + 16 * a + 4 * fq; const float bias = bs[pp];
            const u32x2 uu = *(const u32x2*)(proj + (size_t)(r0 + pp) * PLD + OFF_GU + g * 128 + c0);
            const float u0 = gelu_tanh(bf_lo(uu.x)), u1 = gelu_tanh(bf_hi(uu.x)), u2 = gelu_tanh(bf_lo(uu.y)), u3 = gelu_tanh(bf_hi(uu.y));
            u32x2 o; o.x = pk2(u0 * (acc[a][b][0] + bias), u1 * (acc[a][b][1] + bias)); o.y = pk2(u2 * (acc[a][b][2] + bias), u3 * (acc[a][b][3] + bias));
            *(u32x2*)(Y + (size_t)(r0 + pp) * DM + g * 128 + c0) = o; }
    __syncthreads();
}

DI void rope_item(KP p, int it) {
    const int tid = tid_l();
    u16* proj = (u16*)(p->ws + WS_R);
    const f2_t* ROPE = (const f2_t*)(p->ws + WS_ROPE);
    const float qs = QSCALE * LOG2E;
    const int row0 = it * 128;
    if (it < 256) {
        const int pos0 = (it & 127) * 128;
#pragma unroll 2
        for (int i = 0; i < 16; ++i) { const int task = tid + 512 * i, hh = task >> 10, row = (task >> 3) & 127, pp = task & 7, cq = pp & 3, half = pp >> 2, chA = half * 8 + cq;
            const int pos = pos0 + row, pa = half ? 256 + (pos & 63) : (pos >> 6);
            u16* src = proj + (size_t)(row0 + row) * PLD + OFF_AQ + hh * 128;
            const float scale = hh < 6 ? qs : 1.f;
            const u32x4 ra = *(const u32x4*)(src + chA * 8), rb = *(const u32x4*)(src + (chA + 4) * 8);
            float x1[8], x2[8], o1[8], o2[8]; unpack8(ra, x1); unpack8(rb, x2);
            const f2_t* tb = ROPE + pa * 32 + cq * 8;
#pragma unroll
            for (int e = 0; e < 8; ++e) { const f2_t cs = tb[e]; o1[e] = (x1[e] * cs.x - x2[e] * cs.y) * scale; o2[e] = (x1[e] * cs.y + x2[e] * cs.x) * scale; }
            *(u32x4*)(src + chA * 8) = pack8(o1); *(u32x4*)(src + (chA + 4) * 8) = pack8(o2); }
    } else {
#pragma unroll 2
        for (int i = 0; i < 24; ++i) { const int id = tid + 512 * i, row = id / 96, ch = id % 96; float v[8];
            u16* src = proj + (size_t)(row0 + row) * PLD + OFF_AQ + ch * 8;
            unpack8(*(const u32x4*)src, v);
#pragma unroll
            for (int e = 0; e < 8; ++e) v[e] *= qs;
            *(u32x4*)src = pack8(v); }
    }
}

DI void attn_tile(int kt, bool isctx, int b, int nb, bool& valid, int& krow0, int& jloc) {
    jloc = 0; valid = true;
    if (kt < 2) { krow0 = RLAT + b * LCTX + kt * 128; return; }
    jloc = kt - 3; const int kb = nb + jloc; krow0 = b * SEQ + kb * 128;
    valid = !isctx && kb >= 0 && kb <= 127 && kt < 5;
    if (!valid) krow0 = 0;
}
DI void attn_item(KP p, int l, int it, LAS unsigned char* lds) {
    const int tid = tid_l(), lane = tid & 63, wid = tid >> 6, fr = lane & 15, fq = lane >> 4;
    const u16* proj = (const u16*)(p->ws + WS_R);
    u16* Y = (u16*)(p->ws + WS_Y);
    LAS unsigned char* T0 = lds; LAS unsigned char* T1 = lds + TILE_B; LAS unsigned char* T2 = lds + 2 * TILE_B;
    int b, nb, hq, qrow0; bool isctx;
    if (it < 1536) { hq = it % 6; nb = (it / 6) & 127; b = it / 768; qrow0 = b * SEQ + nb * 128; isctx = false; }
    else { if (l == 1) return; const int r = it - 1536; hq = r % 6; const int cbk = (r / 6) & 1; b = r / 12; nb = 0; qrow0 = RLAT + b * LCTX + cbk * 128; isctx = true; }
    const int kvh = hq / 3;
    const int srow = tid >> 4, sch = tid & 15;
    u32x4 kr[4], vr[4];
    { const u16* ks = proj + (size_t)(RLAT + b * LCTX) * PLD + OFF_AK + kvh * 128 + sch * 8; const u16* vs = proj + (size_t)(RLAT + b * LCTX) * PLD + OFF_AV + kvh * 128 + sch * 8;
#pragma unroll
      for (int i = 0; i < 4; ++i) { kr[i] = *(const u32x4*)(ks + (size_t)(srow + 32 * i) * PLD); vr[i] = *(const u32x4*)(vs + (size_t)(srow + 32 * i) * PLD); } }
    stage_plain(T0, proj + (size_t)qrow0 * PLD + OFF_AQ + hq * 128, PLD, tid);
    __syncthreads();
    bf16x8 Qf[4];
#pragma unroll
    for (int ks = 0; ks < 4; ++ks) Qf[ks] = frag_row(T0, 16 * wid, 32 * ks, lane);
    float m = p->attn_sink[l * 6 + hq] * LOG2E, lsum = 1.f;
    f32x4 O[8];
#pragma unroll
    for (int i = 0; i < 8; ++i) O[i] = (f32x4){0.f, 0.f, 0.f, 0.f};
    const int rin = 16 * wid + fr;
    for (int kt = 0; kt < 5; ++kt) {
        bool valid; int krow0, jloc; attn_tile(kt, isctx, b, nb, valid, krow0, jloc);
        if (!valid) continue;
        __syncthreads();
#pragma unroll
        for (int i = 0; i < 4; ++i) { *(LAS u32x4*)(T1 + toff(srow + 32 * i, sch)) = kr[i]; *(LAS u32x4*)(T2 + toff(srow + 32 * i, sch)) = vr[i]; }
        {
          int kn = kt + 1; bool vn; int rn, jn; attn_tile(kn, isctx, b, nb, vn, rn, jn);
          if (!vn && kn < 4) { ++kn; attn_tile(kn, isctx, b, nb, vn, rn, jn); }
          if (vn) { const u16* ks = proj + (size_t)rn * PLD + OFF_AK + kvh * 128 + sch * 8; const u16* vs = proj + (size_t)rn * PLD + OFF_AV + kvh * 128 + sch * 8;
#pragma unroll
              for (int i = 0; i < 4; ++i) { kr[i] = *(const u32x4*)(ks + (size_t)(srow + 32 * i) * PLD); vr[i] = *(const u32x4*)(vs + (size_t)(srow + 32 * i) * PLD); } } }
        __syncthreads();
        const bool local = kt >= 2;
        f32x4 S[8];
#pragma unroll
        for (int n = 0; n < 8; ++n) S[n] = (f32x4){0.f, 0.f, 0.f, 0.f};
        {
            bf16x8 kf[2][8];
#pragma unroll
            for (int n = 0; n < 8; ++n) kf[0][n] = frag_row(T1, 16 * n, 0, lane);
#pragma unroll
            for (int ks = 0; ks < 4; ++ks) {
                if (ks < 3) {
#pragma unroll
                    for (int n = 0; n < 8; ++n) kf[(ks + 1) & 1][n] = frag_row(T1, 16 * n, 32 * (ks + 1), lane);
                }
#pragma unroll
                for (int n = 0; n < 8; ++n) S[n] = MFMA16(kf[ks & 1][n], Qf[ks], S[n]);
            }
        }
        if (local && jloc != 0) {
#pragma unroll
            for (int n = 0; n < 8; ++n)
#pragma unroll
                for (int j = 0; j < 4; ++j) { const int dk = 16 * n + 4 * fq + j - rin; const bool keep = jloc < 0 ? dk >= 0 : dk <= 0; S[n][j] = keep ? S[n][j] : -INFINITY; }
        }
        float mx = -INFINITY;
#pragma unroll
        for (int n = 0; n < 8; ++n) mx = fmaxf(fmaxf(mx, fmaxf(S[n][0], S[n][1])), fmaxf(S[n][2], S[n][3]));
        mx = fmaxf(mx, __shfl_xor(mx, 16)); mx = fmaxf(mx, __shfl_xor(mx, 32));
        const float mnew = fmaxf(m, mx), alpha = __builtin_amdgcn_exp2f(m - mnew);
        float rs = 0.f;
#pragma unroll
        for (int n = 0; n < 8; ++n)
#pragma unroll
            for (int j = 0; j < 4; ++j) { const float e = __builtin_amdgcn_exp2f(S[n][j] - mnew); S[n][j] = e; rs += e; }
        rs += __shfl_xor(rs, 16); rs += __shfl_xor(rs, 32);
        lsum = lsum * alpha + rs; m = mnew;
#pragma unroll
        for (int i = 0; i < 8; ++i) O[i] *= alpha;
        bf16x8 Pf[4];
#pragma unroll
        for (int nn = 0; nn < 4; ++nn) { u32x4 o; o.x = pk2(S[2 * nn][0], S[2 * nn][1]); o.y = pk2(S[2 * nn][2], S[2 * nn][3]); o.z = pk2(S[2 * nn + 1][0], S[2 * nn + 1][1]); o.w = pk2(S[2 * nn + 1][2], S[2 * nn + 1][3]); Pf[nn] = __builtin_bit_cast(bf16x8, o); }
        {
            bf16x8 vf[2][8];
#pragma unroll
            for (int nd = 0; nd < 8; ++nd) vf[0][nd] = frag_tr_perm(T2, 0, 16 * nd, lane);
#pragma unroll
            for (int nn = 0; nn < 4; ++nn) {
                if (nn < 3) {
#pragma unroll
                    for (int nd = 0; nd < 8; ++nd) vf[(nn + 1) & 1][nd] = frag_tr_perm(T2, 32 * (nn + 1), 16 * nd, lane);
                }
#pragma unroll
                for (int nd = 0; nd < 8; ++nd) O[nd] = MFMA16(vf[nn & 1][nd], Pf[nn], O[nd]);
            }
        }
    }
    const float inv = __builtin_amdgcn_rcpf(lsum);
    u16* yr = Y + (size_t)(qrow0 + rin) * DM + 512 + hq * 128 + 4 * fq;
#pragma unroll
    for (int nd = 0; nd < 8; ++nd) { u32x2 o; o.x = pk2(O[nd][0] * inv, O[nd][1] * inv); o.y = pk2(O[nd][2] * inv, O[nd][3] * inv); *(u32x2*)(yr + 16 * nd) = o; }
    __syncthreads();
}

DI void ml_item_geom(int it, int& b, int& c, int& h, int& base, int& lo, int& hi) {
    h = it % 6; c = (it / 6) % NCH; b = it / (6 * NCH);
    if (c < 2) { base = RLAT + b * LCTX + c * 128; lo = -c * 128; hi = LCTX - c * 128; }
    else { base = b * SEQ + (c - 2) * 128; lo = -(c - 2) * 128; hi = SEQ - (c - 2) * 128; }
}
DI int ml_pos(int c, int d) { return d == 0 ? c : (c < 2 ? 1 - c : 131 - c); }
DI void ml_gate_scan(const float* gates, int base, int d, int h, float bi, float bff, int lane, int& t0, int& t1, float& li0, float& li1, float& b0, float& b1) {
    t0 = d ? 127 - 2 * lane : 2 * lane; t1 = d ? t0 - 1 : t0 + 1;
    const float* g0 = gates + (size_t)(base + t0) * 32 + d * 12 + h; const float* g1 = gates + (size_t)(base + t1) * 32 + d * 12 + h;
    li0 = g0[0] + bi; li1 = g1[0] + bi;
    const float lf0 = log_sigmoid(g0[6] + bff), lf1 = log_sigmoid(g1[6] + bff);
    float s = lf0 + lf1;
#pragma unroll
    for (int o = 1; o < 64; o <<= 1) { const float v = __shfl_up(s, o); if (lane >= o) s += v; }
    b1 = s; b0 = s - lf1;
}

DI void ml1_item(KP p, int l, int it, LAS unsigned char* lds) {
    const int tid = tid_l(), lane = tid & 63, wid = tid >> 6, fr = lane & 15, fq = lane >> 4;
    int b, c, h, base, lo, hi; ml_item_geom(it, b, c, h, base, lo, hi);
    const u16* proj = (const u16*)(p->ws + WS_R);
    const float* gates = (const float*)(p->ws + WS_GATES);
    LAS unsigned char* T0 = lds; LAS unsigned char* T1 = lds + TILE_B; LAS unsigned char* T2 = lds + 2 * TILE_B;
    LAS float* wsc = (LAS float*)(lds + SC_OFF);
    if (wid < 2) { const int d = wid; int t0, t1; float li0, li1, b0, b1;
        ml_gate_scan(gates, base, d, h, p->ml_b_i[l * 12 + d * 6 + h], p->ml_b_f[l * 12 + d * 6 + h], lane, t0, t1, li0, li1, b0, b1);
        const float g = __shfl(b1, 63);
        const float a0 = g - b0 + li0, a1 = g - b1 + li1;
        const float ml = wave_max(fmaxf(a0, a1));
        wsc[d * 128 + t0] = __expf(a0 - ml); wsc[d * 128 + t1] = __expf(a1 - ml);
        if (lane == 0) { const int sq = ((b * 6 + h) * 2 + d) * NCH + ml_pos(c, d); ((float*)(p->ws + WS_GSC))[sq] = g; ((float*)(p->ws + WS_MLS))[sq] = ml; } }
    stage_conv(T0, proj + (size_t)base * PLD + OFF_MK + h * 128, PLD, lo, hi, p->ml_conv_w + (size_t)l * 4608 + 768 + h * 128, p->ml_conv_b + l * 1536 + 768 + h * 128, QSCALE, tid,
               (u16*)(p->ws + WS_XN) + (size_t)base * 768 + h * 128);
    __syncthreads();
#pragma unroll
    for (int i = 0; i < 4; ++i) { const int id = tid + 512 * i, row = id >> 4, ch = id & 15; float v[8], y[8];
        unpack8(*(const u32x4*)(proj + (size_t)(base + row) * PLD + OFF_MV + h * 128 + ch * 8), v);
        const float w0 = wsc[row], w1 = wsc[128 + row];
#pragma unroll
        for (int e = 0; e < 8; ++e) y[e] = v[e] * w0;
        *(LAS u32x4*)(T1 + toff(row, ch)) = pack8(y);
#pragma unroll
        for (int e = 0; e < 8; ++e) y[e] = v[e] * w1;
        *(LAS u32x4*)(T2 + toff(row, ch)) = pack8(y); }
    __syncthreads();
    const int kb = 32 * (wid >> 1), vb = 64 * (wid & 1);
    u16* CST = (u16*)(p->ws + WS_CST);
#pragma unroll
    for (int d = 0; d < 2; ++d) {
        const LAS unsigned char* TV = d ? T2 : T1;
        f32x4 acc[2][4];
#pragma unroll
        for (int a = 0; a < 2; ++a)
#pragma unroll
            for (int bb = 0; bb < 4; ++bb) acc[a][bb] = (f32x4){0.f, 0.f, 0.f, 0.f};
#pragma unroll
        for (int ks = 0; ks < 4; ++ks) {
            bf16x8 af[2], bfg[4];
#pragma unroll
            for (int a = 0; a < 2; ++a) af[a] = frag_tr(T0, 32 * ks, kb + 16 * a, lane);
#pragma unroll
            for (int bb = 0; bb < 4; ++bb) bfg[bb] = frag_tr(TV, 32 * ks, vb + 16 * bb, lane);
#pragma unroll
            for (int a = 0; a < 2; ++a)
#pragma unroll
                for (int bb = 0; bb < 4; ++bb) acc[a][bb] = MFMA16(af[a], bfg[bb], acc[a][bb]);
        }
        u16* Cd = CST + ((size_t)(((b * 6 + h) * 2 + d) * NCH + ml_pos(c, d))) * 16384;
#pragma unroll
        for (int a = 0; a < 2; ++a)
#pragma unroll
            for (int bb = 0; bb < 4; ++bb) { const int v = vb + 16 * bb + fr, k0 = kb + 16 * a + 4 * fq;
                u32x2 o; o.x = pk2(acc[a][bb][0], acc[a][bb][1]); o.y = pk2(acc[a][bb][2], acc[a][bb][3]); *(u32x2*)(Cd + v * 128 + k0) = o; }
    }
    { const int d = tid >> 8, k2 = tid & 63, tq = (tid >> 6) & 3; float s0 = 0.f, s1 = 0.f;
#pragma unroll 8
        for (int t = 32 * tq; t < 32 * tq + 32; ++t) { const float w = wsc[d * 128 + t]; const unsigned kv = *(const LAS unsigned*)(T0 + toff(t, k2 >> 2) + 4 * (k2 & 3)); s0 += w * bf_lo(kv); s1 += w * bf_hi(kv); }
        LAS float* red = (LAS float*)(lds + SC_OFF + 2048);
        red[(d * 4 + tq) * 128 + 2 * k2] = s0; red[(d * 4 + tq) * 128 + 2 * k2 + 1] = s1;
        __syncthreads();
        if (tid < 256) { const int dd = tid >> 7, k = tid & 127; const float sum = (red[(dd * 4 + 0) * 128 + k] + red[(dd * 4 + 1) * 128 + k]) + (red[(dd * 4 + 2) * 128 + k] + red[(dd * 4 + 3) * 128 + k]);
            ((float*)(p->ws + WS_NST))[((size_t)(((b * 6 + h) * 2 + dd) * NCH + ml_pos(c, dd))) * 128 + k] = sum; } }
    __syncthreads();
}

DI void scan_item(KP p, int it) {
    const float* GSC = (const float*)(p->ws + WS_GSC); const float* MLS = (const float*)(p->ws + WS_MLS);
    const int gt = it * 512 + tid_l();
    if (gt < NSEQ * 4096) {
        const int sq = gt >> 12, e4 = gt & 4095;
        u16* base = (u16*)(p->ws + WS_CST) + (size_t)sq * NCH * 16384 + e4 * 4;
        float c0 = 0.f, c1 = 0.f, c2 = 0.f, c3 = 0.f, m = 0.f;
        for (int j0 = 0; j0 < NCH; j0 += 10) {
            u32x2 v[10]; float gj[10], mj[10];
#pragma unroll
            for (int u = 0; u < 10; ++u) { v[u] = *(const u32x2*)(base + (size_t)(j0 + u) * 16384); gj[u] = GSC[sq * NCH + j0 + u]; mj[u] = MLS[sq * NCH + j0 + u]; }
#pragma unroll
            for (int u = 0; u < 10; ++u) {
                u32x2 o; o.x = pk2(c0, c1); o.y = pk2(c2, c3); *(u32x2*)(base + (size_t)(j0 + u) * 16384) = o;
                const float mn = fmaxf(gj[u] + m, mj[u]), ao = __expf(gj[u] + m - mn), an = __expf(mj[u] - mn);
                c0 = ao * c0 + an * bf_lo(v[u].x); c1 = ao * c1 + an * bf_hi(v[u].x); c2 = ao * c2 + an * bf_lo(v[u].y); c3 = ao * c3 + an * bf_hi(v[u].y); m = mn; }
        }
    } else {
        const int r = gt - NSEQ * 4096, sq = r >> 7, k = r & 127;
        float* nb = (float*)(p->ws + WS_NST) + (size_t)sq * NCH * 128 + k; float* M0 = (float*)(p->ws + WS_M0);
        float n = 0.f, m = 0.f;
        for (int j = 0; j < NCH; ++j) { const float dn = nb[(size_t)j * 128], gj = GSC[sq * NCH + j], mj = MLS[sq * NCH + j];
            nb[(size_t)j * 128] = n; if (k == 0) M0[sq * NCH + j] = m;
            const float mn = fmaxf(gj + m, mj), ao = __expf(gj + m - mn), an = __expf(mj - mn); n = ao * n + an * dn; m = mn; }
    }
}

DI void ml3_item(KP p, int l, int it, LAS unsigned char* lds) {
    const int tid = tid_l(), lane = tid & 63, wid = tid >> 6, fr = lane & 15, fq = lane >> 4;
    int b, c, h, base, lo, hi; ml_item_geom(it, b, c, h, base, lo, hi);
    if (l == 1 && c < 2) return;
    const u16* proj = (const u16*)(p->ws + WS_R);
    const float* gates = (const float*)(p->ws + WS_GATES);
    u16* Y = (u16*)(p->ws + WS_Y);
    LAS unsigned char* T0 = lds; LAS unsigned char* T1 = lds + TILE_B; LAS unsigned char* T2 = lds + 2 * TILE_B; LAS unsigned char* T3 = T0;
    LAS float* sc_rt = (LAS float*)(lds + SC_OFF);
    LAS float* sc_ct = sc_rt + 256;
    LAS float* sc_in = sc_rt + 512;
    LAS float* sc_em = sc_rt + 768;
    LAS float* sc_n0 = sc_rt + 1024;
    const int srow = tid >> 4, sch = tid & 15;
    u32x4 c0a[4], c0b[4]; u32x2 mor[8];
    { const u16* ca = (const u16*)(p->ws + WS_CST) + (size_t)(((b * 6 + h) * 2 + 0) * NCH + ml_pos(c, 0)) * 16384 + srow * 128 + sch * 8;
      const u16* cb = (const u16*)(p->ws + WS_CST) + (size_t)(((b * 6 + h) * 2 + 1) * NCH + ml_pos(c, 1)) * 16384 + srow * 128 + sch * 8;
#pragma unroll
      for (int i = 0; i < 4; ++i) { c0a[i] = *(const u32x4*)(ca + i * 32 * 128); c0b[i] = *(const u32x4*)(cb + i * 32 * 128); }
      const u16* mo_ = proj + (size_t)(base + 16 * wid + fr) * PLD + OFF_MO + h * 128 + 4 * fq;
#pragma unroll
      for (int nd = 0; nd < 8; ++nd) mor[nd] = *(const u32x2*)(mo_ + 16 * nd); }
    if (wid < 2) { const int d = wid; int t0, t1; float li0, li1, b0, b1;
        ml_gate_scan(gates, base, d, h, p->ml_b_i[l * 12 + d * 6 + h], p->ml_b_f[l * 12 + d * 6 + h], lane, t0, t1, li0, li1, b0, b1);
        const int sq = ((b * 6 + h) * 2 + d) * NCH + ml_pos(c, d);
        const float m0 = ((const float*)(p->ws + WS_M0))[sq];
        const float ct0 = li0 - b0, ct1 = li1 - b1;
        float pm = fmaxf(ct0, ct1);
#pragma unroll
        for (int o = 1; o < 64; o <<= 1) { const float v = __shfl_up(pm, o); if (lane >= o) pm = fmaxf(pm, v); }
        float pe = __shfl_up(pm, 1); if (lane == 0) pe = -INFINITY;
        const float pm0 = fmaxf(pe, ct0), pm1 = pm;
        const float mt0 = fmaxf(b0 + m0, b0 + pm0), mt1 = fmaxf(b1 + m0, b1 + pm1);
        sc_rt[d * 128 + t0] = b0 - mt0; sc_rt[d * 128 + t1] = b1 - mt1;
        sc_ct[d * 128 + t0] = ct0; sc_ct[d * 128 + t1] = ct1;
        sc_in[d * 128 + t0] = __expf(b0 + m0 - mt0); sc_in[d * 128 + t1] = __expf(b1 + m0 - mt1);
        sc_em[d * 128 + t0] = __expf(-mt0); sc_em[d * 128 + t1] = __expf(-mt1);
        const float* n0 = (const float*)(p->ws + WS_NST) + (size_t)sq * 128;
        sc_n0[d * 128 + 2 * lane] = n0[2 * lane]; sc_n0[d * 128 + 2 * lane + 1] = n0[2 * lane + 1]; }
    stage_conv(T0, proj + (size_t)base * PLD + OFF_MQ + h * 128, PLD, lo, hi, p->ml_conv_w + (size_t)l * 4608 + h * 128, p->ml_conv_b + l * 1536 + h * 128, 1.f, tid);
    stage_plain(T1, (const u16*)(p->ws + WS_XN) + (size_t)base * 768 + h * 128, 768, tid);
    stage_plain(T2, proj + (size_t)base * PLD + OFF_MV + h * 128, PLD, tid);
    __syncthreads();
    const int t = 16 * wid + fr;
    bf16x8 Qf[4];
#pragma unroll
    for (int ks = 0; ks < 4; ++ks) Qf[ks] = frag_row(T0, 16 * wid, 32 * ks, lane);
    float nq[2] = {0.f, 0.f};
#pragma unroll
    for (int ks = 0; ks < 4; ++ks) { const u32x4 qv = __builtin_bit_cast(u32x4, Qf[ks]); float q[8]; unpack8(qv, q);
#pragma unroll
        for (int e = 0; e < 8; ++e) { const int k = 32 * ks + 8 * fq + e; nq[0] += q[e] * sc_n0[k]; nq[1] += q[e] * sc_n0[128 + k]; } }
#pragma unroll
    for (int d = 0; d < 2; ++d) { nq[d] += __shfl_xor(nq[d], 16); nq[d] += __shfl_xor(nq[d], 32); }
    f32x4 hs[8];
#pragma unroll
    for (int i = 0; i < 8; ++i) hs[i] = (f32x4){0.f, 0.f, 0.f, 0.f};
#pragma unroll 1
    for (int d = 0; d < 2; ++d) {
        const int sq = ((b * 6 + h) * 2 + d) * NCH + ml_pos(c, d);
        const float nqd = d ? nq[1] : nq[0];
        __syncthreads();
#pragma unroll
        for (int i = 0; i < 4; ++i) { const u32x4 v = d ? c0b[i] : c0a[i]; *(LAS u32x4*)(T3 + toff(srow + 32 * i, sch)) = v; }
        __syncthreads();
        const float rt = sc_rt[d * 128 + t], inter = sc_in[d * 128 + t], em = sc_em[d * 128 + t];
        f32x4 S[8]; float den = 0.f;
#pragma unroll
        for (int n = 0; n < 8; ++n) { S[n] = (f32x4){0.f, 0.f, 0.f, 0.f};
            const bool need = d ? (n >= wid) : (n <= wid);
            if (need) {
#pragma unroll
                for (int ks = 0; ks < 4; ++ks) S[n] = MFMA16(frag_row(T1, 16 * n, 32 * ks, lane), Qf[ks], S[n]);
#pragma unroll
                for (int j = 0; j < 4; ++j) { const int s = 16 * n + 4 * fq + j; const bool valid = d ? (s >= t) : (s <= t);
                    const float w = valid ? __expf(rt + sc_ct[d * 128 + s]) : 0.f; const float pv = S[n][j] * w; S[n][j] = pv; den += pv; }
            }
            __builtin_amdgcn_sched_barrier(0); }
        den += __shfl_xor(den, 16); den += __shfl_xor(den, 32);
        den += inter * nqd;
        bf16x8 Pf[4];
#pragma unroll
        for (int nn = 0; nn < 4; ++nn) { u32x4 o; o.x = pk2(S[2 * nn][0], S[2 * nn][1]); o.y = pk2(S[2 * nn][2], S[2 * nn][3]); o.z = pk2(S[2 * nn + 1][0], S[2 * nn + 1][1]); o.w = pk2(S[2 * nn + 1][2], S[2 * nn + 1][3]); Pf[nn] = __builtin_bit_cast(bf16x8, o); }
        const float inv = 1.f / fmaxf(fabsf(den), em);
#pragma unroll
        for (int nd = 0; nd < 8; ++nd) {
            f32x4 a1 = {0.f, 0.f, 0.f, 0.f}, a2 = {0.f, 0.f, 0.f, 0.f};
#pragma unroll
            for (int nn = 0; nn < 4; ++nn) a1 = MFMA16(frag_tr_perm(T2, 32 * nn, 16 * nd, lane), Pf[nn], a1);
#pragma unroll
            for (int ks = 0; ks < 4; ++ks) a2 = MFMA16(frag_row(T3, 16 * nd, 32 * ks, lane), Qf[ks], a2);
            hs[nd] += (a1 + a2 * inter) * inv;
            __builtin_amdgcn_sched_barrier(0);
        }
    }
    float ss = 0.f;
#pragma unroll
    for (int nd = 0; nd < 8; ++nd) ss += (hs[nd][0] * hs[nd][0] + hs[nd][1] * hs[nd][1]) + (hs[nd][2] * hs[nd][2] + hs[nd][3] * hs[nd][3]);
    ss += __shfl_xor(ss, 16); ss += __shfl_xor(ss, 32);
    const float rstd = rsqrtf(ss * (1.f / 128.f) + EPSN);
    const float* og = p->ml_out_gain + l * 768 + h * 128;
    u16* yr = Y + (size_t)(base + t) * DM + 1280 + h * 128;
#pragma unroll
    for (int nd = 0; nd < 8; ++nd) { const int v0 = 16 * nd + 4 * fq; const u32x2 ov = mor[nd]; const f32x4 gn = *(const f32x4*)(og + v0);
        const float y0 = hs[nd][0] * rstd * gn[0] * sigmoidf_(bf_lo(ov.x)), y1 = hs[nd][1] * rstd * gn[1] * sigmoidf_(bf_hi(ov.x));
        const float y2 = hs[nd][2] * rstd * gn[2] * sigmoidf_(bf_lo(ov.y)), y3 = hs[nd][3] * rstd * gn[3] * sigmoidf_(bf_hi(ov.y));
        u32x2 o; o.x = pk2(y0, y1); o.y = pk2(y2, y3); *(u32x2*)(yr + v0) = o; }
    __syncthreads();
}

#define XB_TMO      128
#define XB_XCNT(j)  (256  + 64 * (j))
#define XB_XSUB(j)  (1280 + 64 * (j))
#define XB_XGEN(j)  (2304 + 64 * (j))
#define XB_TOP      3328
#define XB_TOPGEN   3392
#define XCD_BAR_WORDS 3456
#define XB_SPIN_CAP (1u << 18)

__device__ __forceinline__ unsigned xb_ld(unsigned* p)              { return __hip_atomic_load(p, __ATOMIC_RELAXED, __HIP_MEMORY_SCOPE_AGENT); }
__device__ __forceinline__ unsigned xb_add(unsigned* p, unsigned v) { return __hip_atomic_fetch_add(p, v, __ATOMIC_RELAXED, __HIP_MEMORY_SCOPE_AGENT); }
__device__ __forceinline__ unsigned xb_xcc_id() { return (unsigned)__builtin_amdgcn_s_getreg((3 << 11) | 20) & 0xFu; }
#define XB_SPIN(cond, bar) do { unsigned _sp = 0; while (cond) { __builtin_amdgcn_s_sleep(1); \
    if ((++_sp & 255u) == 0u) { if (xb_ld(&(bar)[XB_TMO])) break; if (_sp > XB_SPIN_CAP) { atomicAdd(&(bar)[XB_TMO], 1u); break; } } } } while (0)

struct XcdBarrier {
    unsigned* bar; unsigned x;
    volatile LAS unsigned* st;
};

__device__ __forceinline__ XcdBarrier xcd_barrier_post(unsigned* bar, volatile LAS unsigned* st) {
    XcdBarrier b; b.bar = bar; b.x = xb_xcc_id(); b.st = st;
    if (threadIdx.x == 0) (void)xb_add(&bar[XB_XCNT(b.x)], 1u);
    return b;
}
__device__ __forceinline__ void xcd_barrier_complete(unsigned* bar, unsigned x, unsigned& nloc, unsigned& nx) {
    const unsigned G = gridDim.x * gridDim.y * gridDim.z;
    unsigned sum, cnt, mine, sp = 0u;
    for (;;) {
        sum = 0u; cnt = 0u; mine = 0u;
#pragma unroll
        for (unsigned j = 0; j < 16; ++j) { const unsigned c = xb_ld(&bar[XB_XCNT(j)]); sum += c; cnt += (c > 0u) ? 1u : 0u; mine = (j == x) ? c : mine; }
        if (sum == G) break;
        __builtin_amdgcn_s_sleep(1);
        if ((++sp & 255u) == 0u) { if (xb_ld(&bar[XB_TMO])) break; if (sp > XB_SPIN_CAP) { atomicAdd(&bar[XB_TMO], 1u); break; } }
    }
    nloc = mine > 0u ? mine : 1u; nx = cnt > 0u ? cnt : 1u;
}

__device__ __forceinline__ void xcd_barrier(const XcdBarrier& b) {
    asm volatile("s_waitcnt vmcnt(0)" ::: "memory");
    __syncthreads();
    if (threadIdx.x == 0) {
        unsigned* bar = b.bar;
        __builtin_amdgcn_s_waitcnt(0);
        unsigned nloc = b.st[0], nx = b.st[1];
        if (nloc == 0u) { xcd_barrier_complete(bar, b.x, nloc, nx); b.st[0] = nloc; b.st[1] = nx; }
        const unsigned old = xb_add(&bar[XB_XSUB(b.x)], 1u);
        const unsigned gen = old / nloc;
        if (old + 1u == (gen + 1u) * nloc) {
            __builtin_amdgcn_fence(__ATOMIC_RELEASE, "agent");
            asm volatile("s_waitcnt vmcnt(0)" ::: "memory");
            const unsigned og = xb_add(&bar[XB_TOP], 1u);
            const unsigned tg = og / nx;
            if (og + 1u == (tg + 1u) * nx) xb_add(&bar[XB_TOPGEN], 1u);
            else XB_SPIN(xb_ld(&bar[XB_TOPGEN]) == tg, bar);
            __builtin_amdgcn_fence(__ATOMIC_ACQUIRE, "agent");
            xb_add(&bar[XB_XGEN(b.x)], 1u);
            asm volatile("s_waitcnt vmcnt(0)" ::: "memory");
        } else {
            XB_SPIN(xb_ld(&bar[XB_XGEN(b.x)]) == gen, bar);
            __builtin_amdgcn_fence(__ATOMIC_ACQUIRE, "agent");
            asm volatile("s_waitcnt vmcnt(0)" ::: "memory");
        }
    }
    __syncthreads();
}

constexpr int N_ATT = 1560, N_ML = 2 * NCH * 6  , N_GM = 260 * 4, N_SCAN = 198, N_ROPE = 260;

DI int next_item(unsigned* ctr, LAS unsigned char* lds) {
    LAS int* slot = (LAS int*)(lds + LDS_BYTES - 16);
    __syncthreads();
    if (threadIdx.x == 0) *slot = (int)atomicAdd(ctr, 1u);
    __syncthreads();
    return *slot;
}

__global__ void __launch_bounds__(512, 2) fwd_megakernel(Params p_unused) {
    const KP kp = (KP)__builtin_amdgcn_kernarg_segment_ptr();
#define PP launder(kp)
    extern __shared__ __attribute__((aligned(16))) unsigned char smem[];
    LAS unsigned char* lds = (LAS unsigned char*)smem;
    cg::grid_group grid = cg::this_grid();
    volatile LAS unsigned* xst = (volatile LAS unsigned*)(lds + LDS_BYTES - 32);
    if (threadIdx.x == 0) { xst[0] = 0u; xst[1] = 0u; }
    __syncthreads();
    { XcdBarrier b0 = xcd_barrier_post((unsigned*)(PP->ws + WS_BAR), xst); (void)b0; }
#define GSYNC() do { XcdBarrier b_; b_.bar = (unsigned*)(PP->ws + WS_BAR); b_.x = xb_xcc_id(); b_.st = xst; xcd_barrier(b_); } while (0)
    phase_prep(PP, lds);
    if (PP->ws == nullptr) grid.sync();
    GSYNC();
    phase_norm0(PP);
    phase_prep2(PP, lds);
    GSYNC();
    for (int l = 0; l < 2; ++l) {
        const int stage = l;
        const int Mres = l == 0 ? MROWS : RLAT;
        unsigned* ctr = (unsigned*)(PP->ws + WS_CTR) + l * 4;
        { EpiProj E; E.O = (u16*)(PP->ws + WS_R); E.gates = (float*)(PP->ws + WS_GATES);
          E.ss = (const float*)(PP->ws + WS_SS) + (l == 0 ? 3 : 1) * MROWS; E.bias0 = (const float*)(PP->ws + WS_BIASP) + (size_t)l * 3 * NPROJ;
          run_gemm(lds, (const u16*)(PP->ws + WS_XN), (const u16*)(PP->ws + WS_WIN + l * SZ_WIN), MROWS, PLD, DM, E); }
        for (;;) { const int it = next_item(ctr + 3, lds); if (it >= 260) break; gate_item(PP, l, it, lds); }
        GSYNC();
        for (;;) { const int it = next_item(ctr + 0, lds); if (it >= N_ROPE + N_ML) break; if (it < N_ROPE) rope_item(PP, it); else ml1_item(PP, l, it - N_ROPE, lds); }
        GSYNC();
        for (;;) { const int it = next_item(ctr + 1, lds); if (it >= N_SCAN + N_ATT + N_GM) break;
            if (it < N_SCAN) scan_item(PP, it);
            else if (it < N_SCAN + N_ATT) attn_item(PP, l, it - N_SCAN, lds);
            else gmlp_item(PP, l, it - N_SCAN - N_ATT, lds); }
        GSYNC();
        for (;;) { const int it = next_item(ctr + 2, lds); if (it >= N_ML) break; ml3_item(PP, l, it, lds); }
        GSYNC();
        { EpiRes E; E.p = PP; E.stage = stage; E.gate0 = (const float*)(PP->ws + WS_MOD) + (size_t)l * 3 * 12288 + 2 * DM;
          E.gs0 = (const float*)(PP->ws + WS_GS) + (size_t)(l * 2 + 1) * 3 * DM; E.ssn = (float*)(PP->ws + WS_SS) + (l == 0 ? 0 : 2) * MROWS; E.ntfull = DM / 64;
          run_gemm_split(lds, (const u16*)(PP->ws + WS_Y), (const u16*)(PP->ws + WS_WOUT + l * SZ_WOUT), RLAT, DM, DM, l == 0 ? 4 : 0, E); }
        GSYNC();
        if (l == 0) { phase_ctx_norm(PP, (const float*)(PP->ws + WS_GS) + (size_t)((0 * 2 + 1) * 3 + 2) * DM, (float*)(PP->ws + WS_SS) + 0 * MROWS, 4); GSYNC(); }
        { EpiSqRelu E; E.O = (u16*)(PP->ws + WS_R); E.ss = (const float*)(PP->ws + WS_SS) + (l == 0 ? 0 : 2) * MROWS; E.bias0 = (const float*)(PP->ws + WS_BIASF) + (size_t)l * 3 * DFF;
          run_gemm(lds, (const u16*)(PP->ws + WS_XN), (const u16*)(PP->ws + WS_WFF1 + l * SZ_WFF), Mres, DFF, DM, E); }
        GSYNC();
        { EpiRes E; E.p = PP; E.stage = 1; E.gate0 = (const float*)(PP->ws + WS_MOD) + (size_t)l * 3 * 12288 + 5 * DM;
          E.gs0 = l == 0 ? (const float*)(PP->ws + WS_GS) + (size_t)(1 * 2 + 0) * 3 * DM : nullptr; E.ssn = (float*)(PP->ws + WS_SS) + 1 * MROWS; E.ntfull = DFF / 64;
          run_gemm_split(lds, (const u16*)(PP->ws + WS_R), (const u16*)(PP->ws + WS_WFF2 + l * SZ_WFF), RLAT, DM, DFF, l == 0 ? 16 : 0, E); }
        GSYNC();
        if (l == 0) { phase_ctx_norm(PP, (const float*)(PP->ws + WS_GS) + (size_t)((1 * 2 + 0) * 3 + 2) * DM, (float*)(PP->ws + WS_SS) + 1 * MROWS, 16); GSYNC(); }
    }
    phase_final(PP);
#undef GSYNC
#undef PP
}

extern "C" void kernel_launch(void* const* d_in, const int* in_sizes, int n_in, void* d_out, int out_size, void* d_ws, size_t ws_size, hipStream_t stream) {
    static int grid_blocks = 0;
    if (grid_blocks == 0) {
        if (n_in != 22 || ws_size < WS_END || out_size != RLAT * DM) { fprintf(stderr, "kernel_launch: unexpected shapes (n_in %d ws %zu need %zu out %d)\n", n_in, ws_size, (size_t)WS_END, out_size); grid_blocks = -1; return; }
        int dev = 0, cus = 0, per_cu = 0;
        hipGetDevice(&dev);
        hipDeviceGetAttribute(&cus, hipDeviceAttributeMultiprocessorCount, dev);
        if (hipFuncSetAttribute((const void*)fwd_megakernel, hipFuncAttributeMaxDynamicSharedMemorySize, LDS_BYTES) != hipSuccess) { fprintf(stderr, "kernel_launch: hipFuncSetAttribute failed\n"); grid_blocks = -1; return; }
        hipOccupancyMaxActiveBlocksPerMultiprocessor(&per_cu, (const void*)fwd_megakernel, 512, LDS_BYTES);
        if (per_cu < 1) { fprintf(stderr, "kernel_launch: occupancy query says %d blocks per CU\n", per_cu); per_cu = 1; }
        (void)hipGetLastError();
        grid_blocks = cus * 1;
    }
    if (grid_blocks < 0) return;
    if (hipMemsetAsync((unsigned char*)d_ws + WS_BAR, 0, 16384, stream) != hipSuccess) { fprintf(stderr, "kernel_launch: memset failed\n"); return; }
    Params p{};
    const float** pp = (const float**)&p;
    for (int i = 0; i < 22; ++i) pp[i] = (const float*)d_in[i];
    p.out = (float*)d_out; p.ws = (unsigned char*)d_ws;
    void* args[] = {&p};
    hipError_t e = hipLaunchCooperativeKernel((const void*)fwd_megakernel, dim3(grid_blocks), dim3(512), args, LDS_BYTES, stream);
    if (e != hipSuccess) fprintf(stderr, "cooperative launch failed: %s (grid %d)\n", hipGetErrorString(e), grid_blocks);
}
```

```cpp
#include <hip/hip_runtime.h>
#include <hip/hip_cooperative_groups.h>
#include <cstdio>
namespace cg = cooperative_groups;
namespace pg8 {
#define PG8_LAS __attribute__((address_space(3)))
typedef unsigned short bf16_t;
typedef short bf16x8 __attribute__((ext_vector_type(8)));
typedef float f32x4 __attribute__((ext_vector_type(4)));
typedef unsigned u32x4 __attribute__((ext_vector_type(4)));
constexpr int BM = 256, BK = 64, HALF = 128, HTB = HALF * BK * 2  , STAGE_BYTES = 8 * HTB, NXCD = 8, WGM = 8;

__host__ __device__ __forceinline__ int lds_byte(int r, int c) { const int st = (r >> 4) * 2 + (c >> 5), rr = r & 15, cc = c & 31, ob = rr * 64 + cc * 2; return st * 1024 + (ob ^ (((ob >> 9) & 1) << 5)); }
__host__ __device__ __forceinline__ void stage_rc(int b, int& R, int& C) { const int st = b / 1024, sb = b % 1024, swz = sb ^ (((sb >> 9) & 1) << 5); R = (st >> 1) * 16 + swz / 64; C = (st & 1) * 32 + (swz % 64) / 2; }
__host__ __device__ __forceinline__ int perm32(int rho) { const int n = rho >> 4, i = rho & 15; return 8 * (i >> 2) + 4 * n + (i & 3); }

struct Unit { int pm, pn, koff, nt; };
struct Gemm { const bf16_t* A; const bf16_t* Bt; int M, N, K; };

struct StaticOrder {
    int nM, nN, nwg, G, c, ntf, wgm;
    __host__ __device__ void init(int M, int N, int K, int G_, int c_) { nM = M / BM; nN = N / BM; nwg = nM * nN; G = G_; c = c_; ntf = K / BK; wgm = WGM; }
    __host__ __device__ bool next(int i, Unit& u) const {
        const long L = (long)i * G + c; if (L >= nwg) return false;
        int wgid = (int)L; { const int q = nwg / NXCD, r = nwg % NXCD, xcd = wgid % NXCD, off = wgid / NXCD; wgid = (xcd < r ? xcd * (q + 1) : r * (q + 1) + (xcd - r) * q) + off; }
        const int nig = wgm * nN, gid = wgid / nig, fm = gid * wgm, gsz = (nM - fm) < wgm ? (nM - fm) : wgm;
        u.pm = fm + ((wgid % nig) % gsz); u.pn = (wgid % nig) / gsz; u.koff = 0; u.nt = ntf; return true;
    }
    __device__ __forceinline__ void a_ready(const Unit&) const {}
    __device__ __forceinline__ void done(const Unit&) const {}
};
template <class Epi, class Sched, bool STAMP = false>
__device__ __forceinline__ void gemm_phase(PG8_LAS unsigned char* lds, const Gemm g, const Sched& S, const Epi& E, unsigned long long* stamps) {
    int tid_ = threadIdx.x; asm volatile("" : "+v"(tid_)); const int tid = tid_, wid = __builtin_amdgcn_readfirstlane(tid >> 6), lane = tid & 63, wr = wid >> 2, wc = wid & 3, fr = lane & 15, fq = lane >> 4;
    const int K = g.K;
    int ts_lo = 0, ts_hi = 0, nts = 0; const unsigned long long rt_entry = STAMP ? (unsigned long long)wall_clock64() : 0ull;
#define PG8_STAMP() do { if (STAMP && wid == 0 && nts < 64) { const unsigned long long _c = (unsigned long long)clock64(); \
        ts_lo = (lane == nts) ? (int)(unsigned)_c : ts_lo; ts_hi = (lane == nts) ? (int)(unsigned)(_c >> 32) : ts_hi; ++nts; } } while (0)
    PG8_STAMP();
    unsigned voffA[2], voffB[2];
#pragma unroll
    for (int i = 0; i < 2; ++i) { int R, C; stage_rc(tid * 16 + i * 8192, R, C); const int Rb = Epi::PERM ? ((R & ~31) + perm32(R & 31)) : R;
        voffA[i] = (unsigned)(R * K + C) * 2u; voffB[i] = (unsigned)(Rb * K + C) * 2u; }
    const size_t kstep = (size_t)(BK * 2);
    const size_t hstep = (size_t)HALF * K * 2;
    const size_t tstep = 2 * hstep;
    const unsigned ldsw = (unsigned)wid * 1024u;
    const int aoff = lds_byte(wr * 64 + fr, fq * 8), boff = lds_byte(wc * 32 + fr, fq * 8);
#define PG8_SA(b, h) (((b) * 2 + (h)) * HTB)
#define PG8_SB(b, h) ((4 + (b) * 2 + (h)) * HTB)
#define PG8_STAGE(bufoff, gbase, voff) do { _Pragma("unroll") for (int _i = 0; _i < 2; ++_i) \
        __builtin_amdgcn_global_load_lds((const unsigned*)((const char*)(gbase) + (voff)[_i]), (PG8_LAS unsigned*)(lds + (bufoff) + ldsw + _i * 8192), 16, 0, 0); } while (0)
#define PG8_LDA(dst, b, h) do { _Pragma("unroll") for (int m = 0; m < 4; ++m) _Pragma("unroll") for (int k = 0; k < 2; ++k) dst[m][k] = *(const PG8_LAS bf16x8*)(lds + PG8_SA(b, h) + aoff + m * 2048 + k * 1024); } while (0)
#define PG8_LDB(dst, b, h) do { _Pragma("unroll") for (int n = 0; n < 2; ++n) _Pragma("unroll") for (int k = 0; k < 2; ++k) dst[n][k] = *(const PG8_LAS bf16x8*)(lds + PG8_SB(b, h) + boff + n * 2048 + k * 1024); } while (0)
#define PG8_MMA(ai, bj, At, Bt) do { __builtin_amdgcn_s_setprio(1); _Pragma("unroll") for (int m = 0; m < 4; ++m) _Pragma("unroll") for (int n = 0; n < 2; ++n) _Pragma("unroll") for (int k = 0; k < 2; ++k) \
        acc[ai][bj][m][n] = __builtin_amdgcn_mfma_f32_16x16x32_bf16(Bt[n][k], At[m][k], acc[ai][bj][m][n], 0, 0, 0); __builtin_amdgcn_s_setprio(0); } while (0)
#define PG8_WAIT_V(n) asm volatile("s_waitcnt vmcnt(" #n ")" ::: "memory")
#define PG8_WAIT_L(n) asm volatile("s_waitcnt lgkmcnt(" #n ")" ::: "memory")
#define PG8_BAR __builtin_amdgcn_s_barrier()
#define PG8_SCHED __builtin_amdgcn_sched_barrier(0)
    Unit cur, nxt; int ui = 0;
    if (!S.next(0, cur)) return;
    f32x4 acc[2][2][4][2];
#pragma unroll
    for (int a = 0; a < 2; ++a)
#pragma unroll
        for (int b = 0; b < 2; ++b)
#pragma unroll
            for (int m = 0; m < 4; ++m)
#pragma unroll
                for (int n = 0; n < 2; ++n) acc[a][b][m][n] = (f32x4){0.f, 0.f, 0.f, 0.f};
    bf16x8 At[4][2], B0[2][2], B1[2][2];
    const char* cA = (const char*)g.A + (size_t)cur.pm * tstep + (size_t)cur.koff * 2; const char* cB = (const char*)g.Bt + (size_t)cur.pn * tstep + (size_t)cur.koff * 2;
    S.a_ready(cur);
    PG8_STAGE(PG8_SB(0, 0), cB, voffB); PG8_STAGE(PG8_SA(0, 0), cA, voffA); PG8_STAGE(PG8_SB(0, 1), cB + hstep, voffB); PG8_STAGE(PG8_SA(0, 1), cA + hstep, voffA);
    if (wr == 1) PG8_BAR;
    PG8_WAIT_V(4); PG8_BAR;
    PG8_STAGE(PG8_SB(1, 0), cB + kstep, voffB); PG8_STAGE(PG8_SA(1, 0), cA + kstep, voffA); PG8_STAGE(PG8_SB(1, 1), cB + hstep + kstep, voffB);
    PG8_WAIT_V(6); PG8_BAR;
    PG8_STAMP();
    for (;;) {
        const bool has_next = S.next(ui + 1, nxt);
        const char* nA = has_next ? (const char*)g.A + (size_t)nxt.pm * tstep + (size_t)nxt.koff * 2 : cA; const char* nB = has_next ? (const char*)g.Bt + (size_t)nxt.pn * tstep + (size_t)nxt.koff * 2 : cB;
        const int nt = cur.nt;
        for (int t = 0; t < nt; t += 2) {
            const bool last = (t == nt - 2);
            const char* a1 = cA + (size_t)(t + 1) * kstep;
            const char* a2 = last ? nA : cA + (size_t)(t + 2) * kstep; const char* b2 = last ? nB : cB + (size_t)(t + 2) * kstep;
            const char* a3 = a2 + kstep; const char* b3 = b2 + kstep;
            if (last && has_next) S.a_ready(nxt);
            PG8_LDB(B0, 0, 0); PG8_SCHED; PG8_LDA(At, 0, 0); PG8_STAGE(PG8_SA(1, 1), a1 + hstep, voffA);
            PG8_WAIT_L(8); PG8_BAR; PG8_WAIT_L(0); PG8_MMA(0, 0, At, B0); PG8_BAR; PG8_SCHED;
            PG8_LDB(B1, 0, 1); PG8_STAGE(PG8_SB(0, 0), b2, voffB);
            PG8_BAR; PG8_WAIT_L(0); PG8_MMA(0, 1, At, B1); PG8_BAR;
            PG8_LDA(At, 0, 1); PG8_STAGE(PG8_SA(0, 0), a2, voffA);
            PG8_BAR; PG8_WAIT_L(0); PG8_MMA(1, 0, At, B0); PG8_BAR; PG8_SCHED;
            PG8_STAGE(PG8_SB(0, 1), b2 + hstep, voffB);
            PG8_WAIT_V(6); PG8_BAR; PG8_MMA(1, 1, At, B1); PG8_BAR;
            PG8_LDB(B0, 1, 0); PG8_SCHED; PG8_LDA(At, 1, 0); PG8_STAGE(PG8_SA(0, 1), a2 + hstep, voffA);
            PG8_WAIT_L(8); PG8_BAR; PG8_WAIT_L(0); PG8_MMA(0, 0, At, B0); PG8_BAR; PG8_SCHED;
            PG8_LDB(B1, 1, 1); PG8_STAGE(PG8_SB(1, 0), b3, voffB);
            PG8_BAR; PG8_WAIT_L(0); PG8_MMA(0, 1, At, B1); PG8_BAR;
            PG8_LDA(At, 1, 1); PG8_STAGE(PG8_SA(1, 0), a3, voffA);
            PG8_BAR; PG8_WAIT_L(0); PG8_MMA(1, 0, At, B0); PG8_BAR; PG8_SCHED;
            PG8_STAGE(PG8_SB(1, 1), b3 + hstep, voffB);
            PG8_WAIT_V(6); PG8_BAR; PG8_MMA(1, 1, At, B1); PG8_BAR;
        }
        PG8_STAMP();
        if constexpr (!Epi::AFTER_DRAIN) { E(acc, cur, wr, wc, fr, fq); S.done(cur); }
        PG8_STAMP();
        if (!has_next) break;
#pragma unroll
        for (int a = 0; a < 2; ++a)
#pragma unroll
            for (int b = 0; b < 2; ++b)
#pragma unroll
                for (int m = 0; m < 4; ++m)
#pragma unroll
                    for (int n = 0; n < 2; ++n) acc[a][b][m][n] = (f32x4){0.f, 0.f, 0.f, 0.f};
        cur = nxt; cA = nA; cB = nB; ++ui;
    }
    PG8_WAIT_V(0);
    if (wr == 0) PG8_BAR;
    PG8_BAR;
    if constexpr (Epi::AFTER_DRAIN) { E.fused(acc, cur, wr, wc, fr, fq, lds, wid, lane); S.done(cur); }
    PG8_STAMP();
    if (STAMP && wid == 0) { stamps[lane] = lane < nts ? (((unsigned long long)(unsigned)ts_hi << 32) | (unsigned)ts_lo) : 0ull;
        if (lane == 62) stamps[62] = rt_entry; if (lane == 63) stamps[63] = (unsigned long long)wall_clock64(); }
#undef PG8_STAMP
#undef PG8_SA
#undef PG8_SB
#undef PG8_STAGE
#undef PG8_LDA
#undef PG8_LDB
#undef PG8_MMA
#undef PG8_WAIT_V
#undef PG8_WAIT_L
#undef PG8_BAR
#undef PG8_SCHED
}
}

#define LAS __attribute__((address_space(3)))
typedef unsigned short u16;
typedef short s16x4 __attribute__((ext_vector_type(4)));
typedef unsigned u32x2 __attribute__((ext_vector_type(2)));
typedef __bf16 bf2_t __attribute__((ext_vector_type(2)));
typedef float f2_t __attribute__((ext_vector_type(2)));
using pg8::bf16x8; using pg8::f32x4; using pg8::u32x4;

constexpr int DM = 2048, SEQ = 16384, RLAT = 32768, LCTX = 256, MROWS = 33280, DFF = 8192;
constexpr int PLD = 5376, NPROJ = 5632, NIN = 5400;
constexpr int OFF_GU = 0, OFF_GV = 512, OFF_AQ = 1024, OFF_AK = 1792, OFF_AV = 2048, OFF_MQ = 2304, OFF_MK = 3072, OFF_MV = 3840, OFF_MO = 4608;
constexpr int NCH = 130;
constexpr int NSEQ = 24;
constexpr float EPSN = 1e-6f;
constexpr float LOG2E = 1.4426950408889634f;
constexpr float QSCALE = 0.08838834764831845f;

constexpr size_t WS_WIN = 0;
constexpr size_t SZ_WIN = (size_t)NPROJ * DM * 2;
constexpr size_t WS_WOUT = WS_WIN + 2 * SZ_WIN;
constexpr size_t SZ_WOUT = (size_t)DM * DM * 2;
constexpr size_t WS_WFF1 = WS_WOUT + 2 * SZ_WOUT;
constexpr size_t SZ_WFF = (size_t)DFF * DM * 2;
constexpr size_t WS_WFF2 = WS_WFF1 + 2 * SZ_WFF;
constexpr size_t WS_MOD = WS_WFF2 + 2 * SZ_WFF;
constexpr size_t WS_ROPE = WS_MOD + 2 * 3 * 12288 * 4;
constexpr size_t WS_XC = WS_ROPE + 320 * 32 * 8;
constexpr size_t WS_GATES = WS_XC + (size_t)512 * DM * 4;
constexpr size_t WS_NST = WS_GATES + (size_t)MROWS * 32 * 4;
constexpr size_t WS_GSC = WS_NST + (size_t)NSEQ * NCH * 128 * 4;
constexpr size_t WS_MLS = WS_GSC + 16384;
constexpr size_t WS_M0 = WS_MLS + 16384;
constexpr size_t WS_SS = WS_M0 + 16384;
constexpr size_t WS_BIASP = WS_SS + (size_t)4 * MROWS * 4;
constexpr size_t WS_BIASF = WS_BIASP + (size_t)2 * 3 * NPROJ * 4;
constexpr size_t WS_GS = WS_BIASF + (size_t)2 * 3 * DFF * 4;
constexpr size_t WS_CTR = WS_GS + (size_t)2 * 2 * 3 * DM * 4;
constexpr size_t WS_BAR = WS_CTR + 256;
constexpr size_t WS_XN = WS_BAR + 16384;
constexpr size_t WS_R = WS_XN + (size_t)MROWS * DM * 2;
constexpr size_t SZ_PROJ = (size_t)MROWS * PLD * 2;
constexpr size_t WS_Y = WS_R + SZ_PROJ;
constexpr size_t SZ_H = (size_t)MROWS * DFF * 2;
constexpr size_t WS_CST = WS_R + SZ_H;
constexpr size_t WS_END = WS_CST + (size_t)NSEQ * NCH * 16384 * 2;

constexpr int LDS_BYTES = 163840;
constexpr int TSTR = 320;
constexpr int TILE_B = 128 * TSTR;
constexpr int SC_OFF = 3 * TILE_B;

struct Params {
    const float *x, *c, *ctx, *c_ctx, *w_ada, *b_ada, *g_mix, *g_ffn, *w_in, *gm_v_gain, *gm_w_s, *gm_b_s, *attn_sink,
        *ml_conv_w, *ml_conv_b, *ml_b_i, *ml_b_f, *ml_out_gain, *w_out, *w_ff1, *w_ff2, *g_final;
    float* out; unsigned char* ws;
};

#define DI __device__ __forceinline__
typedef const __attribute__((address_space(4))) Params* KP;
DI int tid_l() { int t = threadIdx.x; asm volatile("" : "+v"(t)); return t; }
DI KP launder(KP p) { asm volatile("" : "+s"(p)); return p; }
DI unsigned pk2(float lo, float hi) { bf2_t v = __builtin_convertvector((f2_t){lo, hi}, bf2_t); return __builtin_bit_cast(unsigned, v); }
DI float bf_lo(unsigned u) { return __uint_as_float(u << 16); }
DI float bf_hi(unsigned u) { return __uint_as_float(u & 0xffff0000u); }
DI float wave_sum(float v) {
#pragma unroll
    for (int o = 1; o < 64; o <<= 1) v += __shfl_xor(v, o);
    return v;
}
DI float wave_max(float v) {
#pragma unroll
    for (int o = 1; o < 64; o <<= 1) v = fmaxf(v, __shfl_xor(v, o));
    return v;
}
DI float gelu_tanh(float x) {
    const float k1 = -2.f * 0.7978845608028654f * LOG2E, k2 = k1 * 0.044715f;
    const float a = x * __builtin_fmaf(x * x, k2, k1);
    return x * __builtin_amdgcn_rcpf(1.f + __builtin_amdgcn_exp2f(a));
}
DI float sigmoidf_(float x) { return __builtin_amdgcn_rcpf(1.f + __builtin_amdgcn_exp2f(-LOG2E * x)); }
DI float log_sigmoid(float x) { return fminf(x, 0.f) - log1pf(__expf(-fabsf(x))); }
DI void unpack8(const u32x4 v, float* f) { f[0] = bf_lo(v.x); f[1] = bf_hi(v.x); f[2] = bf_lo(v.y); f[3] = bf_hi(v.y); f[4] = bf_lo(v.z); f[5] = bf_hi(v.z); f[6] = bf_lo(v.w); f[7] = bf_hi(v.w); }
DI u32x4 pack8(const float* f) { u32x4 o; o.x = pk2(f[0], f[1]); o.y = pk2(f[2], f[3]); o.z = pk2(f[4], f[5]); o.w = pk2(f[6], f[7]); return o; }
#define MFMA16(a, b, c) __builtin_amdgcn_mfma_f32_16x16x32_bf16((a), (b), (c), 0, 0, 0)

DI int toff(int row, int ch) { return row * TSTR + 16 * ch; }
DI bf16x8 frag_row(const LAS unsigned char* tile, int idx0, int k0, int lane) {
    return *(const LAS bf16x8*)(tile + toff(idx0 + (lane & 15), (k0 >> 3) + (lane >> 4)));
}
DI bf16x8 tr_pair(const LAS unsigned char* p, const LAS unsigned char* p2) {
    s16x4 a = __builtin_amdgcn_ds_read_tr16_b64_v4i16((LAS s16x4*)p);
    s16x4 b = __builtin_amdgcn_ds_read_tr16_b64_v4i16((LAS s16x4*)p2);
    return (bf16x8){a[0], a[1], a[2], a[3], b[0], b[1], b[2], b[3]};
}
DI bf16x8 frag_tr(const LAS unsigned char* tile, int k0, int idx0, int lane) {
    const int i = lane & 15, q = lane >> 4, row = k0 + 8 * q + (i >> 2), ch = (idx0 >> 3) + ((i & 3) >> 1), sub = 8 * (i & 1);
    return tr_pair(tile + toff(row, ch) + sub, tile + toff(row + 4, ch) + sub);
}
DI bf16x8 frag_tr_perm(const LAS unsigned char* tile, int k0, int idx0, int lane) {
    const int i = lane & 15, q = lane >> 4, row = k0 + 4 * q + (i >> 2), ch = (idx0 >> 3) + ((i & 3) >> 1), sub = 8 * (i & 1);
    const LAS unsigned char* a = tile + toff(row, ch) + sub;
    return tr_pair(a, a + 16 * TSTR);
}

DI const float* xrow_in(KP p, int stage, int row) {
    if (row < RLAT) return (stage ? (const float*)p->out : p->x) + (size_t)row * DM;
    return (stage ? (const float*)(p->ws + WS_XC) : p->ctx) + (size_t)(row - RLAT) * DM;
}
DI float* xrow_out(KP p, int row) {
    if (row < RLAT) return p->out + (size_t)row * DM;
    return (float*)(p->ws + WS_XC) + (size_t)(row - RLAT) * DM;
}
DI int mod_index(int row) { return row < SEQ ? 0 : (row < RLAT ? 1 : 2); }
DI float row_rstd(const float* ss, int row) { return rsqrtf(ss[row] * (1.f / DM) + EPSN); }

DI void transpose_item(const float* W, int K, int N, u16* WT, LAS float* scr  , int item, int nblk, int lane) {
    const int kb = item / nblk, nb = item % nblk, k0 = 64 * kb, n0 = 64 * nb;
    const int c4 = lane & 15, rr = lane >> 4;
    const bool ok = n0 + 4 * c4 < N;
    f32x4 v[16];
#pragma unroll
    for (int i = 0; i < 16; ++i) v[i] = ok ? *(const f32x4*)(W + (size_t)(k0 + 4 * i + rr) * N + n0 + 4 * c4) : (f32x4){0.f, 0.f, 0.f, 0.f};
#pragma unroll
    for (int i = 0; i < 16; ++i) { LAS float* d = scr + (4 * i + rr) * 65 + 4 * c4; d[0] = v[i].x; d[1] = v[i].y; d[2] = v[i].z; d[3] = v[i].w; }
    asm volatile("s_waitcnt lgkmcnt(0)" ::: "memory"); __builtin_amdgcn_wave_barrier();
    const int c = lane & 7;
#pragma unroll
    for (int j = 0; j < 8; ++j) { const int nn = (lane >> 3) + 8 * j; const LAS float* q = scr + (8 * c) * 65 + nn;
        u32x4 o; o.x = pk2(q[0 * 65], q[1 * 65]); o.y = pk2(q[2 * 65], q[3 * 65]); o.z = pk2(q[4 * 65], q[5 * 65]); o.w = pk2(q[6 * 65], q[7 * 65]);
        *(u32x4*)(WT + (size_t)(n0 + nn) * K + k0 + 8 * c) = o; }
    asm volatile("s_waitcnt lgkmcnt(0)" ::: "memory"); __builtin_amdgcn_wave_barrier();
}

DI void phase_prep(KP p, LAS unsigned char* lds) {
    const int tid = tid_l(), lane = tid & 63, wave = tid >> 6, bid = blockIdx.x, G = gridDim.x;
    { float* SS = (float*)(p->ws + WS_SS);
      for (int i = bid * 512 + tid; i < 3 * MROWS; i += G * 512) SS[i] = 0.f;
      if (bid == 0 && tid < 64) ((unsigned*)(p->ws + WS_CTR))[tid] = 0u; }
    { const f32x4* src = (const f32x4*)p->ctx; f32x4* dst = (f32x4*)(p->ws + WS_XC);
      for (int i = bid * 512 + tid; i < 512 * DM / 4; i += G * 512) dst[i] = src[i]; }
    {
        LAS float* sv = (LAS float*)lds;
        LAS float* red = (LAS float*)(lds + 3 * 2048 * 4);
        for (int i = tid; i < 3 * 2048; i += 512) { const int v = i >> 11, k = i & 2047; const float x = v == 0 ? p->c[k] : (v == 1 ? p->c[2048 + k] : p->c_ctx[k]); sv[i] = x * sigmoidf_(x); }
        __syncthreads();
        float* MOD = (float*)(p->ws + WS_MOD);
        for (int it = bid; it < 2 * 384; it += G) {
            const int l = it / 384, n0 = (it % 384) * 32, j = tid & 7, kk = tid >> 3;
            const float* w = p->w_ada + (size_t)l * 2048 * 12288 + n0 + 4 * j;
            f32x4 a0 = {0, 0, 0, 0}, a1 = a0, a2 = a0;
#pragma unroll 16
            for (int k = kk; k < 2048; k += 64) { const f32x4 wv = *(const f32x4*)(w + (size_t)k * 12288); a0 += wv * sv[k]; a1 += wv * sv[2048 + k]; a2 += wv * sv[4096 + k]; }
            LAS float* r = red + (kk * 8 + j) * 12;
            *(LAS f32x4*)(r) = a0; *(LAS f32x4*)(r + 4) = a1; *(LAS f32x4*)(r + 8) = a2;
            __syncthreads();
            if (tid < 96) { const int v = tid >> 5, cc = tid & 31, jj = cc >> 2, e = cc & 3; float sum = 0.f;
                for (int q = 0; q < 64; ++q) sum += red[(q * 8 + jj) * 12 + v * 4 + e];
                MOD[(size_t)(l * 3 + v) * 12288 + n0 + cc] = sum + p->b_ada[l * 12288 + n0 + cc]; }
            __syncthreads();
        }
    }
    {
        f2_t* ROPE = (f2_t*)(p->ws + WS_ROPE);
        for (int i = bid * 512 + tid; i < 320 * 32; i += G * 512) { const int pos = i >> 5, f = i & 31; const int pa = pos < 256 ? pos : pos - 256;
            const float freq = 1.0f / powf(10000.0f, (float)(2 * f) / 64.0f); const float ang = (float)pa * freq; ROPE[i] = (f2_t){cosf(ang), sinf(ang)}; }
    }
    {
        LAS float* scr = (LAS float*)(lds + wave * 16640);
        const int gw = bid * 8 + wave, NGW = G * 8;
        constexpr int I_IN = 32 * 88, I_OUT = 32 * 32, I_F1 = 32 * 128, I_F2 = 128 * 32, I_L = I_IN + I_OUT + I_F1 + I_F2;
        for (int it = gw; it < 2 * I_L; it += NGW) {
            const int l = it / I_L; int r = it % I_L;
            if (r < I_IN) { transpose_item(p->w_in + (size_t)l * DM * NIN, DM, NIN, (u16*)(p->ws + WS_WIN + l * SZ_WIN), scr, r, 88, lane); continue; } r -= I_IN;
            if (r < I_OUT) { transpose_item(p->w_out + (size_t)l * DM * DM, DM, DM, (u16*)(p->ws + WS_WOUT + l * SZ_WOUT), scr, r, 32, lane); continue; } r -= I_OUT;
            if (r < I_F1) { transpose_item(p->w_ff1 + (size_t)l * DM * DFF, DM, DFF, (u16*)(p->ws + WS_WFF1 + l * SZ_WFF), scr, r, 128, lane); continue; } r -= I_F1;
            transpose_item(p->w_ff2 + (size_t)l * DFF * DM, DFF, DM, (u16*)(p->ws + WS_WFF2 + l * SZ_WFF), scr, r, 32, lane);
        }
    }
}

DI void phase_prep2(KP p, LAS unsigned char* lds) {
    const int tid = tid_l(), lane = tid & 63, wave = tid >> 6, bid = blockIdx.x, G = gridDim.x;
    const float* MOD = (const float*)(p->ws + WS_MOD);
    { float* GS = (float*)(p->ws + WS_GS);
      for (int i = bid * 512 + tid; i < 2 * 2 * 3 * DM; i += G * 512) { const int k = i & 2047, cls = (i >> 11) % 3, which = (i / (3 * DM)) & 1, l = i / (6 * DM);
          GS[i] = (which ? p->g_ffn : p->g_mix)[l * DM + k] * (1.f + MOD[(size_t)(l * 3 + cls) * 12288 + (which * 3 + 1) * DM + k]); } }
    LAS float* sh = (LAS float*)lds;
    const int gw = bid * 8 + wave, NGW = G * 8;
    for (int l = 0; l < 2; ++l) {
        __syncthreads();
        for (int i = tid; i < 6 * DM; i += 512) { const int k = i & 2047, cls = (i >> 11) % 3, which = i / (3 * DM); sh[i] = MOD[(size_t)(l * 3 + cls) * 12288 + (which * 3) * DM + k]; }
        __syncthreads();
        for (int r = gw; r < NPROJ + DFF; r += NGW) {
            const bool isf = r >= NPROJ; const int n = isf ? r - NPROJ : r;
            const u16* wrow = isf ? (const u16*)(p->ws + WS_WFF1 + l * SZ_WFF) + (size_t)n * DM : (const u16*)(p->ws + WS_WIN + l * SZ_WIN) + (size_t)n * DM;
            const LAS float* s0 = sh + (isf ? 3 * DM : 0);
            float a0 = 0.f, a1 = 0.f, a2 = 0.f;
#pragma unroll
            for (int j = 0; j < 4; ++j) { const int k = 8 * (lane + 64 * j); float w[8]; unpack8(*(const u32x4*)(wrow + k), w);
#pragma unroll
                for (int e = 0; e < 8; ++e) { a0 += w[e] * s0[k + e]; a1 += w[e] * s0[DM + k + e]; a2 += w[e] * s0[2 * DM + k + e]; } }
            a0 = wave_sum(a0); a1 = wave_sum(a1); a2 = wave_sum(a2);
            if (lane == 0) { float* B = isf ? (float*)(p->ws + WS_BIASF) + (size_t)l * 3 * DFF : (float*)(p->ws + WS_BIASP) + (size_t)l * 3 * NPROJ; const int N = isf ? DFF : NPROJ;
                B[n] = a0; B[N + n] = a1; B[2 * N + n] = a2; }
        }
    }
}

DI void phase_norm0(KP p) {
    const int tid = tid_l(), lane = tid & 63, gw = blockIdx.x * 8 + (tid >> 6), NGW = gridDim.x * 8;
    const float* gain = p->g_mix;
    u16* XN = (u16*)(p->ws + WS_XN);
    float* SS = (float*)(p->ws + WS_SS) + 3 * MROWS;
    f32x4 v[8], nx[8];
    if (gw < MROWS) { const float* xr = xrow_in(p, 0, gw);
#pragma unroll
        for (int j = 0; j < 8; ++j) v[j] = *(const f32x4*)(xr + 4 * lane + 256 * j); }
    for (int row = gw; row < MROWS; row += NGW) {
        const int nrow = row + NGW;
        if (nrow < MROWS) { const float* xr = xrow_in(p, 0, nrow);
#pragma unroll
            for (int j = 0; j < 8; ++j) nx[j] = *(const f32x4*)(xr + 4 * lane + 256 * j); }
        const float* md = (const float*)(p->ws + WS_MOD) + (size_t)mod_index(row) * 12288;
        float sum = 0.f;
#pragma unroll
        for (int j = 0; j < 8; ++j) sum += (v[j].x * v[j].x + v[j].y * v[j].y) + (v[j].z * v[j].z + v[j].w * v[j].w);
        sum = wave_sum(sum);
        if (lane == 0) SS[row] = sum;
#pragma unroll
        for (int j = 0; j < 8; ++j) { const int c = 4 * lane + 256 * j;
            const f32x4 g = *(const f32x4*)(gain + c), sc = *(const f32x4*)(md + DM + c);
            const f32x4 y = (v[j] * g) * (sc + 1.f);
            u32x2 o; o.x = pk2(y.x, y.y); o.y = pk2(y.z, y.w);
            *(u32x2*)(XN + (size_t)row * DM + c) = o; }
#pragma unroll
        for (int j = 0; j < 8; ++j) v[j] = nx[j];
    }
}
DI void phase_ctx_norm(KP p, const float* gs  , float* ss, int nsp) {
    const int tid = tid_l(), lane = tid & 63, gw = blockIdx.x * 8 + (tid >> 6), NGW = gridDim.x * 8;
    u16* XN = (u16*)(p->ws + WS_XN);
    for (int row = RLAT + gw; row < MROWS; row += NGW) {
        float* xr = (float*)(p->ws + WS_XC) + (size_t)(row - RLAT) * DM;
        const float* part = (const float*)(p->ws + WS_CST) + (size_t)(row - RLAT) * DM;
        f32x4 v[8]; float sum = 0.f;
#pragma unroll
        for (int j = 0; j < 8; ++j) v[j] = *(const f32x4*)(xr + 4 * lane + 256 * j);
        for (int ks = 0; ks < nsp; ++ks) {
#pragma unroll
            for (int j = 0; j < 8; ++j) v[j] += *(const f32x4*)(part + (size_t)ks * 512 * DM + 4 * lane + 256 * j); }
#pragma unroll
        for (int j = 0; j < 8; ++j) { *(f32x4*)(xr + 4 * lane + 256 * j) = v[j]; sum += (v[j].x * v[j].x + v[j].y * v[j].y) + (v[j].z * v[j].z + v[j].w * v[j].w); }
        sum = wave_sum(sum);
        if (lane == 0) ss[row] = sum;
#pragma unroll
        for (int j = 0; j < 8; ++j) { const int c = 4 * lane + 256 * j; const f32x4 y = v[j] * *(const f32x4*)(gs + c);
            u32x2 o; o.x = pk2(y.x, y.y); o.y = pk2(y.z, y.w); *(u32x2*)(XN + (size_t)row * DM + c) = o; }
    }
}
DI void phase_final(KP p) {
    const int tid = tid_l(), lane = tid & 63, gw = blockIdx.x * 8 + (tid >> 6), NGW = gridDim.x * 8;
    f32x4 v[8], nx[8];
    if (gw < RLAT) { const float* xr = p->out + (size_t)gw * DM;
#pragma unroll
        for (int j = 0; j < 8; ++j) v[j] = *(const f32x4*)(xr + 4 * lane + 256 * j); }
    for (int row = gw; row < RLAT; row += NGW) {
        const int nrow = row + NGW;
        if (nrow < RLAT) { const float* xn = p->out + (size_t)nrow * DM;
#pragma unroll
            for (int j = 0; j < 8; ++j) nx[j] = *(const f32x4*)(xn + 4 * lane + 256 * j); }
        float* xr = p->out + (size_t)row * DM;
        float sum = 0.f;
#pragma unroll
        for (int j = 0; j < 8; ++j) sum += (v[j].x * v[j].x + v[j].y * v[j].y) + (v[j].z * v[j].z + v[j].w * v[j].w);
        const float rstd = rsqrtf(wave_sum(sum) * (1.f / DM) + EPSN);
#pragma unroll
        for (int j = 0; j < 8; ++j) { const int c = 4 * lane + 256 * j; const f32x4 g = *(const f32x4*)(p->g_final + c); *(f32x4*)(xr + c) = v[j] * rstd * g; }
#pragma unroll
        for (int j = 0; j < 8; ++j) v[j] = nx[j];
    }
}

struct EpiProj {
    static constexpr bool PERM = true, AFTER_DRAIN = false;
    u16* O; float* gates; const float* ss; const float* bias0;
    __device__ __forceinline__ void operator()(const f32x4 (&acc)[2][2][4][2], const pg8::Unit& u, int wr, int wc, int fr, int fq) const {
        const int row0 = u.pm * 256 + wr * 64 + fr;
        const float* bias = bias0 + (size_t)mod_index(u.pm * 256) * NPROJ + u.pn * 256 + wc * 32 + 8 * fq;
        float rs[2][4];
#pragma unroll
        for (int ai = 0; ai < 2; ++ai)
#pragma unroll
            for (int m = 0; m < 4; ++m) rs[ai][m] = row_rstd(ss, row0 + ai * 128 + m * 16);
        {
            const int col0 = u.pn * 256 + wc * 32 + 8 * fq;
#pragma unroll
            for (int bj = 0; bj < 2; ++bj) { const f32x4 b0 = *(const f32x4*)(bias + bj * 128), b1 = *(const f32x4*)(bias + bj * 128 + 4);
#pragma unroll
                for (int ai = 0; ai < 2; ++ai)
#pragma unroll
                    for (int m = 0; m < 4; ++m) { const f32x4 v0 = acc[ai][bj][m][0] * rs[ai][m] + b0, v1 = acc[ai][bj][m][1] * rs[ai][m] + b1;
                        u32x4 o; o.x = pk2(v0[0], v0[1]); o.y = pk2(v0[2], v0[3]); o.z = pk2(v1[0], v1[1]); o.w = pk2(v1[2], v1[3]);
                        *(u32x4*)(O + (size_t)(row0 + ai * 128 + m * 16) * PLD + col0 + bj * 128) = o; } }
        }
    }
};
struct EpiRes {
    static constexpr bool PERM = false, AFTER_DRAIN = false;
    KP p; int stage; const float* gate0;
    const float* gs0; float* ssn;
    int ntfull;
    __device__ __forceinline__ void operator()(const f32x4 (&acc)[2][2][4][2], const pg8::Unit& u, int wr, int wc, int fr, int fq) const {
        const int row0 = u.pm * 256 + wr * 64 + fr, col0 = u.pn * 256 + wc * 32 + 4 * fq, cls = mod_index(u.pm * 256);
        const float* gate = gate0 + (size_t)cls * 12288 + col0;
        if (u.nt != ntfull) {
#pragma unroll
            for (int ai = 0; ai < 2; ++ai)
#pragma unroll
                for (int m = 0; m < 4; ++m) { float* xo = (float*)(p->ws + WS_CST) + ((size_t)(u.koff / 512) * 512 + (row0 + ai * 128 + m * 16 - RLAT)) * DM + col0;
#pragma unroll
                    for (int bj = 0; bj < 2; ++bj)
#pragma unroll
                        for (int n = 0; n < 2; ++n) { const int co = bj * 128 + n * 16; *(f32x4*)(xo + co) = *(const f32x4*)(gate + co) * acc[ai][bj][m][n]; } }
            return;
        }
        const float* gs = gs0 ? gs0 + cls * DM + col0 : nullptr;
        u16* XN = (u16*)(p->ws + WS_XN);
#pragma unroll
        for (int ai = 0; ai < 2; ++ai)
#pragma unroll
            for (int m = 0; m < 4; ++m) { const int row = row0 + ai * 128 + m * 16; const float* xi = xrow_in(p, stage, row) + col0; float* xo = xrow_out(p, row) + col0;
                float sq = 0.f;
#pragma unroll
                for (int bj = 0; bj < 2; ++bj)
#pragma unroll
                    for (int n = 0; n < 2; ++n) { const int co = bj * 128 + n * 16;
                        const f32x4 v = *(const f32x4*)(xi + co) + *(const f32x4*)(gate + co) * acc[ai][bj][m][n];
                        *(f32x4*)(xo + co) = v;
                        if (gs) { const f32x4 y = v * *(const f32x4*)(gs + co); u32x2 o; o.x = pk2(y.x, y.y); o.y = pk2(y.z, y.w);
                            *(u32x2*)(XN + (size_t)row * DM + col0 + co) = o; sq += (v.x * v.x + v.y * v.y) + (v.z * v.z + v.w * v.w); } }
                if (gs) { sq += __shfl_xor(sq, 16); sq += __shfl_xor(sq, 32); if (fq == 0) atomicAdd(ssn + row, sq); } }
    }
};
struct EpiSqRelu {
    static constexpr bool PERM = true, AFTER_DRAIN = false;
    u16* O; const float* ss; const float* bias0;
    __device__ __forceinline__ void operator()(const f32x4 (&acc)[2][2][4][2], const pg8::Unit& u, int wr, int wc, int fr, int fq) const {
        const int row0 = u.pm * 256 + wr * 64 + fr, col0 = u.pn * 256 + wc * 32 + 8 * fq;
        const float* bias = bias0 + (size_t)mod_index(u.pm * 256) * DFF + col0;
        float rs[2][4];
#pragma unroll
        for (int ai = 0; ai < 2; ++ai)
#pragma unroll
            for (int m = 0; m < 4; ++m) rs[ai][m] = row_rstd(ss, row0 + ai * 128 + m * 16);
#pragma unroll
        for (int bj = 0; bj < 2; ++bj) { const f32x4 b0 = *(const f32x4*)(bias + bj * 128), b1 = *(const f32x4*)(bias + bj * 128 + 4);
#pragma unroll
            for (int ai = 0; ai < 2; ++ai)
#pragma unroll
                for (int m = 0; m < 4; ++m) { f32x4 v0 = acc[ai][bj][m][0] * rs[ai][m] + b0, v1 = acc[ai][bj][m][1] * rs[ai][m] + b1;
#pragma unroll
                    for (int e = 0; e < 4; ++e) { const float a = fmaxf(v0[e], 0.f), b = fmaxf(v1[e], 0.f); v0[e] = a * a; v1[e] = b * b; }
                    u32x4 o; o.x = pk2(v0[0], v0[1]); o.y = pk2(v0[2], v0[3]); o.z = pk2(v1[0], v1[1]); o.w = pk2(v1[2], v1[3]);
                    *(u32x4*)(O + (size_t)(row0 + ai * 128 + m * 16) * DFF + col0 + bj * 128) = o; } }
    }
};
template <class Epi> DI void run_gemm(LAS unsigned char* lds, const u16* A, const u16* Bt, int M, int N, int K, const Epi& E) {
    pg8::Gemm g; g.A = A; g.Bt = Bt; g.M = M; g.N = N; g.K = K;
    pg8::StaticOrder S; S.init(M, N, K, (int)gridDim.x, (int)blockIdx.x);
    pg8::gemm_phase<Epi, pg8::StaticOrder, false>(lds, g, S, E, nullptr);
}
struct SplitOrder : pg8::StaticOrder {
    int nsp, ksp, ntsp, pm0, nctx;
    __device__ __forceinline__ bool next(int i, pg8::Unit& u) const {
        const long L = (long)i * G + c;
        if (L < nwg) return pg8::StaticOrder::next(i, u);
        const int q = (int)(L - nwg); if (q >= nctx) return false;
        const int tile = q % (2 * nN), ks = q / (2 * nN);
        u.pm = pm0 + tile / nN; u.pn = tile % nN; u.koff = ks * ksp; u.nt = ntsp; return true;
    }
};
template <class Epi> DI void run_gemm_split(LAS unsigned char* lds, const u16* A, const u16* Bt, int Mlat, int N, int K, int nsp, const Epi& E) {
    pg8::Gemm g; g.A = A; g.Bt = Bt; g.M = Mlat; g.N = N; g.K = K;
    SplitOrder S; S.init(Mlat, N, K, (int)gridDim.x, (int)blockIdx.x);
    S.nsp = nsp; S.ksp = nsp ? K / nsp : K; S.ntsp = S.ksp / 64; S.pm0 = Mlat / 256; S.nctx = nsp ? 2 * (N / 256) * nsp : 0;
    S.wgm = 4;
    pg8::gemm_phase<Epi, SplitOrder, false>(lds, g, S, E, nullptr);
}


DI void stage_plain(LAS unsigned char* T, const u16* src, int ld, int tid) {
#pragma unroll
    for (int i = 0; i < 4; ++i) { const int id = tid + 512 * i, row = id >> 4, ch = id & 15;
        *(LAS u32x4*)(T + toff(row, ch)) = *(const u32x4*)(src + (size_t)row * ld + ch * 8); }
}
DI void stage_rope(LAS unsigned char* T, const u16* src, int ld, int pos0, float scale, const f2_t* ROPE, int tid) {
#pragma unroll
    for (int i = 0; i < 2; ++i) { const int task = tid + 512 * i, row = task >> 3, pp = task & 7, cq = pp & 3, half = pp >> 2, chA = half * 8 + cq;
        const int pos = pos0 + row, pa = half ? 256 + (pos & 63) : (pos >> 6);
        const u32x4 ra = *(const u32x4*)(src + (size_t)row * ld + chA * 8), rb = *(const u32x4*)(src + (size_t)row * ld + (chA + 4) * 8);
        float x1[8], x2[8], o1[8], o2[8]; unpack8(ra, x1); unpack8(rb, x2);
        const f2_t* tb = ROPE + pa * 32 + cq * 8;
#pragma unroll
        for (int e = 0; e < 8; ++e) { const f2_t cs = tb[e]; o1[e] = (x1[e] * cs.x - x2[e] * cs.y) * scale; o2[e] = (x1[e] * cs.y + x2[e] * cs.x) * scale; }
        *(LAS u32x4*)(T + toff(row, chA)) = pack8(o1); *(LAS u32x4*)(T + toff(row, chA + 4)) = pack8(o2); }
}
DI void stage_conv(LAS unsigned char* T, const u16* src, int ld, int lo, int hi, const float* cw  , const float* cb, float scale, int tid, u16* gdst = nullptr  ) {
#pragma unroll
    for (int i = 0; i < 4; ++i) { const int id = tid + 512 * i, row = id >> 4, ch = id & 15;
        float xm[8], x0[8], xp[8], y[8];
        const u32x4 z = {0u, 0u, 0u, 0u};
        const bool okm = row - 1 >= lo, okp = row + 1 < hi;
        const u32x4 r0 = *(const u32x4*)(src + (size_t)row * ld + ch * 8);
        u32x4 rm = *(const u32x4*)(src + (ptrdiff_t)(okm ? row - 1 : row) * ld + ch * 8);
        u32x4 rp = *(const u32x4*)(src + (ptrdiff_t)(okp ? row + 1 : row) * ld + ch * 8);
        rm = okm ? rm : z; rp = okp ? rp : z;
        unpack8(rm, xm); unpack8(r0, x0); unpack8(rp, xp);
#pragma unroll
        for (int e = 0; e < 8; ++e) { const int c = ch * 8 + e; const float v = cb[c] + xm[e] * cw[c] + x0[e] * cw[1536 + c] + xp[e] * cw[3072 + c]; y[e] = v * sigmoidf_(v) * scale; }
        const u32x4 pk = pack8(y);
        *(LAS u32x4*)(T + toff(row, ch)) = pk;
        if (gdst) *(u32x4*)(gdst + (size_t)row * 768 + ch * 8) = pk; }
}

DI void gate_item(KP p, int l, int it, LAS unsigned char* lds) {
    const int tid = tid_l(), lane = tid & 63, wid = tid >> 6, fr = lane & 15, fq = lane >> 4;
    const int r0 = it * 128, srow = tid >> 4, sch = tid & 15;
    const u16* xa = (const u16*)(p->ws + WS_XN) + (size_t)(r0 + srow) * DM + sch * 8;
    const u16* wg = (const u16*)(p->ws + WS_WIN + l * SZ_WIN) + (size_t)(PLD + (tid >> 4)) * DM + sch * 8;
    LAS unsigned char* T0 = lds; LAS unsigned char* T1 = lds + TILE_B;
    u32x4 ar[4], wreg;
#pragma unroll
    for (int i = 0; i < 4; ++i) ar[i] = *(const u32x4*)(xa + (size_t)(32 * i) * DM);
    wreg = *(const u32x4*)wg;
    f32x4 acc0 = {0.f, 0.f, 0.f, 0.f}, acc1 = {0.f, 0.f, 0.f, 0.f};
    for (int kc = 0; kc < 16; ++kc) {
        __syncthreads();
#pragma unroll
        for (int i = 0; i < 4; ++i) *(LAS u32x4*)(T0 + toff(srow + 32 * i, sch)) = ar[i];
        *(LAS u32x4*)(T1 + toff(srow, sch)) = wreg;
        if (kc < 15) {
#pragma unroll
            for (int i = 0; i < 4; ++i) ar[i] = *(const u32x4*)(xa + (size_t)(32 * i) * DM + (kc + 1) * 128);
            wreg = *(const u32x4*)(wg + (kc + 1) * 128); }
        __syncthreads();
#pragma unroll
        for (int ks = 0; ks < 4; ++ks) { const bf16x8 xf = frag_row(T0, 16 * wid, 32 * ks, lane);
            acc0 = MFMA16(frag_row(T1, 0, 32 * ks, lane), xf, acc0); acc1 = MFMA16(frag_row(T1, 16, 32 * ks, lane), xf, acc1); }
    }
    const int row = r0 + 16 * wid + fr;
    const float rs = row_rstd((const float*)(p->ws + WS_SS) + (l == 0 ? 3 : 1) * MROWS, row);
    const float* bias = (const float*)(p->ws + WS_BIASP) + (size_t)(l * 3 + mod_index(row)) * NPROJ + PLD + 4 * fq;
    float* gp = (float*)(p->ws + WS_GATES) + (size_t)row * 32 + 4 * fq;
    *(f32x4*)gp = acc0 * rs + *(const f32x4*)bias; *(f32x4*)(gp + 16) = acc1 * rs + *(const f32x4*)(bias + 16);
    __syncthreads();
}

DI void gmlp_item(KP p, int l, int it, LAS unsigned char* lds) {
    const int tid = tid_l(), lane = tid & 63, wid = tid >> 6, fr = lane & 15, fq = lane >> 4;
    const int n = it >> 2, g = it & 3, r0 = n * 128;
    if (l == 1 && n >= 256) return;
    const u16* proj = (const u16*)(p->ws + WS_R);
    u16* Y = (u16*)(p->ws + WS_Y);
    LAS unsigned char* T0 = lds; LAS unsigned char* T1 = lds + TILE_B;
    { const float* ws = p->gm_w_s + (size_t)(l * 4 + g) * 16384;
#pragma unroll
      for (int i = 0; i < 8; ++i) { const int f = tid + 512 * i, row = f >> 5, c4 = f & 31; const f32x4 v = *(const f32x4*)(ws + (size_t)f * 4);
          u32x2 o; o.x = pk2(v.x, v.y); o.y = pk2(v.z, v.w); *(LAS u32x2*)(T0 + toff(row, c4 >> 1) + 8 * (c4 & 1)) = o; } }
    { const float* vg = p->gm_v_gain + l * 512 + g * 128;
#pragma unroll
      for (int i = 0; i < 4; ++i) { const int id = tid + 512 * i, row = id >> 4, ch = id & 15;
          float v[8]; unpack8(*(const u32x4*)(proj + (size_t)(r0 + row) * PLD + OFF_GV + g * 128 + ch * 8), v);
          float ss = 0.f;
#pragma unroll
          for (int e = 0; e < 8; ++e) { v[e] = gelu_tanh(v[e]); ss += v[e] * v[e]; }
          ss += __shfl_xor(ss, 1); ss += __shfl_xor(ss, 2); ss += __shfl_xor(ss, 4); ss += __shfl_xor(ss, 8);
          const float rstd = rsqrtf(ss * (1.f / 128.f) + EPSN);
#pragma unroll
          for (int e = 0; e < 8; ++e) v[e] = v[e] * rstd * vg[ch * 8 + e];
          *(LAS u32x4*)(T1 + toff(row, ch)) = pack8(v); } }
    __syncthreads();
    const int cb = 32 * (wid >> 1), pb = 64 * (wid & 1);
    f32x4 acc[2][4];
#pragma unroll
    for (int a = 0; a < 2; ++a)
#pragma unroll
        for (int b = 0; b < 4; ++b) acc[a][b] = (f32x4){0.f, 0.f, 0.f, 0.f};
#pragma unroll
    for (int ks = 0; ks < 4; ++ks) {
        bf16x8 af[2], bfg[4];
#pragma unroll
        for (int a = 0; a < 2; ++a) af[a] = frag_tr(T1, 32 * ks, cb + 16 * a, lane);
#pragma unroll
        for (int b = 0; b < 4; ++b) bfg[b] = frag_row(T0, pb + 16 * b, 32 * ks, lane);
#pragma unroll
        for (int a = 0; a < 2; ++a)
#pragma unroll
            for (int b = 0; b < 4; ++b) acc[a][b] = MFMA16(af[a], bfg[b], acc[a][b]);
    }
    const float* bs = p->gm_b_s + (l * 4 + g) * 128;
#pragma unroll
    for (int a = 0; a < 2; ++a)
#pragma unroll
        for (int b = 0; b < 4; ++b) { const int pp = pb + 16 * b + fr, c0 = cb + 16 * a + 4 * fq; const float bias = bs[pp];
            const u32x2 uu = *(const u32x2*)(proj + (size_t)(r0 + pp) * PLD + OFF_GU + g * 128 + c0);
            const float u0 = gelu_tanh(bf_lo(uu.x)), u1 = gelu_tanh(bf_hi(uu.x)), u2 = gelu_tanh(bf_lo(uu.y)), u3 = gelu_tanh(bf_hi(uu.y));
            u32x2 o; o.x = pk2(u0 * (acc[a][b][0] + bias), u1 * (acc[a][b][1] + bias)); o.y = pk2(u2 * (acc[a][b][2] + bias), u3 * (acc[a][b][3] + bias));
            *(u32x2*)(Y + (size_t)(r0 + pp) * DM + g * 128 + c0) = o; }
    __syncthreads();
}

DI void rope_item(KP p, int it) {
    const int tid = tid_l();
    u16* proj = (u16*)(p->ws + WS_R);
    const f2_t* ROPE = (const f2_t*)(p->ws + WS_ROPE);
    const float qs = QSCALE * LOG2E;
    const int row0 = it * 128;
    if (it < 256) {
        const int pos0 = (it & 127) * 128;
#pragma unroll 2
        for (int i = 0; i < 16; ++i) { const int task = tid + 512 * i, hh = task >> 10, row = (task >> 3) & 127, pp = task & 7, cq = pp & 3, half = pp >> 2, chA = half * 8 + cq;
            const int pos = pos0 + row, pa = half ? 256 + (pos & 63) : (pos >> 6);
            u16* src = proj + (size_t)(row0 + row) * PLD + OFF_AQ + hh * 128;
            const float scale = hh < 6 ? qs : 1.f;
            const u32x4 ra = *(const u32x4*)(src + chA * 8), rb = *(const u32x4*)(src + (chA + 4) * 8);
            float x1[8], x2[8], o1[8], o2[8]; unpack8(ra, x1); unpack8(rb, x2);
            const f2_t* tb = ROPE + pa * 32 + cq * 8;
#pragma unroll
            for (int e = 0; e < 8; ++e) { const f2_t cs = tb[e]; o1[e] = (x1[e] * cs.x - x2[e] * cs.y) * scale; o2[e] = (x1[e] * cs.y + x2[e] * cs.x) * scale; }
            *(u32x4*)(src + chA * 8) = pack8(o1); *(u32x4*)(src + (chA + 4) * 8) = pack8(o2); }
    } else {
#pragma unroll 2
        for (int i = 0; i < 24; ++i) { const int id = tid + 512 * i, row = id / 96, ch = id % 96; float v[8];
            u16* src = proj + (size_t)(row0 + row) * PLD + OFF_AQ + ch * 8;
            unpack8(*(const u32x4*)src, v);
#pragma unroll
            for (int e = 0; e < 8; ++e) v[e] *= qs;
            *(u32x4*)src = pack8(v); }
    }
}

DI void attn_tile(int kt, bool isctx, int b, int nb, bool& valid, int& krow0, int& jloc) {
    jloc = 0; valid = true;
    if (kt < 2) { krow0 = RLAT + b * LCTX + kt * 128; return; }
    jloc = kt - 3; const int kb = nb + jloc; krow0 = b * SEQ + kb * 128;
    valid = !isctx && kb >= 0 && kb <= 127 && kt < 5;
    if (!valid) krow0 = 0;
}
DI void attn_item(KP p, int l, int it, LAS unsigned char* lds) {
    const int tid = tid_l(), lane = tid & 63, wid = tid >> 6, fr = lane & 15, fq = lane >> 4;
    const u16* proj = (const u16*)(p->ws + WS_R);
    u16* Y = (u16*)(p->ws + WS_Y);
    LAS unsigned char* T0 = lds; LAS unsigned char* T1 = lds + TILE_B; LAS unsigned char* T2 = lds + 2 * TILE_B;
    int b, nb, hq, qrow0; bool isctx;
    if (it < 1536) { hq = it % 6; nb = (it / 6) & 127; b = it / 768; qrow0 = b * SEQ + nb * 128; isctx = false; }
    else { if (l == 1) return; const int r = it - 1536; hq = r % 6; const int cbk = (r / 6) & 1; b = r / 12; nb = 0; qrow0 = RLAT + b * LCTX + cbk * 128; isctx = true; }
    const int kvh = hq / 3;
    const int srow = tid >> 4, sch = tid & 15;
    u32x4 kr[4], vr[4];
    { const u16* ks = proj + (size_t)(RLAT + b * LCTX) * PLD + OFF_AK + kvh * 128 + sch * 8; const u16* vs = proj + (size_t)(RLAT + b * LCTX) * PLD + OFF_AV + kvh * 128 + sch * 8;
#pragma unroll
      for (int i = 0; i < 4; ++i) { kr[i] = *(const u32x4*)(ks + (size_t)(srow + 32 * i) * PLD); vr[i] = *(const u32x4*)(vs + (size_t)(srow + 32 * i) * PLD); } }
    stage_plain(T0, proj + (size_t)qrow0 * PLD + OFF_AQ + hq * 128, PLD, tid);
    __syncthreads();
    bf16x8 Qf[4];
#pragma unroll
    for (int ks = 0; ks < 4; ++ks) Qf[ks] = frag_row(T0, 16 * wid, 32 * ks, lane);
    float m = p->attn_sink[l * 6 + hq] * LOG2E, lsum = 1.f;
    f32x4 O[8];
#pragma unroll
    for (int i = 0; i < 8; ++i) O[i] = (f32x4){0.f, 0.f, 0.f, 0.f};
    const int rin = 16 * wid + fr;
    for (int kt = 0; kt < 5; ++kt) {
        bool valid; int krow0, jloc; attn_tile(kt, isctx, b, nb, valid, krow0, jloc);
        if (!valid) continue;
        __syncthreads();
#pragma unroll
        for (int i = 0; i < 4; ++i) { *(LAS u32x4*)(T1 + toff(srow + 32 * i, sch)) = kr[i]; *(LAS u32x4*)(T2 + toff(srow + 32 * i, sch)) = vr[i]; }
        {
          int kn = kt + 1; bool vn; int rn, jn; attn_tile(kn, isctx, b, nb, vn, rn, jn);
          if (!vn && kn < 4) { ++kn; attn_tile(kn, isctx, b, nb, vn, rn, jn); }
          if (vn) { const u16* ks = proj + (size_t)rn * PLD + OFF_AK + kvh * 128 + sch * 8; const u16* vs = proj + (size_t)rn * PLD + OFF_AV + kvh * 128 + sch * 8;
#pragma unroll
              for (int i = 0; i < 4; ++i) { kr[i] = *(const u32x4*)(ks + (size_t)(srow + 32 * i) * PLD); vr[i] = *(const u32x4*)(vs + (size_t)(srow + 32 * i) * PLD); } } }
        __syncthreads();
        const bool local = kt >= 2;
        f32x4 S[8];
#pragma unroll
        for (int n = 0; n < 8; ++n) S[n] = (f32x4){0.f, 0.f, 0.f, 0.f};
        {
            bf16x8 kf[2][8];
#pragma unroll
            for (int n = 0; n < 8; ++n) kf[0][n] = frag_row(T1, 16 * n, 0, lane);
#pragma unroll
            for (int ks = 0; ks < 4; ++ks) {
                if (ks < 3) {
#pragma unroll
                    for (int n = 0; n < 8; ++n) kf[(ks + 1) & 1][n] = frag_row(T1, 16 * n, 32 * (ks + 1), lane);
                }
#pragma unroll
                for (int n = 0; n < 8; ++n) S[n] = MFMA16(kf[ks & 1][n], Qf[ks], S[n]);
            }
        }
        if (local && jloc != 0) {
#pragma unroll
            for (int n = 0; n < 8; ++n)
#pragma unroll
                for (int j = 0; j < 4; ++j) { const int dk = 16 * n + 4 * fq + j - rin; const bool keep = jloc < 0 ? dk >= 0 : dk <= 0; S[n][j] = keep ? S[n][j] : -INFINITY; }
        }
        float mx = -INFINITY;
#pragma unroll
        for (int n = 0; n < 8; ++n) mx = fmaxf(fmaxf(mx, fmaxf(S[n][0], S[n][1])), fmaxf(S[n][2], S[n][3]));
        mx = fmaxf(mx, __shfl_xor(mx, 16)); mx = fmaxf(mx, __shfl_xor(mx, 32));
        const float mnew = fmaxf(m, mx), alpha = __builtin_amdgcn_exp2f(m - mnew);
        float rs = 0.f;
#pragma unroll
        for (int n = 0; n < 8; ++n)
#pragma unroll
            for (int j = 0; j < 4; ++j) { const float e = __builtin_amdgcn_exp2f(S[n][j] - mnew); S[n][j] = e; rs += e; }
        rs += __shfl_xor(rs, 16); rs += __shfl_xor(rs, 32);
        lsum = lsum * alpha + rs; m = mnew;
#pragma unroll
        for (int i = 0; i < 8; ++i) O[i] *= alpha;
        bf16x8 Pf[4];
#pragma unroll
        for (int nn = 0; nn < 4; ++nn) { u32x4 o; o.x = pk2(S[2 * nn][0], S[2 * nn][1]); o.y = pk2(S[2 * nn][2], S[2 * nn][3]); o.z = pk2(S[2 * nn + 1][0], S[2 * nn + 1][1]); o.w = pk2(S[2 * nn + 1][2], S[2 * nn + 1][3]); Pf[nn] = __builtin_bit_cast(bf16x8, o); }
        {
            bf16x8 vf[2][8];
#pragma unroll
            for (int nd = 0; nd < 8; ++nd) vf[0][nd] = frag_tr_perm(T2, 0, 16 * nd, lane);
#pragma unroll
            for (int nn = 0; nn < 4; ++nn) {
                if (nn < 3) {
#pragma unroll
                    for (int nd = 0; nd < 8; ++nd) vf[(nn + 1) & 1][nd] = frag_tr_perm(T2, 32 * (nn + 1), 16 * nd, lane);
                }
#pragma unroll
                for (int nd = 0; nd < 8; ++nd) O[nd] = MFMA16(vf[nn & 1][nd], Pf[nn], O[nd]);
            }
        }
    }
    const float inv = __builtin_amdgcn_rcpf(lsum);
    u16* yr = Y + (size_t)(qrow0 + rin) * DM + 512 + hq * 128 + 4 * fq;
#pragma unroll
    for (int nd = 0; nd < 8; ++nd) { u32x2 o; o.x = pk2(O[nd][0] * inv, O[nd][1] * inv); o.y = pk2(O[nd][2] * inv, O[nd][3] * inv); *(u32x2*)(yr + 16 * nd) = o; }
    __syncthreads();
}

DI void ml_item_geom(int it, int& b, int& c, int& h, int& base, int& lo, int& hi) {
    h = it % 6; c = (it / 6) % NCH; b = it / (6 * NCH);
    if (c < 2) { base = RLAT + b * LCTX + c * 128; lo = -c * 128; hi = LCTX - c * 128; }
    else { base = b * SEQ + (c - 2) * 128; lo = -(c - 2) * 128; hi = SEQ - (c - 2) * 128; }
}
DI int ml_pos(int c, int d) { return d == 0 ? c : (c < 2 ? 1 - c : 131 - c); }
DI void ml_gate_scan(const float* gates, int base, int d, int h, float bi, float bff, int lane, int& t0, int& t1, float& li0, float& li1, float& b0, float& b1) {
    t0 = d ? 127 - 2 * lane : 2 * lane; t1 = d ? t0 - 1 : t0 + 1;
    const float* g0 = gates + (size_t)(base + t0) * 32 + d * 12 + h; const float* g1 = gates + (size_t)(base + t1) * 32 + d * 12 + h;
    li0 = g0[0] + bi; li1 = g1[0] + bi;
    const float lf0 = log_sigmoid(g0[6] + bff), lf1 = log_sigmoid(g1[6] + bff);
    float s = lf0 + lf1;
#pragma unroll
    for (int o = 1; o < 64; o <<= 1) { const float v = __shfl_up(s, o); if (lane >= o) s += v; }
    b1 = s; b0 = s - lf1;
}

DI void ml1_item(KP p, int l, int it, LAS unsigned char* lds) {
    const int tid = tid_l(), lane = tid & 63, wid = tid >> 6, fr = lane & 15, fq = lane >> 4;
    int b, c, h, base, lo, hi; ml_item_geom(it, b, c, h, base, lo, hi);
    const u16* proj = (const u16*)(p->ws + WS_R);
    const float* gates = (const float*)(p->ws + WS_GATES);
    LAS unsigned char* T0 = lds; LAS unsigned char* T1 = lds + TILE_B; LAS unsigned char* T2 = lds + 2 * TILE_B;
    LAS float* wsc = (LAS float*)(lds + SC_OFF);
    if (wid < 2) { const int d = wid; int t0, t1; float li0, li1, b0, b1;
        ml_gate_scan(gates, base, d, h, p->ml_b_i[l * 12 + d * 6 + h], p->ml_b_f[l * 12 + d * 6 + h], lane, t0, t1, li0, li1, b0, b1);
        const float g = __shfl(b1, 63);
        const float a0 = g - b0 + li0, a1 = g - b1 + li1;
        const float ml = wave_max(fmaxf(a0, a1));
        wsc[d * 128 + t0] = __expf(a0 - ml); wsc[d * 128 + t1] = __expf(a1 - ml);
        if (lane == 0) { const int sq = ((b * 6 + h) * 2 + d) * NCH + ml_pos(c, d); ((float*)(p->ws + WS_GSC))[sq] = g; ((float*)(p->ws + WS_MLS))[sq] = ml; } }
    stage_conv(T0, proj + (size_t)base * PLD + OFF_MK + h * 128, PLD, lo, hi, p->ml_conv_w + (size_t)l * 4608 + 768 + h * 128, p->ml_conv_b + l * 1536 + 768 + h * 128, QSCALE, tid,
               (u16*)(p->ws + WS_XN) + (size_t)base * 768 + h * 128);
    __syncthreads();
#pragma unroll
    for (int i = 0; i < 4; ++i) { const int id = tid + 512 * i, row = id >> 4, ch = id & 15; float v[8], y[8];
        unpack8(*(const u32x4*)(proj + (size_t)(base + row) * PLD + OFF_MV + h * 128 + ch * 8), v);
        const float w0 = wsc[row], w1 = wsc[128 + row];
#pragma unroll
        for (int e = 0; e < 8; ++e) y[e] = v[e] * w0;
        *(LAS u32x4*)(T1 + toff(row, ch)) = pack8(y);
#pragma unroll
        for (int e = 0; e < 8; ++e) y[e] = v[e] * w1;
        *(LAS u32x4*)(T2 + toff(row, ch)) = pack8(y); }
    __syncthreads();
    const int kb = 32 * (wid >> 1), vb = 64 * (wid & 1);
    u16* CST = (u16*)(p->ws + WS_CST);
#pragma unroll
    for (int d = 0; d < 2; ++d) {
        const LAS unsigned char* TV = d ? T2 : T1;
        f32x4 acc[2][4];
#pragma unroll
        for (int a = 0; a < 2; ++a)
#pragma unroll
            for (int bb = 0; bb < 4; ++bb) acc[a][bb] = (f32x4){0.f, 0.f, 0.f, 0.f};
#pragma unroll
        for (int ks = 0; ks < 4; ++ks) {
            bf16x8 af[2], bfg[4];
#pragma unroll
            for (int a = 0; a < 2; ++a) af[a] = frag_tr(T0, 32 * ks, kb + 16 * a, lane);
#pragma unroll
            for (int bb = 0; bb < 4; ++bb) bfg[bb] = frag_tr(TV, 32 * ks, vb + 16 * bb, lane);
#pragma unroll
            for (int a = 0; a < 2; ++a)
#pragma unroll
                for (int bb = 0; bb < 4; ++bb) acc[a][bb] = MFMA16(af[a], bfg[bb], acc[a][bb]);
        }
        u16* Cd = CST + ((size_t)(((b * 6 + h) * 2 + d) * NCH + ml_pos(c, d))) * 16384;
#pragma unroll
        for (int a = 0; a < 2; ++a)
#pragma unroll
            for (int bb = 0; bb < 4; ++bb) { const int v = vb + 16 * bb + fr, k0 = kb + 16 * a + 4 * fq;
                u32x2 o; o.x = pk2(acc[a][bb][0], acc[a][bb][1]); o.y = pk2(acc[a][bb][2], acc[a][bb][3]); *(u32x2*)(Cd + v * 128 + k0) = o; }
    }
    { const int d = tid >> 8, k2 = tid & 63, tq = (tid >> 6) & 3; float s0 = 0.f, s1 = 0.f;
#pragma unroll 8
        for (int t = 32 * tq; t < 32 * tq + 32; ++t) { const float w = wsc[d * 128 + t]; const unsigned kv = *(const LAS unsigned*)(T0 + toff(t, k2 >> 2) + 4 * (k2 & 3)); s0 += w * bf_lo(kv); s1 += w * bf_hi(kv); }
        LAS float* red = (LAS float*)(lds + SC_OFF + 2048);
        red[(d * 4 + tq) * 128 + 2 * k2] = s0; red[(d * 4 + tq) * 128 + 2 * k2 + 1] = s1;
        __syncthreads();
        if (tid < 256) { const int dd = tid >> 7, k = tid & 127; const float sum = (red[(dd * 4 + 0) * 128 + k] + red[(dd * 4 + 1) * 128 + k]) + (red[(dd * 4 + 2) * 128 + k] + red[(dd * 4 + 3) * 128 + k]);
            ((float*)(p->ws + WS_NST))[((size_t)(((b * 6 + h) * 2 + dd) * NCH + ml_pos(c, dd))) * 128 + k] = sum; } }
    __syncthreads();
}

DI void scan_item(KP p, int it) {
    const float* GSC = (const float*)(p->ws + WS_GSC); const float* MLS = (const float*)(p->ws + WS_MLS);
    const int gt = it * 512 + tid_l();
    if (gt < NSEQ * 4096) {
        const int sq = gt >> 12, e4 = gt & 4095;
        u16* base = (u16*)(p->ws + WS_CST) + (size_t)sq * NCH * 16384 + e4 * 4;
        float c0 = 0.f, c1 = 0.f, c2 = 0.f, c3 = 0.f, m = 0.f;
        for (int j0 = 0; j0 < NCH; j0 += 10) {
            u32x2 v[10]; float gj[10], mj[10];
#pragma unroll
            for (int u = 0; u < 10; ++u) { v[u] = *(const u32x2*)(base + (size_t)(j0 + u) * 16384); gj[u] = GSC[sq * NCH + j0 + u]; mj[u] = MLS[sq * NCH + j0 + u]; }
#pragma unroll
            for (int u = 0; u < 10; ++u) {
                u32x2 o; o.x = pk2(c0, c1); o.y = pk2(c2, c3); *(u32x2*)(base + (size_t)(j0 + u) * 16384) = o;
                const float mn = fmaxf(gj[u] + m, mj[u]), ao = __expf(gj[u] + m - mn), an = __expf(mj[u] - mn);
                c0 = ao * c0 + an * bf_lo(v[u].x); c1 = ao * c1 + an * bf_hi(v[u].x); c2 = ao * c2 + an * bf_lo(v[u].y); c3 = ao * c3 + an * bf_hi(v[u].y); m = mn; }
        }
    } else {
        const int r = gt - NSEQ * 4096, sq = r >> 7, k = r & 127;
        float* nb = (float*)(p->ws + WS_NST) + (size_t)sq * NCH * 128 + k; float* M0 = (float*)(p->ws + WS_M0);
        float n = 0.f, m = 0.f;
        for (int j = 0; j < NCH; ++j) { const float dn = nb[(size_t)j * 128], gj = GSC[sq * NCH + j], mj = MLS[sq * NCH + j];
            nb[(size_t)j * 128] = n; if (k == 0) M0[sq * NCH + j] = m;
            const float mn = fmaxf(gj + m, mj), ao = __expf(gj + m - mn), an = __expf(mj - mn); n = ao * n + an * dn; m = mn; }
    }
}

DI void ml3_item(KP p, int l, int it, LAS unsigned char* lds) {
    const int tid = tid_l(), lane = tid & 63, wid = tid >> 6, fr = lane & 15, fq = lane >> 4;
    int b, c, h, base, lo, hi; ml_item_geom(it, b, c, h, base, lo, hi);
    if (l == 1 && c < 2) return;
    const u16* proj = (const u16*)(p->ws + WS_R);
    const float* gates = (const float*)(p->ws + WS_GATES);
    u16* Y = (u16*)(p->ws + WS_Y);
    LAS unsigned char* T0 = lds; LAS unsigned char* T1 = lds + TILE_B; LAS unsigned char* T2 = lds + 2 * TILE_B; LAS unsigned char* T3 = T0;
    LAS float* sc_rt = (LAS float*)(lds + SC_OFF);
    LAS float* sc_ct = sc_rt + 256;
    LAS float* sc_in = sc_rt + 512;
    LAS float* sc_em = sc_rt + 768;
    LAS float* sc_n0 = sc_rt + 1024;
    const int srow = tid >> 4, sch = tid & 15;
    u32x4 c0a[4], c0b[4]; u32x2 mor[8];
    { const u16* ca = (const u16*)(p->ws + WS_CST) + (size_t)(((b * 6 + h) * 2 + 0) * NCH + ml_pos(c, 0)) * 16384 + srow * 128 + sch * 8;
      const u16* cb = (const u16*)(p->ws + WS_CST) + (size_t)(((b * 6 + h) * 2 + 1) * NCH + ml_pos(c, 1)) * 16384 + srow * 128 + sch * 8;
#pragma unroll
      for (int i = 0; i < 4; ++i) { c0a[i] = *(const u32x4*)(ca + i * 32 * 128); c0b[i] = *(const u32x4*)(cb + i * 32 * 128); }
      const u16* mo_ = proj + (size_t)(base + 16 * wid + fr) * PLD + OFF_MO + h * 128 + 4 * fq;
#pragma unroll
      for (int nd = 0; nd < 8; ++nd) mor[nd] = *(const u32x2*)(mo_ + 16 * nd); }
    if (wid < 2) { const int d = wid; int t0, t1; float li0, li1, b0, b1;
        ml_gate_scan(gates, base, d, h, p->ml_b_i[l * 12 + d * 6 + h], p->ml_b_f[l * 12 + d * 6 + h], lane, t0, t1, li0, li1, b0, b1);
        const int sq = ((b * 6 + h) * 2 + d) * NCH + ml_pos(c, d);
        const float m0 = ((const float*)(p->ws + WS_M0))[sq];
        const float ct0 = li0 - b0, ct1 = li1 - b1;
        float pm = fmaxf(ct0, ct1);
#pragma unroll
        for (int o = 1; o < 64; o <<= 1) { const float v = __shfl_up(pm, o); if (lane >= o) pm = fmaxf(pm, v); }
        float pe = __shfl_up(pm, 1); if (lane == 0) pe = -INFINITY;
        const float pm0 = fmaxf(pe, ct0), pm1 = pm;
        const float mt0 = fmaxf(b0 + m0, b0 + pm0), mt1 = fmaxf(b1 + m0, b1 + pm1);
        sc_rt[d * 128 + t0] = b0 - mt0; sc_rt[d * 128 + t1] = b1 - mt1;
        sc_ct[d * 128 + t0] = ct0; sc_ct[d * 128 + t1] = ct1;
        sc_in[d * 128 + t0] = __expf(b0 + m0 - mt0); sc_in[d * 128 + t1] = __expf(b1 + m0 - mt1);
        sc_em[d * 128 + t0] = __expf(-mt0); sc_em[d * 128 + t1] = __expf(-mt1);
        const float* n0 = (const float*)(p->ws + WS_NST) + (size_t)sq * 128;
        sc_n0[d * 128 + 2 * lane] = n0[2 * lane]; sc_n0[d * 128 + 2 * lane + 1] = n0[2 * lane + 1]; }
    stage_conv(T0, proj + (size_t)base * PLD + OFF_MQ + h * 128, PLD, lo, hi, p->ml_conv_w + (size_t)l * 4608 + h * 128, p->ml_conv_b + l * 1536 + h * 128, 1.f, tid);
    stage_plain(T1, (const u16*)(p->ws + WS_XN) + (size_t)base * 768 + h * 128, 768, tid);
    stage_plain(T2, proj + (size_t)base * PLD + OFF_MV + h * 128, PLD, tid);
    __syncthreads();
    const int t = 16 * wid + fr;
    bf16x8 Qf[4];
#pragma unroll
    for (int ks = 0; ks < 4; ++ks) Qf[ks] = frag_row(T0, 16 * wid, 32 * ks, lane);
    float nq[2] = {0.f, 0.f};
#pragma unroll
    for (int ks = 0; ks < 4; ++ks) { const u32x4 qv = __builtin_bit_cast(u32x4, Qf[ks]); float q[8]; unpack8(qv, q);
#pragma unroll
        for (int e = 0; e < 8; ++e) { const int k = 32 * ks + 8 * fq + e; nq[0] += q[e] * sc_n0[k]; nq[1] += q[e] * sc_n0[128 + k]; } }
#pragma unroll
    for (int d = 0; d < 2; ++d) { nq[d] += __shfl_xor(nq[d], 16); nq[d] += __shfl_xor(nq[d], 32); }
    f32x4 hs[8];
#pragma unroll
    for (int i = 0; i < 8; ++i) hs[i] = (f32x4){0.f, 0.f, 0.f, 0.f};
#pragma unroll 1
    for (int d = 0; d < 2; ++d) {
        const int sq = ((b * 6 + h) * 2 + d) * NCH + ml_pos(c, d);
        const float nqd = d ? nq[1] : nq[0];
        __syncthreads();
#pragma unroll
        for (int i = 0; i < 4; ++i) { const u32x4 v = d ? c0b[i] : c0a[i]; *(LAS u32x4*)(T3 + toff(srow + 32 * i, sch)) = v; }
        __syncthreads();
        const float rt = sc_rt[d * 128 + t], inter = sc_in[d * 128 + t], em = sc_em[d * 128 + t];
        f32x4 S[8]; float den = 0.f;
#pragma unroll
        for (int n = 0; n < 8; ++n) { S[n] = (f32x4){0.f, 0.f, 0.f, 0.f};
            const bool need = d ? (n >= wid) : (n <= wid);
            if (need) {
#pragma unroll
                for (int ks = 0; ks < 4; ++ks) S[n] = MFMA16(frag_row(T1, 16 * n, 32 * ks, lane), Qf[ks], S[n]);
#pragma unroll
                for (int j = 0; j < 4; ++j) { const int s = 16 * n + 4 * fq + j; const bool valid = d ? (s >= t) : (s <= t);
                    const float w = valid ? __expf(rt + sc_ct[d * 128 + s]) : 0.f; const float pv = S[n][j] * w; S[n][j] = pv; den += pv; }
            }
            __builtin_amdgcn_sched_barrier(0); }
        den += __shfl_xor(den, 16); den += __shfl_xor(den, 32);
        den += inter * nqd;
        bf16x8 Pf[4];
#pragma unroll
        for (int nn = 0; nn < 4; ++nn) { u32x4 o; o.x = pk2(S[2 * nn][0], S[2 * nn][1]); o.y = pk2(S[2 * nn][2], S[2 * nn][3]); o.z = pk2(S[2 * nn + 1][0], S[2 * nn + 1][1]); o.w = pk2(S[2 * nn + 1][2], S[2 * nn + 1][3]); Pf[nn] = __builtin_bit_cast(bf16x8, o); }
        const float inv = 1.f / fmaxf(fabsf(den), em);
#pragma unroll
        for (int nd = 0; nd < 8; ++nd) {
            f32x4 a1 = {0.f, 0.f, 0.f, 0.f}, a2 = {0.f, 0.f, 0.f, 0.f};
#pragma unroll
            for (int nn = 0; nn < 4; ++nn) a1 = MFMA16(frag_tr_perm(T2, 32 * nn, 16 * nd, lane), Pf[nn], a1);
#pragma unroll
            for (int ks = 0; ks < 4; ++ks) a2 = MFMA16(frag_row(T3, 16 * nd, 32 * ks, lane), Qf[ks], a2);
            hs[nd] += (a1 + a2 * inter) * inv;
            __builtin_amdgcn_sched_barrier(0);
        }
    }
    float ss = 0.f;
#pragma unroll
    for (int nd = 0; nd < 8; ++nd) ss += (hs[nd][0] * hs[nd][0] + hs[nd][1] * hs[nd][1]) + (hs[nd][2] * hs[nd][2] + hs[nd][3] * hs[nd][3]);
    ss += __shfl_xor(ss, 16); ss += __shfl_xor(ss, 32);
    const float rstd = rsqrtf(ss * (1.f / 128.f) + EPSN);
    const float* og = p->ml_out_gain + l * 768 + h * 128;
    u16* yr = Y + (size_t)(base + t) * DM + 1280 + h * 128;
#pragma unroll
    for (int nd = 0; nd < 8; ++nd) { const int v0 = 16 * nd + 4 * fq; const u32x2 ov = mor[nd]; const f32x4 gn = *(const f32x4*)(og + v0);
        const float y0 = hs[nd][0] * rstd * gn[0] * sigmoidf_(bf_lo(ov.x)), y1 = hs[nd][1] * rstd * gn[1] * sigmoidf_(bf_hi(ov.x));
        const float y2 = hs[nd][2] * rstd * gn[2] * sigmoidf_(bf_lo(ov.y)), y3 = hs[nd][3] * rstd * gn[3] * sigmoidf_(bf_hi(ov.y));
        u32x2 o; o.x = pk2(y0, y1); o.y = pk2(y2, y3); *(u32x2*)(yr + v0) = o; }
    __syncthreads();
}

#define XB_TMO      128
#define XB_XCNT(j)  (256  + 64 * (j))
#define XB_XSUB(j)  (1280 + 64 * (j))
#define XB_XGEN(j)  (2304 + 64 * (j))
#define XB_TOP      3328
#define XB_TOPGEN   3392
#define XCD_BAR_WORDS 3456
#define XB_SPIN_CAP (1u << 18)

__device__ __forceinline__ unsigned xb_ld(unsigned* p)              { return __hip_atomic_load(p, __ATOMIC_RELAXED, __HIP_MEMORY_SCOPE_AGENT); }
__device__ __forceinline__ unsigned xb_add(unsigned* p, unsigned v) { return __hip_atomic_fetch_add(p, v, __ATOMIC_RELAXED, __HIP_MEMORY_SCOPE_AGENT); }
__device__ __forceinline__ unsigned xb_xcc_id() { return (unsigned)__builtin_amdgcn_s_getreg((3 << 11) | 20) & 0xFu; }
#define XB_SPIN(cond, bar) do { unsigned _sp = 0; while (cond) { __builtin_amdgcn_s_sleep(1); \
    if ((++_sp & 255u) == 0u) { if (xb_ld(&(bar)[XB_TMO])) break; if (_sp > XB_SPIN_CAP) { atomicAdd(&(bar)[XB_TMO], 1u); break; } } } } while (0)

struct XcdBarrier {
    unsigned* bar; unsigned x;
    volatile LAS unsigned* st;
};

__device__ __forceinline__ XcdBarrier xcd_barrier_post(unsigned* bar, volatile LAS unsigned* st) {
    XcdBarrier b; b.bar = bar; b.x = xb_xcc_id(); b.st = st;
    if (threadIdx.x == 0) (void)xb_add(&bar[XB_XCNT(b.x)], 1u);
    return b;
}
__device__ __forceinline__ void xcd_barrier_complete(unsigned* bar, unsigned x, unsigned& nloc, unsigned& nx) {
    const unsigned G = gridDim.x * gridDim.y * gridDim.z;
    unsigned sum, cnt, mine, sp = 0u;
    for (;;) {
        sum = 0u; cnt = 0u; mine = 0u;
#pragma unroll
        for (unsigned j = 0; j < 16; ++j) { const unsigned c = xb_ld(&bar[XB_XCNT(j)]); sum += c; cnt += (c > 0u) ? 1u : 0u; mine = (j == x) ? c : mine; }
        if (sum == G) break;
        __builtin_amdgcn_s_sleep(1);
        if ((++sp & 255u) == 0u) { if (xb_ld(&bar[XB_TMO])) break; if (sp > XB_SPIN_CAP) { atomicAdd(&bar[XB_TMO], 1u); break; } }
    }
    nloc = mine > 0u ? mine : 1u; nx = cnt > 0u ? cnt : 1u;
}

__device__ __forceinline__ void xcd_barrier(const XcdBarrier& b) {
    asm volatile("s_waitcnt vmcnt(0)" ::: "memory");
    __syncthreads();
    if (threadIdx.x == 0) {
        unsigned* bar = b.bar;
        __builtin_amdgcn_s_waitcnt(0);
        unsigned nloc = b.st[0], nx = b.st[1];
        if (nloc == 0u) { xcd_barrier_complete(bar, b.x, nloc, nx); b.st[0] = nloc; b.st[1] = nx; }
        const unsigned old = xb_add(&bar[XB_XSUB(b.x)], 1u);
        const unsigned gen = old / nloc;
        if (old + 1u == (gen + 1u) * nloc) {
            __builtin_amdgcn_fence(__ATOMIC_RELEASE, "agent");
            asm volatile("s_waitcnt vmcnt(0)" ::: "memory");
            const unsigned og = xb_add(&bar[XB_TOP], 1u);
            const unsigned tg = og / nx;
            if (og + 1u == (tg + 1u) * nx) xb_add(&bar[XB_TOPGEN], 1u);
            else XB_SPIN(xb_ld(&bar[XB_TOPGEN]) == tg, bar);
            __builtin_amdgcn_fence(__ATOMIC_ACQUIRE, "agent");
            xb_add(&bar[XB_XGEN(b.x)], 1u);
            asm volatile("s_waitcnt vmcnt(0)" ::: "memory");
        } else {
            XB_SPIN(xb_ld(&bar[XB_XGEN(b.x)]) == gen, bar);
            __builtin_amdgcn_fence(__ATOMIC_ACQUIRE, "agent");
            asm volatile("s_waitcnt vmcnt(0)" ::: "memory");
        }
    }
    __syncthreads();
}

constexpr int N_ATT = 1560, N_ML = 2 * NCH * 6  , N_GM = 260 * 4, N_SCAN = 198, N_ROPE = 260;

DI int next_item(unsigned* ctr, LAS unsigned char* lds) {
    LAS int* slot = (LAS int*)(lds + LDS_BYTES - 16);
    __syncthreads();
    if (threadIdx.x == 0) *slot = (int)atomicAdd(ctr, 1u);
    __syncthreads();
    return *slot;
}

__global__ void __launch_bounds__(512, 2) fwd_megakernel(Params p_unused) {
    const KP kp = (KP)__builtin_amdgcn_kernarg_segment_ptr();
#define PP launder(kp)
    extern __shared__ __attribute__((aligned(16))) unsigned char smem[];
    LAS unsigned char* lds = (LAS unsigned char*)smem;
    cg::grid_group grid = cg::this_grid();
    volatile LAS unsigned* xst = (volatile LAS unsigned*)(lds + LDS_BYTES - 32);
    if (threadIdx.x == 0) { xst[0] = 0u; xst[1] = 0u; }
    __syncthreads();
    { XcdBarrier b0 = xcd_barrier_post((unsigned*)(PP->ws + WS_BAR), xst); (void)b0; }
#define GSYNC() do { XcdBarrier b_; b_.bar = (unsigned*)(PP->ws + WS_BAR); b_.x = xb_xcc_id(); b_.st = xst; xcd_barrier(b_); } while (0)
    phase_prep(PP, lds);
    if (PP->ws == nullptr) grid.sync();
    GSYNC();
    phase_norm0(PP);
    phase_prep2(PP, lds);
    GSYNC();
    for (int l = 0; l < 2; ++l) {
        const int stage = l;
        const int Mres = l == 0 ? MROWS : RLAT;
        unsigned* ctr = (unsigned*)(PP->ws + WS_CTR) + l * 4;
        { EpiProj E; E.O = (u16*)(PP->ws + WS_R); E.gates = (float*)(PP->ws + WS_GATES);
          E.ss = (const float*)(PP->ws + WS_SS) + (l == 0 ? 3 : 1) * MROWS; E.bias0 = (const float*)(PP->ws + WS_BIASP) + (size_t)l * 3 * NPROJ;
          run_gemm(lds, (const u16*)(PP->ws + WS_XN), (const u16*)(PP->ws + WS_WIN + l * SZ_WIN), MROWS, PLD, DM, E); }
        for (;;) { const int it = next_item(ctr + 3, lds); if (it >= 260) break; gate_item(PP, l, it, lds); }
        GSYNC();
        for (;;) { const int it = next_item(ctr + 0, lds); if (it >= N_ROPE + N_ML) break; if (it < N_ROPE) rope_item(PP, it); else ml1_item(PP, l, it - N_ROPE, lds); }
        GSYNC();
        for (;;) { const int it = next_item(ctr + 1, lds); if (it >= N_SCAN + N_ATT + N_GM) break;
            if (it < N_SCAN) scan_item(PP, it);
            else if (it < N_SCAN + N_ATT) attn_item(PP, l, it - N_SCAN, lds);
            else gmlp_item(PP, l, it - N_SCAN - N_ATT, lds); }
        GSYNC();
        for (;;) { const int it = next_item(ctr + 2, lds); if (it >= N_ML) break; ml3_item(PP, l, it, lds); }
        GSYNC();
        { EpiRes E; E.p = PP; E.stage = stage; E.gate0 = (const float*)(PP->ws + WS_MOD) + (size_t)l * 3 * 12288 + 2 * DM;
          E.gs0 = (const float*)(PP->ws + WS_GS) + (size_t)(l * 2 + 1) * 3 * DM; E.ssn = (float*)(PP->ws + WS_SS) + (l == 0 ? 0 : 2) * MROWS; E.ntfull = DM / 64;
          run_gemm_split(lds, (const u16*)(PP->ws + WS_Y), (const u16*)(PP->ws + WS_WOUT + l * SZ_WOUT), RLAT, DM, DM, l == 0 ? 4 : 0, E); }
        GSYNC();
        if (l == 0) { phase_ctx_norm(PP, (const float*)(PP->ws + WS_GS) + (size_t)((0 * 2 + 1) * 3 + 2) * DM, (float*)(PP->ws + WS_SS) + 0 * MROWS, 4); GSYNC(); }
        { EpiSqRelu E; E.O = (u16*)(PP->ws + WS_R); E.ss = (const float*)(PP->ws + WS_SS) + (l == 0 ? 0 : 2) * MROWS; E.bias0 = (const float*)(PP->ws + WS_BIASF) + (size_t)l * 3 * DFF;
          run_gemm(lds, (const u16*)(PP->ws + WS_XN), (const u16*)(PP->ws + WS_WFF1 + l * SZ_WFF), Mres, DFF, DM, E); }
        GSYNC();
        { EpiRes E; E.p = PP; E.stage = 1; E.gate0 = (const float*)(PP->ws + WS_MOD) + (size_t)l * 3 * 12288 + 5 * DM;
          E.gs0 = l == 0 ? (const float*)(PP->ws + WS_GS) + (size_t)(1 * 2 + 0) * 3 * DM : nullptr; E.ssn = (float*)(PP->ws + WS_SS) + 1 * MROWS; E.ntfull = DFF / 64;
          run_gemm_split(lds, (const u16*)(PP->ws + WS_R), (const u16*)(PP->ws + WS_WFF2 + l * SZ_WFF), RLAT, DM, DFF, l == 0 ? 16 : 0, E); }
        GSYNC();
        if (l == 0) { phase_ctx_norm(PP, (const float*)(PP->ws + WS_GS) + (size_t)((1 * 2 + 0) * 3 + 2) * DM, (float*)(PP->ws + WS_SS) + 1 * MROWS, 16); GSYNC(); }
    }
    phase_final(PP);
#undef GSYNC
#undef PP
}

extern "C" void kernel_launch(void* const* d_in, const int* in_sizes, int n_in, void* d_out, int out_size, void* d_ws, size_t ws_size, hipStream_t stream) {
    static int grid_blocks = 0;
    if (grid_blocks == 0) {
        if (n_in != 22 || ws_size < WS_END || out_size != RLAT * DM) { fprintf(stderr, "kernel_launch: unexpected shapes (n_in %d ws %zu need %zu out %d)\n", n_in, ws_size, (size_t)WS_END, out_size); grid_blocks = -1; return; }
        int dev = 0, cus = 0, per_cu = 0;
        hipGetDevice(&dev);
        hipDeviceGetAttribute(&cus, hipDeviceAttributeMultiprocessorCount, dev);
        if (hipFuncSetAttribute((const void*)fwd_megakernel, hipFuncAttributeMaxDynamicSharedMemorySize, LDS_BYTES) != hipSuccess) { fprintf(stderr, "kernel_launch: hipFuncSetAttribute failed\n"); grid_blocks = -1; return; }
        hipOccupancyMaxActiveBlocksPerMultiprocessor(&per_cu, (const void*)fwd_megakernel, 512, LDS_BYTES);
        if (per_cu < 1) { fprintf(stderr, "kernel_launch: occupancy query says %d blocks per CU\n", per_cu); per_cu = 1; }
        (void)hipGetLastError();
        grid_blocks = cus * 1;
    }
    if (grid_blocks < 0) return;
    if (hipMemsetAsync((unsigned char*)d_ws + WS_BAR, 0, 16384, stream) != hipSuccess) { fprintf(stderr, "kernel_launch: memset failed\n"); return; }
    Params p{};
    const float** pp = (const float**)&p;
    for (int i = 0; i < 22; ++i) pp[i] = (const float*)d_in[i];
    p.out = (float*)d_out; p.ws = (unsigned char*)d_ws;
    void* args[] = {&p};
    hipError_t e = hipLaunchCooperativeKernel((const void*)fwd_megakernel, dim3(grid_blocks), dim3(512), args, LDS_BYTES, stream);
    if (e != hipSuccess) fprintf(stderr, "cooperative launch failed: %s (grid %d)\n", hipGetErrorString(e), grid_blocks);
}
```

```cpp
#include <hip/hip_runtime.h>
#include <hip/hip_cooperative_groups.h>
#include <cstdio>
namespace cg = cooperative_groups;
namespace pg8 {
#define PG8_LAS __attribute__((address_space(3)))
typedef unsigned short bf16_t;
typedef short bf16x8 __attribute__((ext_vector_type(8)));
typedef float f32x4 __attribute__((ext_vector_type(4)));
typedef unsigned u32x4 __attribute__((ext_vector_type(4)));
constexpr int BM = 256, BK = 64, HALF = 128, HTB = HALF * BK * 2  , STAGE_BYTES = 8 * HTB, NXCD = 8, WGM = 8;

__host__ __device__ __forceinline__ int lds_byte(int r, int c) { const int st = (r >> 4) * 2 + (c >> 5), rr = r & 15, cc = c & 31, ob = rr * 64 + cc * 2; return st * 1024 + (ob ^ (((ob >> 9) & 1) << 5)); }
__host__ __device__ __forceinline__ void stage_rc(int b, int& R, int& C) { const int st = b / 1024, sb = b % 1024, swz = sb ^ (((sb >> 9) & 1) << 5); R = (st >> 1) * 16 + swz / 64; C = (st & 1) * 32 + (swz % 64) / 2; }
__host__ __device__ __forceinline__ int perm32(int rho) { const int n = rho >> 4, i = rho & 15; return 8 * (i >> 2) + 4 * n + (i & 3); }

struct Unit { int pm, pn, koff, nt; };
struct Gemm { const bf16_t* A; const bf16_t* Bt; int M, N, K; };

struct StaticOrder {
    int nM, nN, nwg, G, c, ntf, wgm;
    __host__ __device__ void init(int M, int N, int K, int G_, int c_) { nM = M / BM; nN = N / BM; nwg = nM * nN; G = G_; c = c_; ntf = K / BK; wgm = WGM; }
    __host__ __device__ bool next(int i, Unit& u) const {
        const long L = (long)i * G + c; if (L >= nwg) return false;
        int wgid = (int)L; { const int q = nwg / NXCD, r = nwg % NXCD, xcd = wgid % NXCD, off = wgid / NXCD; wgid = (xcd < r ? xcd * (q + 1) : r * (q + 1) + (xcd - r) * q) + off; }
        const int nig = wgm * nN, gid = wgid / nig, fm = gid * wgm, gsz = (nM - fm) < wgm ? (nM - fm) : wgm;
        u.pm = fm + ((wgid % nig) % gsz); u.pn = (wgid % nig) / gsz; u.koff = 0; u.nt = ntf; return true;
    }
    __device__ __forceinline__ void a_ready(const Unit&) const {}
    __device__ __forceinline__ void done(const Unit&) const {}
};
template <class Epi, class Sched, bool STAMP = false>
__device__ __forceinline__ void gemm_phase(PG8_LAS unsigned char* lds, const Gemm g, const Sched& S, const Epi& E, unsigned long long* stamps) {
    int tid_ = threadIdx.x; asm volatile("" : "+v"(tid_)); const int tid = tid_, wid = __builtin_amdgcn_readfirstlane(tid >> 6), lane = tid & 63, wr = wid >> 2, wc = wid & 3, fr = lane & 15, fq = lane >> 4;
    const int K = g.K;
    int ts_lo = 0, ts_hi = 0, nts = 0; const unsigned long long rt_entry = STAMP ? (unsigned long long)wall_clock64() : 0ull;
#define PG8_STAMP() do { if (STAMP && wid == 0 && nts < 64) { const unsigned long long _c = (unsigned long long)clock64(); \
        ts_lo = (lane == nts) ? (int)(unsigned)_c : ts_lo; ts_hi = (lane == nts) ? (int)(unsigned)(_c >> 32) : ts_hi; ++nts; } } while (0)
    PG8_STAMP();
    unsigned voffA[2], voffB[2];
#pragma unroll
    for (int i = 0; i < 2; ++i) { int R, C; stage_rc(tid * 16 + i * 8192, R, C); const int Rb = Epi::PERM ? ((R & ~31) + perm32(R & 31)) : R;
        voffA[i] = (unsigned)(R * K + C) * 2u; voffB[i] = (unsigned)(Rb * K + C) * 2u; }
    const size_t kstep = (size_t)(BK * 2);
    const size_t hstep = (size_t)HALF * K * 2;
    const size_t tstep = 2 * hstep;
    const unsigned ldsw = (unsigned)wid * 1024u;
    const int aoff = lds_byte(wr * 64 + fr, fq * 8), boff = lds_byte(wc * 32 + fr, fq * 8);
#define PG8_SA(b, h) (((b) * 2 + (h)) * HTB)
#define PG8_SB(b, h) ((4 + (b) * 2 + (h)) * HTB)
#define PG8_STAGE(bufoff, gbase, voff) do { _Pragma("unroll") for (int _i = 0; _i < 2; ++_i) \
        __builtin_amdgcn_global_load_lds((const unsigned*)((const char*)(gbase) + (voff)[_i]), (PG8_LAS unsigned*)(lds + (bufoff) + ldsw + _i * 8192), 16, 0, 0); } while (0)
#define PG8_LDA(dst, b, h) do { _Pragma("unroll") for (int m = 0; m < 4; ++m) _Pragma("unroll") for (int k = 0; k < 2; ++k) dst[m][k] = *(const PG8_LAS bf16x8*)(lds + PG8_SA(b, h) + aoff + m * 2048 + k * 1024); } while (0)
#define PG8_LDB(dst, b, h) do { _Pragma("unroll") for (int n = 0; n < 2; ++n) _Pragma("unroll") for (int k = 0; k < 2; ++k) dst[n][k] = *(const PG8_LAS bf16x8*)(lds + PG8_SB(b, h) + boff + n * 2048 + k * 1024); } while (0)
#define PG8_MMA(ai, bj, At, Bt) do { __builtin_amdgcn_s_setprio(1); _Pragma("unroll") for (int m = 0; m < 4; ++m) _Pragma("unroll") for (int n = 0; n < 2; ++n) _Pragma("unroll") for (int k = 0; k < 2; ++k) \
        acc[ai][bj][m][n] = __builtin_amdgcn_mfma_f32_16x16x32_bf16(Bt[n][k], At[m][k], acc[ai][bj][m][n], 0, 0, 0); __builtin_amdgcn_s_setprio(0); } while (0)
#define PG8_WAIT_V(n) asm volatile("s_waitcnt vmcnt(" #n ")" ::: "memory")
#define PG8_WAIT_L(n) asm volatile("s_waitcnt lgkmcnt(" #n ")" ::: "memory")
#define PG8_BAR __builtin_amdgcn_s_barrier()
#define PG8_SCHED __builtin_amdgcn_sched_barrier(0)
    Unit cur, nxt; int ui = 0;
    if (!S.next(0, cur)) return;
    f32x4 acc[2][2][4][2];
#pragma unroll
    for (int a = 0; a < 2; ++a)
#pragma unroll
        for (int b = 0; b < 2; ++b)
#pragma unroll
            for (int m = 0; m < 4; ++m)
#pragma unroll
                for (int n = 0; n < 2; ++n) acc[a][b][m][n] = (f32x4){0.f, 0.f, 0.f, 0.f};
    bf16x8 At[4][2], B0[2][2], B1[2][2];
    const char* cA = (const char*)g.A + (size_t)cur.pm * tstep + (size_t)cur.koff * 2; const char* cB = (const char*)g.Bt + (size_t)cur.pn * tstep + (size_t)cur.koff * 2;
    S.a_ready(cur);
    PG8_STAGE(PG8_SB(0, 0), cB, voffB); PG8_STAGE(PG8_SA(0, 0), cA, voffA); PG8_STAGE(PG8_SB(0, 1), cB + hstep, voffB); PG8_STAGE(PG8_SA(0, 1), cA + hstep, voffA);
    if (wr == 1) PG8_BAR;
    PG8_WAIT_V(4); PG8_BAR;
    PG8_STAGE(PG8_SB(1, 0), cB + kstep, voffB); PG8_STAGE(PG8_SA(1, 0), cA + kstep, voffA); PG8_STAGE(PG8_SB(1, 1), cB + hstep + kstep, voffB);
    PG8_WAIT_V(6); PG8_BAR;
    PG8_STAMP();
    for (;;) {
        const bool has_next = S.next(ui + 1, nxt);
        const char* nA = has_next ? (const char*)g.A + (size_t)nxt.pm * tstep + (size_t)nxt.koff * 2 : cA; const char* nB = has_next ? (const char*)g.Bt + (size_t)nxt.pn * tstep + (size_t)nxt.koff * 2 : cB;
        const int nt = cur.nt;
        for (int t = 0; t < nt; t += 2) {
            const bool last = (t == nt - 2);
            const char* a1 = cA + (size_t)(t + 1) * kstep;
            const char* a2 = last ? nA : cA + (size_t)(t + 2) * kstep; const char* b2 = last ? nB : cB + (size_t)(t + 2) * kstep;
            const char* a3 = a2 + kstep; const char* b3 = b2 + kstep;
            if (last && has_next) S.a_ready(nxt);
            PG8_LDB(B0, 0, 0); PG8_SCHED; PG8_LDA(At, 0, 0); PG8_STAGE(PG8_SA(1, 1), a1 + hstep, voffA);
            PG8_WAIT_L(8); PG8_BAR; PG8_WAIT_L(0); PG8_MMA(0, 0, At, B0); PG8_BAR; PG8_SCHED;
            PG8_LDB(B1, 0, 1); PG8_STAGE(PG8_SB(0, 0), b2, voffB);
            PG8_BAR; PG8_WAIT_L(0); PG8_MMA(0, 1, At, B1); PG8_BAR;
            PG8_LDA(At, 0, 1); PG8_STAGE(PG8_SA(0, 0), a2, voffA);
            PG8_BAR; PG8_WAIT_L(0); PG8_MMA(1, 0, At, B0); PG8_BAR; PG8_SCHED;
            PG8_STAGE(PG8_SB(0, 1), b2 + hstep, voffB);
            PG8_WAIT_V(6); PG8_BAR; PG8_MMA(1, 1, At, B1); PG8_BAR;
            PG8_LDB(B0, 1, 0); PG8_SCHED; PG8_LDA(At, 1, 0); PG8_STAGE(PG8_SA(0, 1), a2 + hstep, voffA);
            PG8_WAIT_L(8); PG8_BAR; PG8_WAIT_L(0); PG8_MMA(0, 0, At, B0); PG8_BAR; PG8_SCHED;
            PG8_LDB(B1, 1, 1); PG8_STAGE(PG8_SB(1, 0), b3, voffB);
            PG8_BAR; PG8_WAIT_L(0); PG8_MMA(0, 1, At, B1); PG8_BAR;
            PG8_LDA(At, 1, 1); PG8_STAGE(PG8_SA(1, 0), a3, voffA);
            PG8_BAR; PG8_WAIT_L(0); PG8_MMA(1, 0, At, B0); PG8_BAR; PG8_SCHED;
            PG8_STAGE(PG8_SB(1, 1), b3 + hstep, voffB);
            PG8_WAIT_V(6); PG8_BAR; PG8_MMA(1, 1, At, B1); PG8_BAR;
        }
        PG8_STAMP();
        if constexpr (!Epi::AFTER_DRAIN) { E(acc, cur, wr, wc, fr, fq); S.done(cur); }
        PG8_STAMP();
        if (!has_next) break;
#pragma unroll
        for (int a = 0; a < 2; ++a)
#pragma unroll
            for (int b = 0; b < 2; ++b)
#pragma unroll
                for (int m = 0; m < 4; ++m)
#pragma unroll
                    for (int n = 0; n < 2; ++n) acc[a][b][m][n] = (f32x4){0.f, 0.f, 0.f, 0.f};
        cur = nxt; cA = nA; cB = nB; ++ui;
    }
    PG8_WAIT_V(0);
    if (wr == 0) PG8_BAR;
    PG8_BAR;
    if constexpr (Epi::AFTER_DRAIN) { E.fused(acc, cur, wr, wc, fr, fq, lds, wid, lane); S.done(cur); }
    PG8_STAMP();
    if (STAMP && wid == 0) { stamps[lane] = lane < nts ? (((unsigned long long)(unsigned)ts_hi << 32) | (unsigned)ts_lo) : 0ull;
        if (lane == 62) stamps[62] = rt_entry; if (lane == 63) stamps[63] = (unsigned long long)wall_clock64(); }
#undef PG8_STAMP
#undef PG8_SA
#undef PG8_SB
#undef PG8_STAGE
#undef PG8_LDA
#undef PG8_LDB
#undef PG8_MMA
#undef PG8_WAIT_V
#undef PG8_WAIT_L
#undef PG8_BAR
#undef PG8_SCHED
}
}

#define LAS __attribute__((address_space(3)))
typedef unsigned short u16;
typedef short s16x4 __attribute__((ext_vector_type(4)));
typedef unsigned u32x2 __attribute__((ext_vector_type(2)));
typedef __bf16 bf2_t __attribute__((ext_vector_type(2)));
typedef float f2_t __attribute__((ext_vector_type(2)));
using pg8::bf16x8; using pg8::f32x4; using pg8::u32x4;

constexpr int DM = 2048, SEQ = 16384, RLAT = 32768, LCTX = 256, MROWS = 33280, DFF = 8192;
constexpr int PLD = 5376, NPROJ = 5632, NIN = 5400;
constexpr int OFF_GU = 0, OFF_GV = 512, OFF_AQ = 1024, OFF_AK = 1792, OFF_AV = 2048, OFF_MQ = 2304, OFF_MK = 3072, OFF_MV = 3840, OFF_MO = 4608;
constexpr int NCH = 130;
constexpr int NSEQ = 24;
constexpr float EPSN = 1e-6f;
constexpr float LOG2E = 1.4426950408889634f;
constexpr float QSCALE = 0.08838834764831845f;

constexpr size_t WS_WIN = 0;
constexpr size_t SZ_WIN = (size_t)NPROJ * DM * 2;
constexpr size_t WS_WOUT = WS_WIN + 2 * SZ_WIN;
constexpr size_t SZ_WOUT = (size_t)DM * DM * 2;
constexpr size_t WS_WFF1 = WS_WOUT + 2 * SZ_WOUT;
constexpr size_t SZ_WFF = (size_t)DFF * DM * 2;
constexpr size_t WS_WFF2 = WS_WFF1 + 2 * SZ_WFF;
constexpr size_t WS_MOD = WS_WFF2 + 2 * SZ_WFF;
constexpr size_t WS_ROPE = WS_MOD + 2 * 3 * 12288 * 4;
constexpr size_t WS_XC = WS_ROPE + 320 * 32 * 8;
constexpr size_t WS_GATES = WS_XC + (size_t)512 * DM * 4;
constexpr size_t WS_NST = WS_GATES + (size_t)MROWS * 32 * 4;
constexpr size_t WS_GSC = WS_NST + (size_t)NSEQ * NCH * 128 * 4;
constexpr size_t WS_MLS = WS_GSC + 16384;
constexpr size_t WS_M0 = WS_MLS + 16384;
constexpr size_t WS_SS = WS_M0 + 16384;
constexpr size_t WS_BIASP = WS_SS + (size_t)4 * MROWS * 4;
constexpr size_t WS_BIASF = WS_BIASP + (size_t)2 * 3 * NPROJ * 4;
constexpr size_t WS_GS = WS_BIASF + (size_t)2 * 3 * DFF * 4;
constexpr size_t WS_CTR = WS_GS + (size_t)2 * 2 * 3 * DM * 4;
constexpr size_t WS_BAR = WS_CTR + 256;
constexpr size_t WS_XN = WS_BAR + 16384;
constexpr size_t WS_R = WS_XN + (size_t)MROWS * DM * 2;
constexpr size_t SZ_PROJ = (size_t)MROWS * PLD * 2;
constexpr size_t WS_Y = WS_R + SZ_PROJ;
constexpr size_t SZ_H = (size_t)MROWS * DFF * 2;
constexpr size_t WS_CST = WS_R + SZ_H;
constexpr size_t WS_END = WS_CST + (size_t)NSEQ * NCH * 16384 * 2;

constexpr int LDS_BYTES = 163840;
constexpr int TSTR = 320;
constexpr int TILE_B = 128 * TSTR;
constexpr int SC_OFF = 3 * TILE_B;

struct Params {
    const float *x, *c, *ctx, *c_ctx, *w_ada, *b_ada, *g_mix, *g_ffn, *w_in, *gm_v_gain, *gm_w_s, *gm_b_s, *attn_sink,
        *ml_conv_w, *ml_conv_b, *ml_b_i, *ml_b_f, *ml_out_gain, *w_out, *w_ff1, *w_ff2, *g_final;
    float* out; unsigned char* ws;
};

#define DI __device__ __forceinline__
typedef const __attribute__((address_space(4))) Params* KP;
DI int tid_l() { int t = threadIdx.x; asm volatile("" : "+v"(t)); return t; }
DI KP launder(KP p) { asm volatile("" : "+s"(p)); return p; }
DI unsigned pk2(float lo, float hi) { bf2_t v = __builtin_convertvector((f2_t){lo, hi}, bf2_t); return __builtin_bit_cast(unsigned, v); }
DI float bf_lo(unsigned u) { return __uint_as_float(u << 16); }
DI float bf_hi(unsigned u) { return __uint_as_float(u & 0xffff0000u); }
DI float wave_sum(float v) {
#pragma unroll
    for (int o = 1; o < 64; o <<= 1) v += __shfl_xor(v, o);
    return v;
}
DI float wave_max(float v) {
#pragma unroll
    for (int o = 1; o < 64; o <<= 1) v = fmaxf(v, __shfl_xor(v, o));
    return v;
}
DI float gelu_tanh(float x) {
    const float k1 = -2.f * 0.7978845608028654f * LOG2E, k2 = k1 * 0.044715f;
    const float a = x * __builtin_fmaf(x * x, k2, k1);
    return x * __builtin_amdgcn_rcpf(1.f + __builtin_amdgcn_exp2f(a));
}
DI float sigmoidf_(float x) { return __builtin_amdgcn_rcpf(1.f + __builtin_amdgcn_exp2f(-LOG2E * x)); }
DI float log_sigmoid(float x) { return fminf(x, 0.f) - log1pf(__expf(-fabsf(x))); }
DI void unpack8(const u32x4 v, float* f) { f[0] = bf_lo(v.x); f[1] = bf_hi(v.x); f[2] = bf_lo(v.y); f[3] = bf_hi(v.y); f[4] = bf_lo(v.z); f[5] = bf_hi(v.z); f[6] = bf_lo(v.w); f[7] = bf_hi(v.w); }
DI u32x4 pack8(const float* f) { u32x4 o; o.x = pk2(f[0], f[1]); o.y = pk2(f[2], f[3]); o.z = pk2(f[4], f[5]); o.w = pk2(f[6], f[7]); return o; }
#define MFMA16(a, b, c) __builtin_amdgcn_mfma_f32_16x16x32_bf16((a), (b), (c), 0, 0, 0)

DI int toff(int row, int ch) { return row * TSTR + 16 * ch; }
DI bf16x8 frag_row(const LAS unsigned char* tile, int idx0, int k0, int lane) {
    return *(const LAS bf16x8*)(tile + toff(idx0 + (lane & 15), (k0 >> 3) + (lane >> 4)));
}
DI bf16x8 tr_pair(const LAS unsigned char* p, const LAS unsigned char* p2) {
    s16x4 a = __builtin_amdgcn_ds_read_tr16_b64_v4i16((LAS s16x4*)p);
    s16x4 b = __builtin_amdgcn_ds_read_tr16_b64_v4i16((LAS s16x4*)p2);
    return (bf16x8){a[0], a[1], a[2], a[3], b[0], b[1], b[2], b[3]};
}
DI bf16x8 frag_tr(const LAS unsigned char* tile, int k0, int idx0, int lane) {
    const int i = lane & 15, q = lane >> 4, row = k0 + 8 * q + (i >> 2), ch = (idx0 >> 3) + ((i & 3) >> 1), sub = 8 * (i & 1);
    return tr_pair(tile + toff(row, ch) + sub, tile + toff(row + 4, ch) + sub);
}
DI bf16x8 frag_tr_perm(const LAS unsigned char* tile, int k0, int idx0, int lane) {
    const int i = lane & 15, q = lane >> 4, row = k0 + 4 * q + (i >> 2), ch = (idx0 >> 3) + ((i & 3) >> 1), sub = 8 * (i & 1);
    const LAS unsigned char* a = tile + toff(row, ch) + sub;
    return tr_pair(a, a + 16 * TSTR);
}

DI const float* xrow_in(KP p, int stage, int row) {
    if (row < RLAT) return (stage ? (const float*)p->out : p->x) + (size_t)row * DM;
    return (stage ? (const float*)(p->ws + WS_XC) : p->ctx) + (size_t)(row - RLAT) * DM;
}
DI float* xrow_out(KP p, int row) {
    if (row < RLAT) return p->out + (size_t)row * DM;
    return (float*)(p->ws + WS_XC) + (size_t)(row - RLAT) * DM;
}
DI int mod_index(int row) { return row < SEQ ? 0 : (row < RLAT ? 1 : 2); }
DI float row_rstd(const float* ss, int row) { return rsqrtf(ss[row] * (1.f / DM) + EPSN); }

DI void transpose_item(const float* W, int K, int N, u16* WT, LAS float* scr  , int item, int nblk, int lane) {
    const int kb = item / nblk, nb = item % nblk, k0 = 64 * kb, n0 = 64 * nb;
    const int c4 = lane & 15, rr = lane >> 4;
    const bool ok = n0 + 4 * c4 < N;
    f32x4 v[16];
#pragma unroll
    for (int i = 0; i < 16; ++i) v[i] = ok ? *(const f32x4*)(W + (size_t)(k0 + 4 * i + rr) * N + n0 + 4 * c4) : (f32x4){0.f, 0.f, 0.f, 0.f};
#pragma unroll
    for (int i = 0; i < 16; ++i) { LAS float* d = scr + (4 * i + rr) * 65 + 4 * c4; d[0] = v[i].x; d[1] = v[i].y; d[2] = v[i].z; d[3] = v[i].w; }
    asm volatile("s_waitcnt lgkmcnt(0)" ::: "memory"); __builtin_amdgcn_wave_barrier();
    const int c = lane & 7;
#pragma unroll
    for (int j = 0; j < 8; ++j) { const int nn = (lane >> 3) + 8 * j; const LAS float* q = scr + (8 * c) * 65 + nn;
        u32x4 o; o.x = pk2(q[0 * 65], q[1 * 65]); o.y = pk2(q[2 * 65], q[3 * 65]); o.z = pk2(q[4 * 65], q[5 * 65]); o.w = pk2(q[6 * 65], q[7 * 65]);
        *(u32x4*)(WT + (size_t)(n0 + nn) * K + k0 + 8 * c) = o; }
    asm volatile("s_waitcnt lgkmcnt(0)" ::: "memory"); __builtin_amdgcn_wave_barrier();
}

DI void phase_prep(KP p, LAS unsigned char* lds) {
    const int tid = tid_l(), lane = tid & 63, wave = tid >> 6, bid = blockIdx.x, G = gridDim.x;
    { float* SS = (float*)(p->ws + WS_SS);
      for (int i = bid * 512 + tid; i < 3 * MROWS; i += G * 512) SS[i] = 0.f;
      if (bid == 0 && tid < 64) ((unsigned*)(p->ws + WS_CTR))[tid] = 0u; }
    { const f32x4* src = (const f32x4*)p->ctx; f32x4* dst = (f32x4*)(p->ws + WS_XC);
      for (int i = bid * 512 + tid; i < 512 * DM / 4; i += G * 512) dst[i] = src[i]; }
    {
        LAS float* sv = (LAS float*)lds;
        LAS float* red = (LAS float*)(lds + 3 * 2048 * 4);
        for (int i = tid; i < 3 * 2048; i += 512) { const int v = i >> 11, k = i & 2047; const float x = v == 0 ? p->c[k] : (v == 1 ? p->c[2048 + k] : p->c_ctx[k]); sv[i] = x * sigmoidf_(x); }
        __syncthreads();
        float* MOD = (float*)(p->ws + WS_MOD);
        for (int it = bid; it < 2 * 384; it += G) {
            const int l = it / 384, n0 = (it % 384) * 32, j = tid & 7, kk = tid >> 3;
            const float* w = p->w_ada + (size_t)l * 2048 * 12288 + n0 + 4 * j;
            f32x4 a0 = {0, 0, 0, 0}, a1 = a0, a2 = a0;
#pragma unroll 16
            for (int k = kk; k < 2048; k += 64) { const f32x4 wv = *(const f32x4*)(w + (size_t)k * 12288); a0 += wv * sv[k]; a1 += wv * sv[2048 + k]; a2 += wv * sv[4096 + k]; }
            LAS float* r = red + (kk * 8 + j) * 12;
            *(LAS f32x4*)(r) = a0; *(LAS f32x4*)(r + 4) = a1; *(LAS f32x4*)(r + 8) = a2;
            __syncthreads();
            if (tid < 96) { const int v = tid >> 5, cc = tid & 31, jj = cc >> 2, e = cc & 3; float sum = 0.f;
                for (int q = 0; q < 64; ++q) sum += red[(q * 8 + jj) * 12 + v * 4 + e];
                MOD[(size_t)(l * 3 + v) * 12288 + n0 + cc] = sum + p->b_ada[l * 12288 + n0 + cc]; }
            __syncthreads();
        }
    }
    {
        f2_t* ROPE = (f2_t*)(p->ws + WS_ROPE);
        for (int i = bid * 512 + tid; i < 320 * 32; i += G * 512) { const int pos = i >> 5, f = i & 31; const int pa = pos < 256 ? pos : pos - 256;
            const float freq = 1.0f / powf(10000.0f, (float)(2 * f) / 64.0f); const float ang = (float)pa * freq; ROPE[i] = (f2_t){cosf(ang), sinf(ang)}; }
    }
    {
        LAS float* scr = (LAS float*)(lds + wave * 16640);
        const int gw = bid * 8 + wave, NGW = G * 8;
        constexpr int I_IN = 32 * 88, I_OUT = 32 * 32, I_F1 = 32 * 128, I_F2 = 128 * 32, I_L = I_IN + I_OUT + I_F1 + I_F2;
        for (int it = gw; it < 2 * I_L; it += NGW) {
            const int l = it / I_L; int r = it % I_L;
            if (r < I_IN) { transpose_item(p->w_in + (size_t)l * DM * NIN, DM, NIN, (u16*)(p->ws + WS_WIN + l * SZ_WIN), scr, r, 88, lane); continue; } r -= I_IN;
            if (r < I_OUT) { transpose_item(p->w_out + (size_t)l * DM * DM, DM, DM, (u16*)(p->ws + WS_WOUT + l * SZ_WOUT), scr, r, 32, lane); continue; } r -= I_OUT;
            if (r < I_F1) { transpose_item(p->w_ff1 + (size_t)l * DM * DFF, DM, DFF, (u16*)(p->ws + WS_WFF1 + l * SZ_WFF), scr, r, 128, lane); continue; } r -= I_F1;
            transpose_item(p->w_ff2 + (size_t)l * DFF * DM, DFF, DM, (u16*)(p->ws + WS_WFF2 + l * SZ_WFF), scr, r, 32, lane);
        }
    }
}

DI void phase_prep2(KP p, LAS unsigned char* lds) {
    const int tid = tid_l(), lane = tid & 63, wave = tid >> 6, bid = blockIdx.x, G = gridDim.x;
    const float* MOD = (const float*)(p->ws + WS_MOD);
    { float* GS = (float*)(p->ws + WS_GS);
      for (int i = bid * 512 + tid; i < 2 * 2 * 3 * DM; i += G * 512) { const int k = i & 2047, cls = (i >> 11) % 3, which = (i / (3 * DM)) & 1, l = i / (6 * DM);
          GS[i] = (which ? p->g_ffn : p->g_mix)[l * DM + k] * (1.f + MOD[(size_t)(l * 3 + cls) * 12288 + (which * 3 + 1) * DM + k]); } }
    LAS float* sh = (LAS float*)lds;
    const int gw = bid * 8 + wave, NGW = G * 8;
    for (int l = 0; l < 2; ++l) {
        __syncthreads();
        for (int i = tid; i < 6 * DM; i += 512) { const int k = i & 2047, cls = (i >> 11) % 3, which = i / (3 * DM); sh[i] = MOD[(size_t)(l * 3 + cls) * 12288 + (which * 3) * DM + k]; }
        __syncthreads();
        for (int r = gw; r < NPROJ + DFF; r += NGW) {
            const bool isf = r >= NPROJ; const int n = isf ? r - NPROJ : r;
            const u16* wrow = isf ? (const u16*)(p->ws + WS_WFF1 + l * SZ_WFF) + (size_t)n * DM : (const u16*)(p->ws + WS_WIN + l * SZ_WIN) + (size_t)n * DM;
            const LAS float* s0 = sh + (isf ? 3 * DM : 0);
            float a0 = 0.f, a1 = 0.f, a2 = 0.f;
#pragma unroll
            for (int j = 0; j < 4; ++j) { const int k = 8 * (lane + 64 * j); float w[8]; unpack8(*(const u32x4*)(wrow + k), w);
#pragma unroll
                for (int e = 0; e < 8; ++e) { a0 += w[e] * s0[k + e]; a1 += w[e] * s0[DM + k + e]; a2 += w[e] * s0[2 * DM + k + e]; } }
            a0 = wave_sum(a0); a1 = wave_sum(a1); a2 = wave_sum(a2);
            if (lane == 0) { float* B = isf ? (float*)(p->ws + WS_BIASF) + (size_t)l * 3 * DFF : (float*)(p->ws + WS_BIASP) + (size_t)l * 3 * NPROJ; const int N = isf ? DFF : NPROJ;
                B[n] = a0; B[N + n] = a1; B[2 * N + n] = a2; }
        }
    }
}

DI void phase_norm0(KP p) {
    const int tid = tid_l(), lane = tid & 63, gw = blockIdx.x * 8 + (tid >> 6), NGW = gridDim.x * 8;
    const float* gain = p->g_mix;
    u16* XN = (u16*)(p->ws + WS_XN);
    float* SS = (float*)(p->ws + WS_SS) + 3 * MROWS;
    f32x4 v[8], nx[8];
    if (gw < MROWS) { const float* xr = xrow_in(p, 0, gw);
#pragma unroll
        for (int j = 0; j < 8; ++j) v[j] = *(const f32x4*)(xr + 4 * lane + 256 * j); }
    for (int row = gw; row < MROWS; row += NGW) {
        const int nrow = row + NGW;
        if (nrow < MROWS) { const float* xr = xrow_in(p, 0, nrow);
#pragma unroll
            for (int j = 0; j < 8; ++j) nx[j] = *(const f32x4*)(xr + 4 * lane + 256 * j); }
        const float* md = (const float*)(p->ws + WS_MOD) + (size_t)mod_index(row) * 12288;
        float sum = 0.f;
#pragma unroll
        for (int j = 0; j < 8; ++j) sum += (v[j].x * v[j].x + v[j].y * v[j].y) + (v[j].z * v[j].z + v[j].w * v[j].w);
        sum = wave_sum(sum);
        if (lane == 0) SS[row] = sum;
#pragma unroll
        for (int j = 0; j < 8; ++j) { const int c = 4 * lane + 256 * j;
            const f32x4 g = *(const f32x4*)(gain + c), sc = *(const f32x4*)(md + DM + c);
            const f32x4 y = (v[j] * g) * (sc + 1.f);
            u32x2 o; o.x = pk2(y.x, y.y); o.y = pk2(y.z, y.w);
            *(u32x2*)(XN + (size_t)row * DM + c) = o; }
#pragma unroll
        for (int j = 0; j < 8; ++j) v[j] = nx[j];
    }
}
DI void phase_ctx_norm(KP p, const float* gs  , float* ss, int nsp) {
    const int tid = tid_l(), lane = tid & 63, gw = blockIdx.x * 8 + (tid >> 6), NGW = gridDim.x * 8;
    u16* XN = (u16*)(p->ws + WS_XN);
    for (int row = RLAT + gw; row < MROWS; row += NGW) {
        float* xr = (float*)(p->ws + WS_XC) + (size_t)(row - RLAT) * DM;
        const float* part = (const float*)(p->ws + WS_CST) + (size_t)(row - RLAT) * DM;
        f32x4 v[8]; float sum = 0.f;
#pragma unroll
        for (int j = 0; j < 8; ++j) v[j] = *(const f32x4*)(xr + 4 * lane + 256 * j);
        for (int ks = 0; ks < nsp; ++ks) {
#pragma unroll
            for (int j = 0; j < 8; ++j) v[j] += *(const f32x4*)(part + (size_t)ks * 512 * DM + 4 * lane + 256 * j); }
#pragma unroll
        for (int j = 0; j < 8; ++j) { *(f32x4*)(xr + 4 * lane + 256 * j) = v[j]; sum += (v[j].x * v[j].x + v[j].y * v[j].y) + (v[j].z * v[j].z + v[j].w * v[j].w); }
        sum = wave_sum(sum);
        if (lane == 0) ss[row] = sum;
#pragma unroll
        for (int j = 0; j < 8; ++j) { const int c = 4 * lane + 256 * j; const f32x4 y = v[j] * *(const f32x4*)(gs + c);
            u32x2 o; o.x = pk2(y.x, y.y); o.y = pk2(y.z, y.w); *(u32x2*)(XN + (size_t)row * DM + c) = o; }
    }
}
DI void phase_final(KP p) {
    const int tid = tid_l(), lane = tid & 63, gw = blockIdx.x * 8 + (tid >> 6), NGW = gridDim.x * 8;
    f32x4 v[8], nx[8];
    if (gw < RLAT) { const float* xr = p->out + (size_t)gw * DM;
#pragma unroll
        for (int j = 0; j < 8; ++j) v[j] = *(const f32x4*)(xr + 4 * lane + 256 * j); }
    for (int row = gw; row < RLAT; row += NGW) {
        const int nrow = row + NGW;
        if (nrow < RLAT) { const float* xn = p->out + (size_t)nrow * DM;
#pragma unroll
            for (int j = 0; j < 8; ++j) nx[j] = *(const f32x4*)(xn + 4 * lane + 256 * j); }
        float* xr = p->out + (size_t)row * DM;
        float sum = 0.f;
#pragma unroll
        for (int j = 0; j < 8; ++j) sum += (v[j].x * v[j].x + v[j].y * v[j].y) + (v[j].z * v[j].z + v[j].w * v[j].w);
        const float rstd = rsqrtf(wave_sum(sum) * (1.f / DM) + EPSN);
#pragma unroll
        for (int j = 0; j < 8; ++j) { const int c = 4 * lane + 256 * j; const f32x4 g = *(const f32x4*)(p->g_final + c); *(f32x4*)(xr + c) = v[j] * rstd * g; }
#pragma unroll
        for (int j = 0; j < 8; ++j) v[j] = nx[j];
    }
}

struct EpiProj {
    static constexpr bool PERM = true, AFTER_DRAIN = false;
    u16* O; float* gates; const float* ss; const float* bias0;
    __device__ __forceinline__ void operator()(const f32x4 (&acc)[2][2][4][2], const pg8::Unit& u, int wr, int wc, int fr, int fq) const {
        const int row0 = u.pm * 256 + wr * 64 + fr;
        const float* bias = bias0 + (size_t)mod_index(u.pm * 256) * NPROJ + u.pn * 256 + wc * 32 + 8 * fq;
        float rs[2][4];
#pragma unroll
        for (int ai = 0; ai < 2; ++ai)
#pragma unroll
            for (int m = 0; m < 4; ++m) rs[ai][m] = row_rstd(ss, row0 + ai * 128 + m * 16);
        {
            const int col0 = u.pn * 256 + wc * 32 + 8 * fq;
#pragma unroll
            for (int bj = 0; bj < 2; ++bj) { const f32x4 b0 = *(const f32x4*)(bias + bj * 128), b1 = *(const f32x4*)(bias + bj * 128 + 4);
#pragma unroll
                for (int ai = 0; ai < 2; ++ai)
#pragma unroll
                    for (int m = 0; m < 4; ++m) { const f32x4 v0 = acc[ai][bj][m][0] * rs[ai][m] + b0, v1 = acc[ai][bj][m][1] * rs[ai][m] + b1;
                        u32x4 o; o.x = pk2(v0[0], v0[1]); o.y = pk2(v0[2], v0[3]); o.z = pk2(v1[0], v1[1]); o.w = pk2(v1[2], v1[3]);
                        *(u32x4*)(O + (size_t)(row0 + ai * 128 + m * 16) * PLD + col0 + bj * 128) = o; } }
        }
    }
};
struct EpiRes {
    static constexpr bool PERM = false, AFTER_DRAIN = false;
    KP p; int stage; const float* gate0;
    const float* gs0; float* ssn;
    int ntfull;
    __device__ __forceinline__ void operator()(const f32x4 (&acc)[2][2][4][2], const pg8::Unit& u, int wr, int wc, int fr, int fq) const {
        const int row0 = u.pm * 256 + wr * 64 + fr, col0 = u.pn * 256 + wc * 32 + 4 * fq, cls = mod_index(u.pm * 256);
        const float* gate = gate0 + (size_t)cls * 12288 + col0;
        if (u.nt != ntfull) {
#pragma unroll
            for (int ai = 0; ai < 2; ++ai)
#pragma unroll
                for (int m = 0; m < 4; ++m) { float* xo = (float*)(p->ws + WS_CST) + ((size_t)(u.koff / 512) * 512 + (row0 + ai * 128 + m * 16 - RLAT)) * DM + col0;
#pragma unroll
                    for (int bj = 0; bj < 2; ++bj)
#pragma unroll
                        for (int n = 0; n < 2; ++n) { const int co = bj * 128 + n * 16; *(f32x4*)(xo + co) = *(const f32x4*)(gate + co) * acc[ai][bj][m][n]; } }
            return;
        }
        const float* gs = gs0 ? gs0 + cls * DM + col0 : nullptr;
        u16* XN = (u16*)(p->ws + WS_XN);
#pragma unroll
        for (int am = 0; am < 4; ++am) {
            f32x4 xv[2][2][2];
#pragma unroll
            for (int h = 0; h < 2; ++h) { const int ai = am >> 1, m = (am & 1) * 2 + h; const float* xi = xrow_in(p, stage, row0 + ai * 128 + m * 16) + col0;
#pragma unroll
                for (int bj = 0; bj < 2; ++bj)
#pragma unroll
                    for (int n = 0; n < 2; ++n) xv[h][bj][n] = *(const f32x4*)(xi + bj * 128 + n * 16); }
#pragma unroll
            for (int h = 0; h < 2; ++h) { const int ai = am >> 1, m = (am & 1) * 2 + h; const int row = row0 + ai * 128 + m * 16; float* xo = xrow_out(p, row) + col0;
                float sq = 0.f;
#pragma unroll
                for (int bj = 0; bj < 2; ++bj)
#pragma unroll
                    for (int n = 0; n < 2; ++n) { const int co = bj * 128 + n * 16;
                        const f32x4 v = xv[h][bj][n] + *(const f32x4*)(gate + co) * acc[ai][bj][m][n];
                        *(f32x4*)(xo + co) = v;
                        if (gs) { const f32x4 y = v * *(const f32x4*)(gs + co); u32x2 o; o.x = pk2(y.x, y.y); o.y = pk2(y.z, y.w);
                            *(u32x2*)(XN + (size_t)row * DM + col0 + co) = o; sq += (v.x * v.x + v.y * v.y) + (v.z * v.z + v.w * v.w); } }
                if (gs) { sq += __shfl_xor(sq, 16); sq += __shfl_xor(sq, 32); if (fq == 0) atomicAdd(ssn + row, sq); } }
        }
    }
};
struct EpiSqRelu {
    static constexpr bool PERM = true, AFTER_DRAIN = false;
    u16* O; const float* ss; const float* bias0;
    __device__ __forceinline__ void operator()(const f32x4 (&acc)[2][2][4][2], const pg8::Unit& u, int wr, int wc, int fr, int fq) const {
        const int row0 = u.pm * 256 + wr * 64 + fr, col0 = u.pn * 256 + wc * 32 + 8 * fq;
        const float* bias = bias0 + (size_t)mod_index(u.pm * 256) * DFF + col0;
        float rs[2][4];
#pragma unroll
        for (int ai = 0; ai < 2; ++ai)
#pragma unroll
            for (int m = 0; m < 4; ++m) rs[ai][m] = row_rstd(ss, row0 + ai * 128 + m * 16);
#pragma unroll
        for (int bj = 0; bj < 2; ++bj) { const f32x4 b0 = *(const f32x4*)(bias + bj * 128), b1 = *(const f32x4*)(bias + bj * 128 + 4);
#pragma unroll
            for (int ai = 0; ai < 2; ++ai)
#pragma unroll
                for (int m = 0; m < 4; ++m) { f32x4 v0 = acc[ai][bj][m][0] * rs[ai][m] + b0, v1 = acc[ai][bj][m][1] * rs[ai][m] + b1;
#pragma unroll
                    for (int e = 0; e < 4; ++e) { const float a = fmaxf(v0[e], 0.f), b = fmaxf(v1[e], 0.f); v0[e] = a * a; v1[e] = b * b; }
                    u32x4 o; o.x = pk2(v0[0], v0[1]); o.y = pk2(v0[2], v0[3]); o.z = pk2(v1[0], v1[1]); o.w = pk2(v1[2], v1[3]);
                    *(u32x4*)(O + (size_t)(row0 + ai * 128 + m * 16) * DFF + col0 + bj * 128) = o; } }
    }
};
template <class Epi> DI void run_gemm(LAS unsigned char* lds, const u16* A, const u16* Bt, int M, int N, int K, const Epi& E) {
    pg8::Gemm g; g.A = A; g.Bt = Bt; g.M = M; g.N = N; g.K = K;
    pg8::StaticOrder S; S.init(M, N, K, (int)gridDim.x, (int)blockIdx.x);
    pg8::gemm_phase<Epi, pg8::StaticOrder, false>(lds, g, S, E, nullptr);
}
struct SplitOrder : pg8::StaticOrder {
    int nsp, ksp, ntsp, pm0, nctx;
    __device__ __forceinline__ bool next(int i, pg8::Unit& u) const {
        const long L = (long)i * G + c;
        if (L < nwg) return pg8::StaticOrder::next(i, u);
        const int q = (int)(L - nwg); if (q >= nctx) return false;
        const int tile = q % (2 * nN), ks = q / (2 * nN);
        u.pm = pm0 + tile / nN; u.pn = tile % nN; u.koff = ks * ksp; u.nt = ntsp; return true;
    }
};
template <class Epi> DI void run_gemm_split(LAS unsigned char* lds, const u16* A, const u16* Bt, int Mlat, int N, int K, int nsp, const Epi& E) {
    pg8::Gemm g; g.A = A; g.Bt = Bt; g.M = Mlat; g.N = N; g.K = K;
    SplitOrder S; S.init(Mlat, N, K, (int)gridDim.x, (int)blockIdx.x);
    S.nsp = nsp; S.ksp = nsp ? K / nsp : K; S.ntsp = S.ksp / 64; S.pm0 = Mlat / 256; S.nctx = nsp ? 2 * (N / 256) * nsp : 0;
    S.wgm = 4;
    pg8::gemm_phase<Epi, SplitOrder, false>(lds, g, S, E, nullptr);
}


DI void stage_plain(LAS unsigned char* T, const u16* src, int ld, int tid) {
#pragma unroll
    for (int i = 0; i < 4; ++i) { const int id = tid + 512 * i, row = id >> 4, ch = id & 15;
        *(LAS u32x4*)(T + toff(row, ch)) = *(const u32x4*)(src + (size_t)row * ld + ch * 8); }
}
DI void stage_rope(LAS unsigned char* T, const u16* src, int ld, int pos0, float scale, const f2_t* ROPE, int tid) {
#pragma unroll
    for (int i = 0; i < 2; ++i) { const int task = tid + 512 * i, row = task >> 3, pp = task & 7, cq = pp & 3, half = pp >> 2, chA = half * 8 + cq;
        const int pos = pos0 + row, pa = half ? 256 + (pos & 63) : (pos >> 6);
        const u32x4 ra = *(const u32x4*)(src + (size_t)row * ld + chA * 8), rb = *(const u32x4*)(src + (size_t)row * ld + (chA + 4) * 8);
        float x1[8], x2[8], o1[8], o2[8]; unpack8(ra, x1); unpack8(rb, x2);
        const f2_t* tb = ROPE + pa * 32 + cq * 8;
#pragma unroll
        for (int e = 0; e < 8; ++e) { const f2_t cs = tb[e]; o1[e] = (x1[e] * cs.x - x2[e] * cs.y) * scale; o2[e] = (x1[e] * cs.y + x2[e] * cs.x) * scale; }
        *(LAS u32x4*)(T + toff(row, chA)) = pack8(o1); *(LAS u32x4*)(T + toff(row, chA + 4)) = pack8(o2); }
}
DI void stage_conv(LAS unsigned char* T, const u16* src, int ld, int lo, int hi, const float* cw  , const float* cb, float scale, int tid, u16* gdst = nullptr  ) {
#pragma unroll
    for (int i = 0; i < 4; ++i) { const int id = tid + 512 * i, row = id >> 4, ch = id & 15;
        float xm[8], x0[8], xp[8], y[8];
        const u32x4 z = {0u, 0u, 0u, 0u};
        const bool okm = row - 1 >= lo, okp = row + 1 < hi;
        const u32x4 r0 = *(const u32x4*)(src + (size_t)row * ld + ch * 8);
        u32x4 rm = *(const u32x4*)(src + (ptrdiff_t)(okm ? row - 1 : row) * ld + ch * 8);
        u32x4 rp = *(const u32x4*)(src + (ptrdiff_t)(okp ? row + 1 : row) * ld + ch * 8);
        rm = okm ? rm : z; rp = okp ? rp : z;
        unpack8(rm, xm); unpack8(r0, x0); unpack8(rp, xp);
#pragma unroll
        for (int e = 0; e < 8; ++e) { const int c = ch * 8 + e; const float v = cb[c] + xm[e] * cw[c] + x0[e] * cw[1536 + c] + xp[e] * cw[3072 + c]; y[e] = v * sigmoidf_(v) * scale; }
        const u32x4 pk = pack8(y);
        *(LAS u32x4*)(T + toff(row, ch)) = pk;
        if (gdst) *(u32x4*)(gdst + (size_t)row * 768 + ch * 8) = pk; }
}

DI void gate_item(KP p, int l, int it, LAS unsigned char* lds) {
    const int tid = tid_l(), lane = tid & 63, wid = tid >> 6, fr = lane & 15, fq = lane >> 4;
    const int r0 = it * 128, srow = tid >> 4, sch = tid & 15;
    const u16* xa = (const u16*)(p->ws + WS_XN) + (size_t)(r0 + srow) * DM + sch * 8;
    const u16* wg = (const u16*)(p->ws + WS_WIN + l * SZ_WIN) + (size_t)(PLD + (tid >> 4)) * DM + sch * 8;
    LAS unsigned char* T0 = lds; LAS unsigned char* T1 = lds + TILE_B;
    u32x4 ar[4], wreg;
#pragma unroll
    for (int i = 0; i < 4; ++i) ar[i] = *(const u32x4*)(xa + (size_t)(32 * i) * DM);
    wreg = *(const u32x4*)wg;
    f32x4 acc0 = {0.f, 0.f, 0.f, 0.f}, acc1 = {0.f, 0.f, 0.f, 0.f};
    for (int kc = 0; kc < 16; ++kc) {
        __syncthreads();
#pragma unroll
        for (int i = 0; i < 4; ++i) *(LAS u32x4*)(T0 + toff(srow + 32 * i, sch)) = ar[i];
        *(LAS u32x4*)(T1 + toff(srow, sch)) = wreg;
        if (kc < 15) {
#pragma unroll
            for (int i = 0; i < 4; ++i) ar[i] = *(const u32x4*)(xa + (size_t)(32 * i) * DM + (kc + 1) * 128);
            wreg = *(const u32x4*)(wg + (kc + 1) * 128); }
        __syncthreads();
#pragma unroll
        for (int ks = 0; ks < 4; ++ks) { const bf16x8 xf = frag_row(T0, 16 * wid, 32 * ks, lane);
            acc0 = MFMA16(frag_row(T1, 0, 32 * ks, lane), xf, acc0); acc1 = MFMA16(frag_row(T1, 16, 32 * ks, lane), xf, acc1); }
    }
    const int row = r0 + 16 * wid + fr;
    const float rs = row_rstd((const float*)(p->ws + WS_SS) + (l == 0 ? 3 : 1) * MROWS, row);
    const float* bias = (const float*)(p->ws + WS_BIASP) + (size_t)(l * 3 + mod_index(row)) * NPROJ + PLD + 4 * fq;
    float* gp = (float*)(p->ws + WS_GATES) + (size_t)row * 32 + 4 * fq;
    *(f32x4*)gp = acc0 * rs + *(const f32x4*)bias; *(f32x4*)(gp + 16) = acc1 * rs + *(const f32x4*)(bias + 16);
    __syncthreads();
}

DI void gmlp_item(KP p, int l, int it, LAS unsigned char* lds) {
    const int tid = tid_l(), lane = tid & 63, wid = tid >> 6, fr = lane & 15, fq = lane >> 4;
    const int n = it >> 2, g = it & 3, r0 = n * 128;
    if (l == 1 && n >= 256) return;
    const u16* proj = (const u16*)(p->ws + WS_R);
    u16* Y = (u16*)(p->ws + WS_Y);
    LAS unsigned char* T0 = lds; LAS unsigned char* T1 = lds + TILE_B;
    { const float* ws = p->gm_w_s + (size_t)(l * 4 + g) * 16384;
#pragma unroll
      for (int i = 0; i < 8; ++i) { const int f = tid + 512 * i, row = f >> 5, c4 = f & 31; const f32x4 v = *(const f32x4*)(ws + (size_t)f * 4);
          u32x2 o; o.x = pk2(v.x, v.y); o.y = pk2(v.z, v.w); *(LAS u32x2*)(T0 + toff(row, c4 >> 1) + 8 * (c4 & 1)) = o; } }
    { const float* vg = p->gm_v_gain + l * 512 + g * 128;
#pragma unroll
      for (int i = 0; i < 4; ++i) { const int id = tid + 512 * i, row = id >> 4, ch = id & 15;
          float v[8]; unpack8(*(const u32x4*)(proj + (size_t)(r0 + row) * PLD + OFF_GV + g * 128 + ch * 8), v);
          float ss = 0.f;
#pragma unroll
          for (int e = 0; e < 8; ++e) { v[e] = gelu_tanh(v[e]); ss += v[e] * v[e]; }
          ss += __shfl_xor(ss, 1); ss += __shfl_xor(ss, 2); ss += __shfl_xor(ss, 4); ss += __shfl_xor(ss, 8);
          const float rstd = rsqrtf(ss * (1.f / 128.f) + EPSN);
#pragma unroll
          for (int e = 0; e < 8; ++e) v[e] = v[e] * rstd * vg[ch * 8 + e];
          *(LAS u32x4*)(T1 + toff(row, ch)) = pack8(v); } }
    __syncthreads();
    const int cb = 32 * (wid >> 1), pb = 64 * (wid & 1);
    f32x4 acc[2][4];
#pragma unroll
    for (int a = 0; a < 2; ++a)
#pragma unroll
        for (int b = 0; b < 4; ++b) acc[a][b] = (f32x4){0.f, 0.f, 0.f, 0.f};
#pragma unroll
    for (int ks = 0; ks < 4; ++ks) {
        bf16x8 af[2], bfg[4];
#pragma unroll
        for (int a = 0; a < 2; ++a) af[a] = frag_tr(T1, 32 * ks, cb + 16 * a, lane);
#pragma unroll
        for (int b = 0; b < 4; ++b) bfg[b] = frag_row(T0, pb + 16 * b, 32 * ks, lane);
#pragma unroll
        for (int a = 0; a < 2; ++a)
#pragma unroll
            for (int b = 0; b < 4; ++b) acc[a][b] = MFMA16(af[a], bfg[b], acc[a][b]);
    }
    const float* bs = p->gm_b_s + (l * 4 + g) * 128;
#pragma unroll
    for (int a = 0; a < 2; ++a)
#pragma unroll
        for (int b = 0; b < 4; ++b) { const int pp = pb + 16 * b + fr, c0 = cb + 16 * a + 4 * fq; const float bias = bs[pp];
            const u32x2 uu = *(const u32x2*)(proj + (size_t)(r0 + pp) * PLD + OFF_GU + g * 128 + c0);
            const float u0 = gelu_tanh(bf_lo(uu.x)), u1 = gelu_tanh(bf_hi(uu.x)), u2 = gelu_tanh(bf_lo(uu.y)), u3 = gelu_tanh(bf_hi(uu.y));
            u32x2 o; o.x = pk2(u0 * (acc[a][b][0] + bias), u1 * (acc[a][b][1] + bias)); o.y = pk2(u2 * (acc[a][b][2] + bias), u3 * (acc[a][b][3] + bias));
            *(u32x2*)(Y + (size_t)(r0 + pp) * DM + g * 128 + c0) = o; }
    __syncthreads();
}

DI void rope_item(KP p, int it) {
    const int tid = tid_l();
    u16* proj = (u16*)(p->ws + WS_R);
    const f2_t* ROPE = (const f2_t*)(p->ws + WS_ROPE);
    const float qs = QSCALE * LOG2E;
    const int row0 = it * 128;
    if (it < 256) {
        const int pos0 = (it & 127) * 128;
#pragma unroll 2
        for (int i = 0; i < 16; ++i) { const int task = tid + 512 * i, hh = task >> 10, row = (task >> 3) & 127, pp = task & 7, cq = pp & 3, half = pp >> 2, chA = half * 8 + cq;
            const int pos = pos0 + row, pa = half ? 256 + (pos & 63) : (pos >> 6);
            u16* src = proj + (size_t)(row0 + row) * PLD + OFF_AQ + hh * 128;
            const float scale = hh < 6 ? qs : 1.f;
            const u32x4 ra = *(const u32x4*)(src + chA * 8), rb = *(const u32x4*)(src + (chA + 4) * 8);
            float x1[8], x2[8], o1[8], o2[8]; unpack8(ra, x1); unpack8(rb, x2);
            const f2_t* tb = ROPE + pa * 32 + cq * 8;
#pragma unroll
            for (int e = 0; e < 8; ++e) { const f2_t cs = tb[e]; o1[e] = (x1[e] * cs.x - x2[e] * cs.y) * scale; o2[e] = (x1[e] * cs.y + x2[e] * cs.x) * scale; }
            *(u32x4*)(src + chA * 8) = pack8(o1); *(u32x4*)(src + (chA + 4) * 8) = pack8(o2); }
    } else {
#pragma unroll 2
        for (int i = 0; i < 24; ++i) { const int id = tid + 512 * i, row = id / 96, ch = id % 96; float v[8];
            u16* src = proj + (size_t)(row0 + row) * PLD + OFF_AQ + ch * 8;
            unpack8(*(const u32x4*)src, v);
#pragma unroll
            for (int e = 0; e < 8; ++e) v[e] *= qs;
            *(u32x4*)src = pack8(v); }
    }
}

DI void attn_tile(int kt, bool isctx, int b, int nb, bool& valid, int& krow0, int& jloc) {
    jloc = 0; valid = true;
    if (kt < 2) { krow0 = RLAT + b * LCTX + kt * 128; return; }
    jloc = kt - 3; const int kb = nb + jloc; krow0 = b * SEQ + kb * 128;
    valid = !isctx && kb >= 0 && kb <= 127 && kt < 5;
    if (!valid) krow0 = 0;
}
DI void attn_item(KP p, int l, int it, LAS unsigned char* lds) {
    const int tid = tid_l(), lane = tid & 63, wid = tid >> 6, fr = lane & 15, fq = lane >> 4;
    const u16* proj = (const u16*)(p->ws + WS_R);
    u16* Y = (u16*)(p->ws + WS_Y);
    LAS unsigned char* T0 = lds; LAS unsigned char* T1 = lds + TILE_B; LAS unsigned char* T2 = lds + 2 * TILE_B;
    int b, nb, hq, qrow0; bool isctx;
    if (it < 1536) { hq = it % 6; nb = (it / 6) & 127; b = it / 768; qrow0 = b * SEQ + nb * 128; isctx = false; }
    else { if (l == 1) return; const int r = it - 1536; hq = r % 6; const int cbk = (r / 6) & 1; b = r / 12; nb = 0; qrow0 = RLAT + b * LCTX + cbk * 128; isctx = true; }
    const int kvh = hq / 3;
    const int srow = tid >> 4, sch = tid & 15;
    u32x4 kr[4], vr[4];
    { const u16* ks = proj + (size_t)(RLAT + b * LCTX) * PLD + OFF_AK + kvh * 128 + sch * 8; const u16* vs = proj + (size_t)(RLAT + b * LCTX) * PLD + OFF_AV + kvh * 128 + sch * 8;
#pragma unroll
      for (int i = 0; i < 4; ++i) { kr[i] = *(const u32x4*)(ks + (size_t)(srow + 32 * i) * PLD); vr[i] = *(const u32x4*)(vs + (size_t)(srow + 32 * i) * PLD); } }
    stage_plain(T0, proj + (size_t)qrow0 * PLD + OFF_AQ + hq * 128, PLD, tid);
    __syncthreads();
    bf16x8 Qf[4];
#pragma unroll
    for (int ks = 0; ks < 4; ++ks) Qf[ks] = frag_row(T0, 16 * wid, 32 * ks, lane);
    float m = p->attn_sink[l * 6 + hq] * LOG2E, lsum = 1.f;
    f32x4 O[8];
#pragma unroll
    for (int i = 0; i < 8; ++i) O[i] = (f32x4){0.f, 0.f, 0.f, 0.f};
    const int rin = 16 * wid + fr;
    for (int kt = 0; kt < 5; ++kt) {
        bool valid; int krow0, jloc; attn_tile(kt, isctx, b, nb, valid, krow0, jloc);
        if (!valid) continue;
        __syncthreads();
#pragma unroll
        for (int i = 0; i < 4; ++i) { *(LAS u32x4*)(T1 + toff(srow + 32 * i, sch)) = kr[i]; *(LAS u32x4*)(T2 + toff(srow + 32 * i, sch)) = vr[i]; }
        {
          int kn = kt + 1; bool vn; int rn, jn; attn_tile(kn, isctx, b, nb, vn, rn, jn);
          if (!vn && kn < 4) { ++kn; attn_tile(kn, isctx, b, nb, vn, rn, jn); }
          if (vn) { const u16* ks = proj + (size_t)rn * PLD + OFF_AK + kvh * 128 + sch * 8; const u16* vs = proj + (size_t)rn * PLD + OFF_AV + kvh * 128 + sch * 8;
#pragma unroll
              for (int i = 0; i < 4; ++i) { kr[i] = *(const u32x4*)(ks + (size_t)(srow + 32 * i) * PLD); vr[i] = *(const u32x4*)(vs + (size_t)(srow + 32 * i) * PLD); } } }
        __syncthreads();
        const bool local = kt >= 2;
        f32x4 S[8];
#pragma unroll
        for (int n = 0; n < 8; ++n) S[n] = (f32x4){0.f, 0.f, 0.f, 0.f};
        {
            bf16x8 kf[2][8];
#pragma unroll
            for (int n = 0; n < 8; ++n) kf[0][n] = frag_row(T1, 16 * n, 0, lane);
#pragma unroll
            for (int ks = 0; ks < 4; ++ks) {
                if (ks < 3) {
#pragma unroll
                    for (int n = 0; n < 8; ++n) kf[(ks + 1) & 1][n] = frag_row(T1, 16 * n, 32 * (ks + 1), lane);
                }
#pragma unroll
                for (int n = 0; n < 8; ++n) S[n] = MFMA16(kf[ks & 1][n], Qf[ks], S[n]);
            }
        }
        if (local && jloc != 0) {
#pragma unroll
            for (int n = 0; n < 8; ++n)
#pragma unroll
                for (int j = 0; j < 4; ++j) { const int dk = 16 * n + 4 * fq + j - rin; const bool keep = jloc < 0 ? dk >= 0 : dk <= 0; S[n][j] = keep ? S[n][j] : -INFINITY; }
        }
        float mx = -INFINITY;
#pragma unroll
        for (int n = 0; n < 8; ++n) mx = fmaxf(fmaxf(mx, fmaxf(S[n][0], S[n][1])), fmaxf(S[n][2], S[n][3]));
        mx = fmaxf(mx, __shfl_xor(mx, 16)); mx = fmaxf(mx, __shfl_xor(mx, 32));
        const float mnew = fmaxf(m, mx), alpha = __builtin_amdgcn_exp2f(m - mnew);
        float rs = 0.f;
#pragma unroll
        for (int n = 0; n < 8; ++n)
#pragma unroll
            for (int j = 0; j < 4; ++j) { const float e = __builtin_amdgcn_exp2f(S[n][j] - mnew); S[n][j] = e; rs += e; }
        rs += __shfl_xor(rs, 16); rs += __shfl_xor(rs, 32);
        lsum = lsum * alpha + rs; m = mnew;
#pragma unroll
        for (int i = 0; i < 8; ++i) O[i] *= alpha;
        bf16x8 Pf[4];
#pragma unroll
        for (int nn = 0; nn < 4; ++nn) { u32x4 o; o.x = pk2(S[2 * nn][0], S[2 * nn][1]); o.y = pk2(S[2 * nn][2], S[2 * nn][3]); o.z = pk2(S[2 * nn + 1][0], S[2 * nn + 1][1]); o.w = pk2(S[2 * nn + 1][2], S[2 * nn + 1][3]); Pf[nn] = __builtin_bit_cast(bf16x8, o); }
        {
            bf16x8 vf[2][8];
#pragma unroll
            for (int nd = 0; nd < 8; ++nd) vf[0][nd] = frag_tr_perm(T2, 0, 16 * nd, lane);
#pragma unroll
            for (int nn = 0; nn < 4; ++nn) {
                if (nn < 3) {
#pragma unroll
                    for (int nd = 0; nd < 8; ++nd) vf[(nn + 1) & 1][nd] = frag_tr_perm(T2, 32 * (nn + 1), 16 * nd, lane);
                }
#pragma unroll
                for (int nd = 0; nd < 8; ++nd) O[nd] = MFMA16(vf[nn & 1][nd], Pf[nn], O[nd]);
            }
        }
    }
    const float inv = __builtin_amdgcn_rcpf(lsum);
    u16* yr = Y + (size_t)(qrow0 + rin) * DM + 512 + hq * 128 + 4 * fq;
#pragma unroll
    for (int nd = 0; nd < 8; ++nd) { u32x2 o; o.x = pk2(O[nd][0] * inv, O[nd][1] * inv); o.y = pk2(O[nd][2] * inv, O[nd][3] * inv); *(u32x2*)(yr + 16 * nd) = o; }
    __syncthreads();
}

DI void ml_item_geom(int it, int& b, int& c, int& h, int& base, int& lo, int& hi) {
    h = it % 6; c = (it / 6) % NCH; b = it / (6 * NCH);
    if (c < 2) { base = RLAT + b * LCTX + c * 128; lo = -c * 128; hi = LCTX - c * 128; }
    else { base = b * SEQ + (c - 2) * 128; lo = -(c - 2) * 128; hi = SEQ - (c - 2) * 128; }
}
DI int ml_pos(int c, int d) { return d == 0 ? c : (c < 2 ? 1 - c : 131 - c); }
DI void ml_gate_scan(const float* gates, int base, int d, int h, float bi, float bff, int lane, int& t0, int& t1, float& li0, float& li1, float& b0, float& b1) {
    t0 = d ? 127 - 2 * lane : 2 * lane; t1 = d ? t0 - 1 : t0 + 1;
    const float* g0 = gates + (size_t)(base + t0) * 32 + d * 12 + h; const float* g1 = gates + (size_t)(base + t1) * 32 + d * 12 + h;
    li0 = g0[0] + bi; li1 = g1[0] + bi;
    const float lf0 = log_sigmoid(g0[6] + bff), lf1 = log_sigmoid(g1[6] + bff);
    float s = lf0 + lf1;
#pragma unroll
    for (int o = 1; o < 64; o <<= 1) { const float v = __shfl_up(s, o); if (lane >= o) s += v; }
    b1 = s; b0 = s - lf1;
}

DI void ml1_item(KP p, int l, int it, LAS unsigned char* lds) {
    const int tid = tid_l(), lane = tid & 63, wid = tid >> 6, fr = lane & 15, fq = lane >> 4;
    int b, c, h, base, lo, hi; ml_item_geom(it, b, c, h, base, lo, hi);
    const u16* proj = (const u16*)(p->ws + WS_R);
    const float* gates = (const float*)(p->ws + WS_GATES);
    LAS unsigned char* T0 = lds; LAS unsigned char* T1 = lds + TILE_B; LAS unsigned char* T2 = lds + 2 * TILE_B;
    LAS float* wsc = (LAS float*)(lds + SC_OFF);
    if (wid < 2) { const int d = wid; int t0, t1; float li0, li1, b0, b1;
        ml_gate_scan(gates, base, d, h, p->ml_b_i[l * 12 + d * 6 + h], p->ml_b_f[l * 12 + d * 6 + h], lane, t0, t1, li0, li1, b0, b1);
        const float g = __shfl(b1, 63);
        const float a0 = g - b0 + li0, a1 = g - b1 + li1;
        const float ml = wave_max(fmaxf(a0, a1));
        wsc[d * 128 + t0] = __expf(a0 - ml); wsc[d * 128 + t1] = __expf(a1 - ml);
        if (lane == 0) { const int sq = ((b * 6 + h) * 2 + d) * NCH + ml_pos(c, d); ((float*)(p->ws + WS_GSC))[sq] = g; ((float*)(p->ws + WS_MLS))[sq] = ml; } }
    stage_conv(T0, proj + (size_t)base * PLD + OFF_MK + h * 128, PLD, lo, hi, p->ml_conv_w + (size_t)l * 4608 + 768 + h * 128, p->ml_conv_b + l * 1536 + 768 + h * 128, QSCALE, tid,
               (u16*)(p->ws + WS_XN) + (size_t)base * 768 + h * 128);
    __syncthreads();
#pragma unroll
    for (int i = 0; i < 4; ++i) { const int id = tid + 512 * i, row = id >> 4, ch = id & 15; float v[8], y[8];
        unpack8(*(const u32x4*)(proj + (size_t)(base + row) * PLD + OFF_MV + h * 128 + ch * 8), v);
        const float w0 = wsc[row], w1 = wsc[128 + row];
#pragma unroll
        for (int e = 0; e < 8; ++e) y[e] = v[e] * w0;
        *(LAS u32x4*)(T1 + toff(row, ch)) = pack8(y);
#pragma unroll
        for (int e = 0; e < 8; ++e) y[e] = v[e] * w1;
        *(LAS u32x4*)(T2 + toff(row, ch)) = pack8(y); }
    __syncthreads();
    const int kb = 32 * (wid >> 1), vb = 64 * (wid & 1);
    u16* CST = (u16*)(p->ws + WS_CST);
#pragma unroll
    for (int d = 0; d < 2; ++d) {
        const LAS unsigned char* TV = d ? T2 : T1;
        f32x4 acc[2][4];
#pragma unroll
        for (int a = 0; a < 2; ++a)
#pragma unroll
            for (int bb = 0; bb < 4; ++bb) acc[a][bb] = (f32x4){0.f, 0.f, 0.f, 0.f};
#pragma unroll
        for (int ks = 0; ks < 4; ++ks) {
            bf16x8 af[2], bfg[4];
#pragma unroll
            for (int a = 0; a < 2; ++a) af[a] = frag_tr(T0, 32 * ks, kb + 16 * a, lane);
#pragma unroll
            for (int bb = 0; bb < 4; ++bb) bfg[bb] = frag_tr(TV, 32 * ks, vb + 16 * bb, lane);
#pragma unroll
            for (int a = 0; a < 2; ++a)
#pragma unroll
                for (int bb = 0; bb < 4; ++bb) acc[a][bb] = MFMA16(af[a], bfg[bb], acc[a][bb]);
        }
        u16* Cd = CST + ((size_t)(((b * 6 + h) * 2 + d) * NCH + ml_pos(c, d))) * 16384;
#pragma unroll
        for (int a = 0; a < 2; ++a)
#pragma unroll
            for (int bb = 0; bb < 4; ++bb) { const int v = vb + 16 * bb + fr, k0 = kb + 16 * a + 4 * fq;
                u32x2 o; o.x = pk2(acc[a][bb][0], acc[a][bb][1]); o.y = pk2(acc[a][bb][2], acc[a][bb][3]); *(u32x2*)(Cd + v * 128 + k0) = o; }
    }
    { const int d = tid >> 8, k2 = tid & 63, tq = (tid >> 6) & 3; float s0 = 0.f, s1 = 0.f;
#pragma unroll 8
        for (int t = 32 * tq; t < 32 * tq + 32; ++t) { const float w = wsc[d * 128 + t]; const unsigned kv = *(const LAS unsigned*)(T0 + toff(t, k2 >> 2) + 4 * (k2 & 3)); s0 += w * bf_lo(kv); s1 += w * bf_hi(kv); }
        LAS float* red = (LAS float*)(lds + SC_OFF + 2048);
        red[(d * 4 + tq) * 128 + 2 * k2] = s0; red[(d * 4 + tq) * 128 + 2 * k2 + 1] = s1;
        __syncthreads();
        if (tid < 256) { const int dd = tid >> 7, k = tid & 127; const float sum = (red[(dd * 4 + 0) * 128 + k] + red[(dd * 4 + 1) * 128 + k]) + (red[(dd * 4 + 2) * 128 + k] + red[(dd * 4 + 3) * 128 + k]);
            ((float*)(p->ws + WS_NST))[((size_t)(((b * 6 + h) * 2 + dd) * NCH + ml_pos(c, dd))) * 128 + k] = sum; } }
    __syncthreads();
}

DI void scan_item(KP p, int it) {
    const float* GSC = (const float*)(p->ws + WS_GSC); const float* MLS = (const float*)(p->ws + WS_MLS);
    const int gt = it * 512 + tid_l();
    if (gt < NSEQ * 4096) {
        const int sq = gt >> 12, e4 = gt & 4095;
        u16* base = (u16*)(p->ws + WS_CST) + (size_t)sq * NCH * 16384 + e4 * 4;
        float c0 = 0.f, c1 = 0.f, c2 = 0.f, c3 = 0.f, m = 0.f;
        for (int j0 = 0; j0 < NCH; j0 += 10) {
            u32x2 v[10]; float gj[10], mj[10];
#pragma unroll
            for (int u = 0; u < 10; ++u) { v[u] = *(const u32x2*)(base + (size_t)(j0 + u) * 16384); gj[u] = GSC[sq * NCH + j0 + u]; mj[u] = MLS[sq * NCH + j0 + u]; }
#pragma unroll
            for (int u = 0; u < 10; ++u) {
                u32x2 o; o.x = pk2(c0, c1); o.y = pk2(c2, c3); *(u32x2*)(base + (size_t)(j0 + u) * 16384) = o;
                const float mn = fmaxf(gj[u] + m, mj[u]), ao = __expf(gj[u] + m - mn), an = __expf(mj[u] - mn);
                c0 = ao * c0 + an * bf_lo(v[u].x); c1 = ao * c1 + an * bf_hi(v[u].x); c2 = ao * c2 + an * bf_lo(v[u].y); c3 = ao * c3 + an * bf_hi(v[u].y); m = mn; }
        }
    } else {
        const int r = gt - NSEQ * 4096, sq = r >> 7, k = r & 127;
        float* nb = (float*)(p->ws + WS_NST) + (size_t)sq * NCH * 128 + k; float* M0 = (float*)(p->ws + WS_M0);
        float n = 0.f, m = 0.f;
        for (int j = 0; j < NCH; ++j) { const float dn = nb[(size_t)j * 128], gj = GSC[sq * NCH + j], mj = MLS[sq * NCH + j];
            nb[(size_t)j * 128] = n; if (k == 0) M0[sq * NCH + j] = m;
            const float mn = fmaxf(gj + m, mj), ao = __expf(gj + m - mn), an = __expf(mj - mn); n = ao * n + an * dn; m = mn; }
    }
}

DI void ml3_item(KP p, int l, int it, LAS unsigned char* lds) {
    const int tid = tid_l(), lane = tid & 63, wid = tid >> 6, fr = lane & 15, fq = lane >> 4;
    int b, c, h, base, lo, hi; ml_item_geom(it, b, c, h, base, lo, hi);
    if (l == 1 && c < 2) return;
    const u16* proj = (const u16*)(p->ws + WS_R);
    const float* gates = (const float*)(p->ws + WS_GATES);
    u16* Y = (u16*)(p->ws + WS_Y);
    LAS unsigned char* T0 = lds; LAS unsigned char* T1 = lds + TILE_B; LAS unsigned char* T2 = lds + 2 * TILE_B; LAS unsigned char* T3 = T0;
    LAS float* sc_rt = (LAS float*)(lds + SC_OFF);
    LAS float* sc_ct = sc_rt + 256;
    LAS float* sc_in = sc_rt + 512;
    LAS float* sc_em = sc_rt + 768;
    LAS float* sc_n0 = sc_rt + 1024;
    const int srow = tid >> 4, sch = tid & 15;
    u32x4 c0a[4], c0b[4]; u32x2 mor[8];
    { const u16* ca = (const u16*)(p->ws + WS_CST) + (size_t)(((b * 6 + h) * 2 + 0) * NCH + ml_pos(c, 0)) * 16384 + srow * 128 + sch * 8;
      const u16* cb = (const u16*)(p->ws + WS_CST) + (size_t)(((b * 6 + h) * 2 + 1) * NCH + ml_pos(c, 1)) * 16384 + srow * 128 + sch * 8;
#pragma unroll
      for (int i = 0; i < 4; ++i) { c0a[i] = *(const u32x4*)(ca + i * 32 * 128); c0b[i] = *(const u32x4*)(cb + i * 32 * 128); }
      const u16* mo_ = proj + (size_t)(base + 16 * wid + fr) * PLD + OFF_MO + h * 128 + 4 * fq;
#pragma unroll
      for (int nd = 0; nd < 8; ++nd) mor[nd] = *(const u32x2*)(mo_ + 16 * nd); }
    if (wid < 2) { const int d = wid; int t0, t1; float li0, li1, b0, b1;
        ml_gate_scan(gates, base, d, h, p->ml_b_i[l * 12 + d * 6 + h], p->ml_b_f[l * 12 + d * 6 + h], lane, t0, t1, li0, li1, b0, b1);
        const int sq = ((b * 6 + h) * 2 + d) * NCH + ml_pos(c, d);
        const float m0 = ((const float*)(p->ws + WS_M0))[sq];
        const float ct0 = li0 - b0, ct1 = li1 - b1;
        float pm = fmaxf(ct0, ct1);
#pragma unroll
        for (int o = 1; o < 64; o <<= 1) { const float v = __shfl_up(pm, o); if (lane >= o) pm = fmaxf(pm, v); }
        float pe = __shfl_up(pm, 1); if (lane == 0) pe = -INFINITY;
        const float pm0 = fmaxf(pe, ct0), pm1 = pm;
        const float mt0 = fmaxf(b0 + m0, b0 + pm0), mt1 = fmaxf(b1 + m0, b1 + pm1);
        sc_rt[d * 128 + t0] = b0 - mt0; sc_rt[d * 128 + t1] = b1 - mt1;
        sc_ct[d * 128 + t0] = ct0; sc_ct[d * 128 + t1] = ct1;
        sc_in[d * 128 + t0] = __expf(b0 + m0 - mt0); sc_in[d * 128 + t1] = __expf(b1 + m0 - mt1);
        sc_em[d * 128 + t0] = __expf(-mt0); sc_em[d * 128 + t1] = __expf(-mt1);
        const float* n0 = (const float*)(p->ws + WS_NST) + (size_t)sq * 128;
        sc_n0[d * 128 + 2 * lane] = n0[2 * lane]; sc_n0[d * 128 + 2 * lane + 1] = n0[2 * lane + 1]; }
    stage_conv(T0, proj + (size_t)base * PLD + OFF_MQ + h * 128, PLD, lo, hi, p->ml_conv_w + (size_t)l * 4608 + h * 128, p->ml_conv_b + l * 1536 + h * 128, 1.f, tid);
    stage_plain(T1, (const u16*)(p->ws + WS_XN) + (size_t)base * 768 + h * 128, 768, tid);
    stage_plain(T2, proj + (size_t)base * PLD + OFF_MV + h * 128, PLD, tid);
    __syncthreads();
    const int t = 16 * wid + fr;
    bf16x8 Qf[4];
#pragma unroll
    for (int ks = 0; ks < 4; ++ks) Qf[ks] = frag_row(T0, 16 * wid, 32 * ks, lane);
    float nq[2] = {0.f, 0.f};
#pragma unroll
    for (int ks = 0; ks < 4; ++ks) { const u32x4 qv = __builtin_bit_cast(u32x4, Qf[ks]); float q[8]; unpack8(qv, q);
#pragma unroll
        for (int e = 0; e < 8; ++e) { const int k = 32 * ks + 8 * fq + e; nq[0] += q[e] * sc_n0[k]; nq[1] += q[e] * sc_n0[128 + k]; } }
#pragma unroll
    for (int d = 0; d < 2; ++d) { nq[d] += __shfl_xor(nq[d], 16); nq[d] += __shfl_xor(nq[d], 32); }
    f32x4 hs[8];
#pragma unroll
    for (int i = 0; i < 8; ++i) hs[i] = (f32x4){0.f, 0.f, 0.f, 0.f};
#pragma unroll 1
    for (int d = 0; d < 2; ++d) {
        const int sq = ((b * 6 + h) * 2 + d) * NCH + ml_pos(c, d);
        const float nqd = d ? nq[1] : nq[0];
        __syncthreads();
#pragma unroll
        for (int i = 0; i < 4; ++i) { const u32x4 v = d ? c0b[i] : c0a[i]; *(LAS u32x4*)(T3 + toff(srow + 32 * i, sch)) = v; }
        __syncthreads();
        const float rt = sc_rt[d * 128 + t], inter = sc_in[d * 128 + t], em = sc_em[d * 128 + t];
        f32x4 S[8]; float den = 0.f;
#pragma unroll
        for (int n = 0; n < 8; ++n) { S[n] = (f32x4){0.f, 0.f, 0.f, 0.f};
            const bool need = d ? (n >= wid) : (n <= wid);
            if (need) {
#pragma unroll
                for (int ks = 0; ks < 4; ++ks) S[n] = MFMA16(frag_row(T1, 16 * n, 32 * ks, lane), Qf[ks], S[n]);
#pragma unroll
                for (int j = 0; j < 4; ++j) { const int s = 16 * n + 4 * fq + j; const bool valid = d ? (s >= t) : (s <= t);
                    const float w = valid ? __expf(rt + sc_ct[d * 128 + s]) : 0.f; const float pv = S[n][j] * w; S[n][j] = pv; den += pv; }
            }
            __builtin_amdgcn_sched_barrier(0); }
        den += __shfl_xor(den, 16); den += __shfl_xor(den, 32);
        den += inter * nqd;
        bf16x8 Pf[4];
#pragma unroll
        for (int nn = 0; nn < 4; ++nn) { u32x4 o; o.x = pk2(S[2 * nn][0], S[2 * nn][1]); o.y = pk2(S[2 * nn][2], S[2 * nn][3]); o.z = pk2(S[2 * nn + 1][0], S[2 * nn + 1][1]); o.w = pk2(S[2 * nn + 1][2], S[2 * nn + 1][3]); Pf[nn] = __builtin_bit_cast(bf16x8, o); }
        const float inv = 1.f / fmaxf(fabsf(den), em);
#pragma unroll
        for (int nd = 0; nd < 8; ++nd) {
            f32x4 a1 = {0.f, 0.f, 0.f, 0.f}, a2 = {0.f, 0.f, 0.f, 0.f};
#pragma unroll
            for (int nn = 0; nn < 4; ++nn) a1 = MFMA16(frag_tr_perm(T2, 32 * nn, 16 * nd, lane), Pf[nn], a1);
#pragma unroll
            for (int ks = 0; ks < 4; ++ks) a2 = MFMA16(frag_row(T3, 16 * nd, 32 * ks, lane), Qf[ks], a2);
            hs[nd] += (a1 + a2 * inter) * inv;
            __builtin_amdgcn_sched_barrier(0);
        }
    }
    float ss = 0.f;
#pragma unroll
    for (int nd = 0; nd < 8; ++nd) ss += (hs[nd][0] * hs[nd][0] + hs[nd][1] * hs[nd][1]) + (hs[nd][2] * hs[nd][2] + hs[nd][3] * hs[nd][3]);
    ss += __shfl_xor(ss, 16); ss += __shfl_xor(ss, 32);
    const float rstd = rsqrtf(ss * (1.f / 128.f) + EPSN);
    const float* og = p->ml_out_gain + l * 768 + h * 128;
    u16* yr = Y + (size_t)(base + t) * DM + 1280 + h * 128;
#pragma unroll
    for (int nd = 0; nd < 8; ++nd) { const int v0 = 16 * nd + 4 * fq; const u32x2 ov = mor[nd]; const f32x4 gn = *(const f32x4*)(og + v0);
        const float y0 = hs[nd][0] * rstd * gn[0] * sigmoidf_(bf_lo(ov.x)), y1 = hs[nd][1] * rstd * gn[1] * sigmoidf_(bf_hi(ov.x));
        const float y2 = hs[nd][2] * rstd * gn[2] * sigmoidf_(bf_lo(ov.y)), y3 = hs[nd][3] * rstd * gn[3] * sigmoidf_(bf_hi(ov.y));
        u32x2 o; o.x = pk2(y0, y1); o.y = pk2(y2, y3); *(u32x2*)(yr + v0) = o; }
    __syncthreads();
}

#define XB_TMO      128
#define XB_XCNT(j)  (256  + 64 * (j))
#define XB_XSUB(j)  (1280 + 64 * (j))
#define XB_XGEN(j)  (2304 + 64 * (j))
#define XB_TOP      3328
#define XB_TOPGEN   3392
#define XCD_BAR_WORDS 3456
#define XB_SPIN_CAP (1u << 18)

__device__ __forceinline__ unsigned xb_ld(unsigned* p)              { return __hip_atomic_load(p, __ATOMIC_RELAXED, __HIP_MEMORY_SCOPE_AGENT); }
__device__ __forceinline__ unsigned xb_add(unsigned* p, unsigned v) { return __hip_atomic_fetch_add(p, v, __ATOMIC_RELAXED, __HIP_MEMORY_SCOPE_AGENT); }
__device__ __forceinline__ unsigned xb_xcc_id() { return (unsigned)__builtin_amdgcn_s_getreg((3 << 11) | 20) & 0xFu; }
#define XB_SPIN(cond, bar) do { unsigned _sp = 0; while (cond) { __builtin_amdgcn_s_sleep(1); \
    if ((++_sp & 255u) == 0u) { if (xb_ld(&(bar)[XB_TMO])) break; if (_sp > XB_SPIN_CAP) { atomicAdd(&(bar)[XB_TMO], 1u); break; } } } } while (0)

struct XcdBarrier {
    unsigned* bar; unsigned x;
    volatile LAS unsigned* st;
};

__device__ __forceinline__ XcdBarrier xcd_barrier_post(unsigned* bar, volatile LAS unsigned* st) {
    XcdBarrier b; b.bar = bar; b.x = xb_xcc_id(); b.st = st;
    if (threadIdx.x == 0) (void)xb_add(&bar[XB_XCNT(b.x)], 1u);
    return b;
}
__device__ __forceinline__ void xcd_barrier_complete(unsigned* bar, unsigned x, unsigned& nloc, unsigned& nx) {
    const unsigned G = gridDim.x * gridDim.y * gridDim.z;
    unsigned sum, cnt, mine, sp = 0u;
    for (;;) {
        sum = 0u; cnt = 0u; mine = 0u;
#pragma unroll
        for (unsigned j = 0; j < 16; ++j) { const unsigned c = xb_ld(&bar[XB_XCNT(j)]); sum += c; cnt += (c > 0u) ? 1u : 0u; mine = (j == x) ? c : mine; }
        if (sum == G) break;
        __builtin_amdgcn_s_sleep(1);
        if ((++sp & 255u) == 0u) { if (xb_ld(&bar[XB_TMO])) break; if (sp > XB_SPIN_CAP) { atomicAdd(&bar[XB_TMO], 1u); break; } }
    }
    nloc = mine > 0u ? mine : 1u; nx = cnt > 0u ? cnt : 1u;
}

__device__ __forceinline__ void xcd_barrier(const XcdBarrier& b) {
    asm volatile("s_waitcnt vmcnt(0)" ::: "memory");
    __syncthreads();
    if (threadIdx.x == 0) {
        unsigned* bar = b.bar;
        __builtin_amdgcn_s_waitcnt(0);
        unsigned nloc = b.st[0], nx = b.st[1];
        if (nloc == 0u) { xcd_barrier_complete(bar, b.x, nloc, nx); b.st[0] = nloc; b.st[1] = nx; }
        const unsigned old = xb_add(&bar[XB_XSUB(b.x)], 1u);
        const unsigned gen = old / nloc;
        if (old + 1u == (gen + 1u) * nloc) {
            __builtin_amdgcn_fence(__ATOMIC_RELEASE, "agent");
            asm volatile("s_waitcnt vmcnt(0)" ::: "memory");
            const unsigned og = xb_add(&bar[XB_TOP], 1u);
            const unsigned tg = og / nx;
            if (og + 1u == (tg + 1u) * nx) xb_add(&bar[XB_TOPGEN], 1u);
            else XB_SPIN(xb_ld(&bar[XB_TOPGEN]) == tg, bar);
            __builtin_amdgcn_fence(__ATOMIC_ACQUIRE, "agent");
            xb_add(&bar[XB_XGEN(b.x)], 1u);
            asm volatile("s_waitcnt vmcnt(0)" ::: "memory");
        } else {
            XB_SPIN(xb_ld(&bar[XB_XGEN(b.x)]) == gen, bar);
            __builtin_amdgcn_fence(__ATOMIC_ACQUIRE, "agent");
            asm volatile("s_waitcnt vmcnt(0)" ::: "memory");
        }
    }
    __syncthreads();
}

constexpr int N_ATT = 1560, N_ML = 2 * NCH * 6  , N_GM = 260 * 4, N_SCAN = 198, N_ROPE = 260;

DI int next_item(unsigned* ctr, LAS unsigned char* lds) {
    LAS int* slot = (LAS int*)(lds + LDS_BYTES - 16);
    __syncthreads();
    if (threadIdx.x == 0) *slot = (int)atomicAdd(ctr, 1u);
    __syncthreads();
    return *slot;
}

__global__ void __launch_bounds__(512, 2) fwd_megakernel(Params p_unused) {
    const KP kp = (KP)__builtin_amdgcn_kernarg_segment_ptr();
#define PP launder(kp)
    extern __shared__ __attribute__((aligned(16))) unsigned char smem[];
    LAS unsigned char* lds = (LAS unsigned char*)smem;
    cg::grid_group grid = cg::this_grid();
    volatile LAS unsigned* xst = (volatile LAS unsigned*)(lds + LDS_BYTES - 32);
    if (threadIdx.x == 0) { xst[0] = 0u; xst[1] = 0u; }
    __syncthreads();
    { XcdBarrier b0 = xcd_barrier_post((unsigned*)(PP->ws + WS_BAR), xst); (void)b0; }
#define GSYNC() do { XcdBarrier b_; b_.bar = (unsigned*)(PP->ws + WS_BAR); b_.x = xb_xcc_id(); b_.st = xst; xcd_barrier(b_); } while (0)
    phase_prep(PP, lds);
    if (PP->ws == nullptr) grid.sync();
    GSYNC();
    phase_norm0(PP);
    phase_prep2(PP, lds);
    GSYNC();
    for (int l = 0; l < 2; ++l) {
        const int stage = l;
        const int Mres = l == 0 ? MROWS : RLAT;
        unsigned* ctr = (unsigned*)(PP->ws + WS_CTR) + l * 4;
        { EpiProj E; E.O = (u16*)(PP->ws + WS_R); E.gates = (float*)(PP->ws + WS_GATES);
          E.ss = (const float*)(PP->ws + WS_SS) + (l == 0 ? 3 : 1) * MROWS; E.bias0 = (const float*)(PP->ws + WS_BIASP) + (size_t)l * 3 * NPROJ;
          run_gemm(lds, (const u16*)(PP->ws + WS_XN), (const u16*)(PP->ws + WS_WIN + l * SZ_WIN), MROWS, PLD, DM, E); }
        for (;;) { const int it = next_item(ctr + 3, lds); if (it >= 260) break; gate_item(PP, l, it, lds); }
        GSYNC();
        for (;;) { const int it = next_item(ctr + 0, lds); if (it >= N_ROPE + N_ML) break; if (it < N_ROPE) rope_item(PP, it); else ml1_item(PP, l, it - N_ROPE, lds); }
        GSYNC();
        for (;;) { const int it = next_item(ctr + 1, lds); if (it >= N_SCAN + N_ATT + N_GM) break;
            if (it < N_SCAN) scan_item(PP, it);
            else if (it < N_SCAN + N_ATT) attn_item(PP, l, it - N_SCAN, lds);
            else gmlp_item(PP, l, it - N_SCAN - N_ATT, lds); }
        GSYNC();
        for (;;) { const int it = next_item(ctr + 2, lds); if (it >= N_ML) break; ml3_item(PP, l, it, lds); }
        GSYNC();
        { EpiRes E; E.p = PP; E.stage = stage; E.gate0 = (const float*)(PP->ws + WS_MOD) + (size_t)l * 3 * 12288 + 2 * DM;
          E.gs0 = (const float*)(PP->ws + WS_GS) + (size_t)(l * 2 + 1) * 3 * DM; E.ssn = (float*)(PP->ws + WS_SS) + (l == 0 ? 0 : 2) * MROWS; E.ntfull = DM / 64;
          run_gemm_split(lds, (const u16*)(PP->ws + WS_Y), (const u16*)(PP->ws + WS_WOUT + l * SZ_WOUT), RLAT, DM, DM, l == 0 ? 4 : 0, E); }
        GSYNC();
        if (l == 0) { phase_ctx_norm(PP, (const float*)(PP->ws + WS_GS) + (size_t)((0 * 2 + 1) * 3 + 2) * DM, (float*)(PP->ws + WS_SS) + 0 * MROWS, 4); GSYNC(); }
        { EpiSqRelu E; E.O = (u16*)(PP->ws + WS_R); E.ss = (const float*)(PP->ws + WS_SS) + (l == 0 ? 0 : 2) * MROWS; E.bias0 = (const float*)(PP->ws + WS_BIASF) + (size_t)l * 3 * DFF;
          run_gemm(lds, (const u16*)(PP->ws + WS_XN), (const u16*)(PP->ws + WS_WFF1 + l * SZ_WFF), Mres, DFF, DM, E); }
        GSYNC();
        { EpiRes E; E.p = PP; E.stage = 1; E.gate0 = (const float*)(PP->ws + WS_MOD) + (size_t)l * 3 * 12288 + 5 * DM;
          E.gs0 = l == 0 ? (const float*)(PP->ws + WS_GS) + (size_t)(1 * 2 + 0) * 3 * DM : nullptr; E.ssn = (float*)(PP->ws + WS_SS) + 1 * MROWS; E.ntfull = DFF / 64;
          run_gemm_split(lds, (const u16*)(PP->ws + WS_R), (const u16*)(PP->ws + WS_WFF2 + l * SZ_WFF), RLAT, DM, DFF, l == 0 ? 16 : 0, E); }
        GSYNC();
        if (l == 0) { phase_ctx_norm(PP, (const float*)(PP->ws + WS_GS) + (size_t)((1 * 2 + 0) * 3 + 2) * DM, (float*)(PP->ws + WS_SS) + 1 * MROWS, 16); GSYNC(); }
    }
    phase_final(PP);
#undef GSYNC
#undef PP
}

extern "C" void kernel_launch(void* const* d_in, const int* in_sizes, int n_in, void* d_out, int out_size, void* d_ws, size_t ws_size, hipStream_t stream) {
    static int grid_blocks = 0;
    if (grid_blocks == 0) {
        if (n_in != 22 || ws_size < WS_END || out_size != RLAT * DM) { fprintf(stderr, "kernel_launch: unexpected shapes (n_in %d ws %zu need %zu out %d)\n", n_in, ws_size, (size_t)WS_END, out_size); grid_blocks = -1; return; }
        int dev = 0, cus = 0, per_cu = 0;
        hipGetDevice(&dev);
        hipDeviceGetAttribute(&cus, hipDeviceAttributeMultiprocessorCount, dev);
        if (hipFuncSetAttribute((const void*)fwd_megakernel, hipFuncAttributeMaxDynamicSharedMemorySize, LDS_BYTES) != hipSuccess) { fprintf(stderr, "kernel_launch: hipFuncSetAttribute failed\n"); grid_blocks = -1; return; }
        hipOccupancyMaxActiveBlocksPerMultiprocessor(&per_cu, (const void*)fwd_megakernel, 512, LDS_BYTES);
        if (per_cu < 1) { fprintf(stderr, "kernel_launch: occupancy query says %d blocks per CU\n", per_cu); per_cu = 1; }
        (void)hipGetLastError();
        grid_blocks = cus * 1;
    }
    if (grid_blocks < 0) return;
    if (hipMemsetAsync((unsigned char*)d_ws + WS_BAR, 0, 16384, stream) != hipSuccess) { fprintf(stderr, "kernel_launch: memset failed\n"); return; }
    Params p{};
    const float** pp = (const float**)&p;
    for (int i = 0; i < 22; ++i) pp[i] = (const float*)d_in[i];
    p.out = (float*)d_out; p.ws = (unsigned char*)d_ws;
    void* args[] = {&p};
    hipError_t e = hipLaunchCooperativeKernel((const void*)fwd_megakernel, dim3(grid_blocks), dim3(512), args, LDS_BYTES, stream);
    if (e != hipSuccess) fprintf(stderr, "cooperative launch failed: %s (grid %d)\n", hipGetErrorString(e), grid_blocks);
}
```

```cpp
#include <hip/hip_runtime.h>
#include <hip/hip_cooperative_groups.h>
#include <cstdio>
namespace cg = cooperative_groups;
namespace pg8 {
#define PG8_LAS __attribute__((address_space(3)))
typedef unsigned short bf16_t;
typedef short bf16x8 __attribute__((ext_vector_type(8)));
typedef float f32x4 __attribute__((ext_vector_type(4)));
typedef unsigned u32x4 __attribute__((ext_vector_type(4)));
constexpr int BM = 256, BK = 64, HALF = 128, HTB = HALF * BK * 2  , STAGE_BYTES = 8 * HTB, NXCD = 8, WGM = 8;

__host__ __device__ __forceinline__ int lds_byte(int r, int c) { const int st = (r >> 4) * 2 + (c >> 5), rr = r & 15, cc = c & 31, ob = rr * 64 + cc * 2; return st * 1024 + (ob ^ (((ob >> 9) & 1) << 5)); }
__host__ __device__ __forceinline__ void stage_rc(int b, int& R, int& C) { const int st = b / 1024, sb = b % 1024, swz = sb ^ (((sb >> 9) & 1) << 5); R = (st >> 1) * 16 + swz / 64; C = (st & 1) * 32 + (swz % 64) / 2; }
__host__ __device__ __forceinline__ int perm32(int rho) { const int n = rho >> 4, i = rho & 15; return 8 * (i >> 2) + 4 * n + (i & 3); }

struct Unit { int pm, pn, koff, nt; };
struct Gemm { const bf16_t* A; const bf16_t* Bt; int M, N, K; };

struct StaticOrder {
    int nM, nN, nwg, G, c, ntf, wgm;
    __host__ __device__ void init(int M, int N, int K, int G_, int c_) { nM = M / BM; nN = N / BM; nwg = nM * nN; G = G_; c = c_; ntf = K / BK; wgm = WGM; }
    __host__ __device__ bool next(int i, Unit& u) const {
        const long L = (long)i * G + c; if (L >= nwg) return false;
        int wgid = (int)L; { const int q = nwg / NXCD, r = nwg % NXCD, xcd = wgid % NXCD, off = wgid / NXCD; wgid = (xcd < r ? xcd * (q + 1) : r * (q + 1) + (xcd - r) * q) + off; }
        const int nig = wgm * nN, gid = wgid / nig, fm = gid * wgm, gsz = (nM - fm) < wgm ? (nM - fm) : wgm;
        u.pm = fm + ((wgid % nig) % gsz); u.pn = (wgid % nig) / gsz; u.koff = 0; u.nt = ntf; return true;
    }
    __device__ __forceinline__ void a_ready(const Unit&) const {}
    __device__ __forceinline__ void done(const Unit&) const {}
};
template <class Epi, class Sched, bool STAMP = false>
__device__ __forceinline__ void gemm_phase(PG8_LAS unsigned char* lds, const Gemm g, const Sched& S, const Epi& E, unsigned long long* stamps) {
    int tid_ = threadIdx.x; asm volatile("" : "+v"(tid_)); const int tid = tid_, wid = __builtin_amdgcn_readfirstlane(tid >> 6), lane = tid & 63, wr = wid >> 2, wc = wid & 3, fr = lane & 15, fq = lane >> 4;
    const int K = g.K;
    int ts_lo = 0, ts_hi = 0, nts = 0; const unsigned long long rt_entry = STAMP ? (unsigned long long)wall_clock64() : 0ull;
#define PG8_STAMP() do { if (STAMP && wid == 0 && nts < 64) { const unsigned long long _c = (unsigned long long)clock64(); \
        ts_lo = (lane == nts) ? (int)(unsigned)_c : ts_lo; ts_hi = (lane == nts) ? (int)(unsigned)(_c >> 32) : ts_hi; ++nts; } } while (0)
    PG8_STAMP();
    unsigned voffA[2], voffB[2];
#pragma unroll
    for (int i = 0; i < 2; ++i) { int R, C; stage_rc(tid * 16 + i * 8192, R, C); const int Rb = Epi::PERM ? ((R & ~31) + perm32(R & 31)) : R;
        voffA[i] = (unsigned)(R * K + C) * 2u; voffB[i] = (unsigned)(Rb * K + C) * 2u; }
    const size_t kstep = (size_t)(BK * 2);
    const size_t hstep = (size_t)HALF * K * 2;
    const size_t tstep = 2 * hstep;
    const unsigned ldsw = (unsigned)wid * 1024u;
    const int aoff = lds_byte(wr * 64 + fr, fq * 8), boff = lds_byte(wc * 32 + fr, fq * 8);
#define PG8_SA(b, h) (((b) * 2 + (h)) * HTB)
#define PG8_SB(b, h) ((4 + (b) * 2 + (h)) * HTB)
#define PG8_STAGE(bufoff, gbase, voff) do { _Pragma("unroll") for (int _i = 0; _i < 2; ++_i) \
        __builtin_amdgcn_global_load_lds((const unsigned*)((const char*)(gbase) + (voff)[_i]), (PG8_LAS unsigned*)(lds + (bufoff) + ldsw + _i * 8192), 16, 0, 0); } while (0)
#define PG8_LDA(dst, b, h) do { _Pragma("unroll") for (int m = 0; m < 4; ++m) _Pragma("unroll") for (int k = 0; k < 2; ++k) dst[m][k] = *(const PG8_LAS bf16x8*)(lds + PG8_SA(b, h) + aoff + m * 2048 + k * 1024); } while (0)
#define PG8_LDB(dst, b, h) do { _Pragma("unroll") for (int n = 0; n < 2; ++n) _Pragma("unroll") for (int k = 0; k < 2; ++k) dst[n][k] = *(const PG8_LAS bf16x8*)(lds + PG8_SB(b, h) + boff + n * 2048 + k * 1024); } while (0)
#define PG8_MMA(ai, bj, At, Bt) do { __builtin_amdgcn_s_setprio(1); _Pragma("unroll") for (int m = 0; m < 4; ++m) _Pragma("unroll") for (int n = 0; n < 2; ++n) _Pragma("unroll") for (int k = 0; k < 2; ++k) \
        acc[ai][bj][m][n] = __builtin_amdgcn_mfma_f32_16x16x32_bf16(Bt[n][k], At[m][k], acc[ai][bj][m][n], 0, 0, 0); __builtin_amdgcn_s_setprio(0); } while (0)
#define PG8_WAIT_V(n) asm volatile("s_waitcnt vmcnt(" #n ")" ::: "memory")
#define PG8_WAIT_L(n) asm volatile("s_waitcnt lgkmcnt(" #n ")" ::: "memory")
#define PG8_BAR __builtin_amdgcn_s_barrier()
#define PG8_SCHED __builtin_amdgcn_sched_barrier(0)
    Unit cur, nxt; int ui = 0;
    if (!S.next(0, cur)) return;
    f32x4 acc[2][2][4][2];
#pragma unroll
    for (int a = 0; a < 2; ++a)
#pragma unroll
        for (int b = 0; b < 2; ++b)
#pragma unroll
            for (int m = 0; m < 4; ++m)
#pragma unroll
                for (int n = 0; n < 2; ++n) acc[a][b][m][n] = (f32x4){0.f, 0.f, 0.f, 0.f};
    bf16x8 At[4][2], B0[2][2], B1[2][2];
    const char* cA = (const char*)g.A + (size_t)cur.pm * tstep + (size_t)cur.koff * 2; const char* cB = (const char*)g.Bt + (size_t)cur.pn * tstep + (size_t)cur.koff * 2;
    S.a_ready(cur);
    PG8_STAGE(PG8_SB(0, 0), cB, voffB); PG8_STAGE(PG8_SA(0, 0), cA, voffA); PG8_STAGE(PG8_SB(0, 1), cB + hstep, voffB); PG8_STAGE(PG8_SA(0, 1), cA + hstep, voffA);
    if (wr == 1) PG8_BAR;
    PG8_WAIT_V(4); PG8_BAR;
    PG8_STAGE(PG8_SB(1, 0), cB + kstep, voffB); PG8_STAGE(PG8_SA(1, 0), cA + kstep, voffA); PG8_STAGE(PG8_SB(1, 1), cB + hstep + kstep, voffB);
    PG8_WAIT_V(6); PG8_BAR;
    PG8_STAMP();
    for (;;) {
        const bool has_next = S.next(ui + 1, nxt);
        const char* nA = has_next ? (const char*)g.A + (size_t)nxt.pm * tstep + (size_t)nxt.koff * 2 : cA; const char* nB = has_next ? (const char*)g.Bt + (size_t)nxt.pn * tstep + (size_t)nxt.koff * 2 : cB;
        const int nt = cur.nt;
        for (int t = 0; t < nt; t += 2) {
            const bool last = (t == nt - 2);
            const char* a1 = cA + (size_t)(t + 1) * kstep;
            const char* a2 = last ? nA : cA + (size_t)(t + 2) * kstep; const char* b2 = last ? nB : cB + (size_t)(t + 2) * kstep;
            const char* a3 = a2 + kstep; const char* b3 = b2 + kstep;
            if (last && has_next) S.a_ready(nxt);
            PG8_LDB(B0, 0, 0); PG8_SCHED; PG8_LDA(At, 0, 0); PG8_STAGE(PG8_SA(1, 1), a1 + hstep, voffA);
            PG8_WAIT_L(8); PG8_BAR; PG8_WAIT_L(0); PG8_MMA(0, 0, At, B0); PG8_BAR; PG8_SCHED;
            PG8_LDB(B1, 0, 1); PG8_STAGE(PG8_SB(0, 0), b2, voffB);
            PG8_BAR; PG8_WAIT_L(0); PG8_MMA(0, 1, At, B1); PG8_BAR;
            PG8_LDA(At, 0, 1); PG8_STAGE(PG8_SA(0, 0), a2, voffA);
            PG8_BAR; PG8_WAIT_L(0); PG8_MMA(1, 0, At, B0); PG8_BAR; PG8_SCHED;
            PG8_STAGE(PG8_SB(0, 1), b2 + hstep, voffB);
            PG8_WAIT_V(6); PG8_BAR; PG8_MMA(1, 1, At, B1); PG8_BAR;
            PG8_LDB(B0, 1, 0); PG8_SCHED; PG8_LDA(At, 1, 0); PG8_STAGE(PG8_SA(0, 1), a2 + hstep, voffA);
            PG8_WAIT_L(8); PG8_BAR; PG8_WAIT_L(0); PG8_MMA(0, 0, At, B0); PG8_BAR; PG8_SCHED;
            PG8_LDB(B1, 1, 1); PG8_STAGE(PG8_SB(1, 0), b3, voffB);
            PG8_BAR; PG8_WAIT_L(0); PG8_MMA(0, 1, At, B1); PG8_BAR;
            PG8_LDA(At, 1, 1); PG8_STAGE(PG8_SA(1, 0), a3, voffA);
            PG8_BAR; PG8_WAIT_L(0); PG8_MMA(1, 0, At, B0); PG8_BAR; PG8_SCHED;
            PG8_STAGE(PG8_SB(1, 1), b3 + hstep, voffB);
            PG8_WAIT_V(6); PG8_BAR; PG8_MMA(1, 1, At, B1); PG8_BAR;
        }
        PG8_STAMP();
        if constexpr (!Epi::AFTER_DRAIN) { E(acc, cur, wr, wc, fr, fq); S.done(cur); }
        PG8_STAMP();
        if (!has_next) break;
#pragma unroll
        for (int a = 0; a < 2; ++a)
#pragma unroll
            for (int b = 0; b < 2; ++b)
#pragma unroll
                for (int m = 0; m < 4; ++m)
#pragma unroll
                    for (int n = 0; n < 2; ++n) acc[a][b][m][n] = (f32x4){0.f, 0.f, 0.f, 0.f};
        cur = nxt; cA = nA; cB = nB; ++ui;
    }
    PG8_WAIT_V(0);
    if (wr == 0) PG8_BAR;
    PG8_BAR;
    if constexpr (Epi::AFTER_DRAIN) { E.fused(acc, cur, wr, wc, fr, fq, lds, wid, lane); S.done(cur); }
    PG8_STAMP();
    if (STAMP && wid == 0) { stamps[lane] = lane < nts ? (((unsigned long long)(unsigned)ts_hi << 32) | (unsigned)ts_lo) : 0ull;
        if (lane == 62) stamps[62] = rt_entry; if (lane == 63) stamps[63] = (unsigned long long)wall_clock64(); }
#undef PG8_STAMP
#undef PG8_SA
#undef PG8_SB
#undef PG8_STAGE
#undef PG8_LDA
#undef PG8_LDB
#undef PG8_MMA
#undef PG8_WAIT_V
#undef PG8_WAIT_L
#undef PG8_BAR
#undef PG8_SCHED
}
}

#define LAS __attribute__((address_space(3)))
typedef unsigned short u16;
typedef short s16x4 __attribute__((ext_vector_type(4)));
typedef unsigned u32x2 __attribute__((ext_vector_type(2)));
typedef __bf16 bf2_t __attribute__((ext_vector_type(2)));
typedef float f2_t __attribute__((ext_vector_type(2)));
using pg8::bf16x8; using pg8::f32x4; using pg8::u32x4;

constexpr int DM = 2048, SEQ = 16384, RLAT = 32768, LCTX = 256, MROWS = 33280, DFF = 8192;
constexpr int PLD = 5376, NPROJ = 5632, NIN = 5400;
constexpr int OFF_GU = 0, OFF_GV = 512, OFF_AQ = 1024, OFF_AK = 1792, OFF_AV = 2048, OFF_MQ = 2304, OFF_MK = 3072, OFF_MV = 3840, OFF_MO = 4608;
constexpr int NCH = 130;
constexpr int NSEQ = 24;
constexpr float EPSN = 1e-6f;
constexpr float LOG2E = 1.4426950408889634f;
constexpr float QSCALE = 0.08838834764831845f;

constexpr size_t WS_WIN = 0;
constexpr size_t SZ_WIN = (size_t)NPROJ * DM * 2;
constexpr size_t WS_WOUT = WS_WIN + 2 * SZ_WIN;
constexpr size_t SZ_WOUT = (size_t)DM * DM * 2;
constexpr size_t WS_WFF1 = WS_WOUT + 2 * SZ_WOUT;
constexpr size_t SZ_WFF = (size_t)DFF * DM * 2;
constexpr size_t WS_WFF2 = WS_WFF1 + 2 * SZ_WFF;
constexpr size_t WS_MOD = WS_WFF2 + 2 * SZ_WFF;
constexpr size_t WS_ROPE = WS_MOD + 2 * 3 * 12288 * 4;
constexpr size_t WS_XC = WS_ROPE + 320 * 32 * 8;
constexpr size_t WS_GATES = WS_XC + (size_t)512 * DM * 4;
constexpr size_t WS_NST = WS_GATES + (size_t)MROWS * 32 * 4;
constexpr size_t WS_GSC = WS_NST + (size_t)NSEQ * NCH * 128 * 4;
constexpr size_t WS_MLS = WS_GSC + 16384;
constexpr size_t WS_M0 = WS_MLS + 16384;
constexpr size_t WS_SS = WS_M0 + 16384;
constexpr size_t WS_BIASP = WS_SS + (size_t)4 * MROWS * 4;
constexpr size_t WS_BIASF = WS_BIASP + (size_t)2 * 3 * NPROJ * 4;
constexpr size_t WS_GS = WS_BIASF + (size_t)2 * 3 * DFF * 4;
constexpr size_t WS_CTR = WS_GS + (size_t)2 * 2 * 3 * DM * 4;
constexpr size_t WS_BAR = WS_CTR + 256;
constexpr size_t WS_XN = WS_BAR + 16384;
constexpr size_t WS_R = WS_XN + (size_t)MROWS * DM * 2;
constexpr size_t SZ_PROJ = (size_t)MROWS * PLD * 2;
constexpr size_t WS_Y = WS_R + SZ_PROJ;
constexpr size_t SZ_H = (size_t)MROWS * DFF * 2;
constexpr size_t WS_CST = WS_R + SZ_H;
constexpr size_t WS_END = WS_CST + (size_t)NSEQ * NCH * 16384 * 2;

constexpr int LDS_BYTES = 163840;
constexpr int TSTR = 320;
constexpr int TILE_B = 128 * TSTR;
constexpr int SC_OFF = 3 * TILE_B;

struct Params {
    const float *x, *c, *ctx, *c_ctx, *w_ada, *b_ada, *g_mix, *g_ffn, *w_in, *gm_v_gain, *gm_w_s, *gm_b_s, *attn_sink,
        *ml_conv_w, *ml_conv_b, *ml_b_i, *ml_b_f, *ml_out_gain, *w_out, *w_ff1, *w_ff2, *g_final;
    float* out; unsigned char* ws;
};

#define DI __device__ __forceinline__
typedef const __attribute__((address_space(4))) Params* KP;
DI int tid_l() { int t = threadIdx.x; asm volatile("" : "+v"(t)); return t; }
DI KP launder(KP p) { asm volatile("" : "+s"(p)); return p; }
DI unsigned pk2(float lo, float hi) { bf2_t v = __builtin_convertvector((f2_t){lo, hi}, bf2_t); return __builtin_bit_cast(unsigned, v); }
DI float bf_lo(unsigned u) { return __uint_as_float(u << 16); }
DI float bf_hi(unsigned u) { return __uint_as_float(u & 0xffff0000u); }
DI float wave_sum(float v) {
#pragma unroll
    for (int o = 1; o < 64; o <<= 1) v += __shfl_xor(v, o);
    return v;
}
DI float wave_max(float v) {
#pragma unroll
    for (int o = 1; o < 64; o <<= 1) v = fmaxf(v, __shfl_xor(v, o));
    return v;
}
DI float gelu_tanh(float x) {
    const float k1 = -2.f * 0.7978845608028654f * LOG2E, k2 = k1 * 0.044715f;
    const float a = x * __builtin_fmaf(x * x, k2, k1);
    return x * __builtin_amdgcn_rcpf(1.f + __builtin_amdgcn_exp2f(a));
}
DI float sigmoidf_(float x) { return __builtin_amdgcn_rcpf(1.f + __builtin_amdgcn_exp2f(-LOG2E * x)); }
DI float log_sigmoid(float x) { return fminf(x, 0.f) - log1pf(__expf(-fabsf(x))); }
DI void unpack8(const u32x4 v, float* f) { f[0] = bf_lo(v.x); f[1] = bf_hi(v.x); f[2] = bf_lo(v.y); f[3] = bf_hi(v.y); f[4] = bf_lo(v.z); f[5] = bf_hi(v.z); f[6] = bf_lo(v.w); f[7] = bf_hi(v.w); }
DI u32x4 pack8(const float* f) { u32x4 o; o.x = pk2(f[0], f[1]); o.y = pk2(f[2], f[3]); o.z = pk2(f[4], f[5]); o.w = pk2(f[6], f[7]); return o; }
#define MFMA16(a, b, c) __builtin_amdgcn_mfma_f32_16x16x32_bf16((a), (b), (c), 0, 0, 0)

DI int toff(int row, int ch) { return row * TSTR + 16 * ch; }
DI bf16x8 frag_row(const LAS unsigned char* tile, int idx0, int k0, int lane) {
    return *(const LAS bf16x8*)(tile + toff(idx0 + (lane & 15), (k0 >> 3) + (lane >> 4)));
}
DI bf16x8 tr_pair(const LAS unsigned char* p, const LAS unsigned char* p2) {
    s16x4 a = __builtin_amdgcn_ds_read_tr16_b64_v4i16((LAS s16x4*)p);
    s16x4 b = __builtin_amdgcn_ds_read_tr16_b64_v4i16((LAS s16x4*)p2);
    return (bf16x8){a[0], a[1], a[2], a[3], b[0], b[1], b[2], b[3]};
}
DI bf16x8 frag_tr(const LAS unsigned char* tile, int k0, int idx0, int lane) {
    const int i = lane & 15, q = lane >> 4, row = k0 + 8 * q + (i >> 2), ch = (idx0 >> 3) + ((i & 3) >> 1), sub = 8 * (i & 1);
    return tr_pair(tile + toff(row, ch) + sub, tile + toff(row + 4, ch) + sub);
}
DI bf16x8 frag_tr_perm(const LAS unsigned char* tile, int k0, int idx0, int lane) {
    const int i = lane & 15, q = lane >> 4, row = k0 + 4 * q + (i >> 2), ch = (idx0 >> 3) + ((i & 3) >> 1), sub = 8 * (i & 1);
    const LAS unsigned char* a = tile + toff(row, ch) + sub;
    return tr_pair(a, a + 16 * TSTR);
}

DI const float* xrow_in(KP p, int stage, int row) {
    if (row < RLAT) return (stage ? (const float*)p->out : p->x) + (size_t)row * DM;
    return (stage ? (const float*)(p->ws + WS_XC) : p->ctx) + (size_t)(row - RLAT) * DM;
}
DI float* xrow_out(KP p, int row) {
    if (row < RLAT) return p->out + (size_t)row * DM;
    return (float*)(p->ws + WS_XC) + (size_t)(row - RLAT) * DM;
}
DI int mod_index(int row) { return row < SEQ ? 0 : (row < RLAT ? 1 : 2); }
DI float row_rstd(const float* ss, int row) { return rsqrtf(ss[row] * (1.f / DM) + EPSN); }

DI void transpose_item(const float* W, int K, int N, u16* WT, LAS float* scr  , int item, int nblk, int lane) {
    const int kb = item / nblk, nb = item % nblk, k0 = 64 * kb, n0 = 64 * nb;
    const int c4 = lane & 15, rr = lane >> 4;
    const bool ok = n0 + 4 * c4 < N;
    f32x4 v[16];
#pragma unroll
    for (int i = 0; i < 16; ++i) v[i] = ok ? *(const f32x4*)(W + (size_t)(k0 + 4 * i + rr) * N + n0 + 4 * c4) : (f32x4){0.f, 0.f, 0.f, 0.f};
#pragma unroll
    for (int i = 0; i < 16; ++i) { LAS float* d = scr + (4 * i + rr) * 65 + 4 * c4; d[0] = v[i].x; d[1] = v[i].y; d[2] = v[i].z; d[3] = v[i].w; }
    asm volatile("s_waitcnt lgkmcnt(0)" ::: "memory"); __builtin_amdgcn_wave_barrier();
    const int c = lane & 7;
#pragma unroll
    for (int j = 0; j < 8; ++j) { const int nn = (lane >> 3) + 8 * j; const LAS float* q = scr + (8 * c) * 65 + nn;
        u32x4 o; o.x = pk2(q[0 * 65], q[1 * 65]); o.y = pk2(q[2 * 65], q[3 * 65]); o.z = pk2(q[4 * 65], q[5 * 65]); o.w = pk2(q[6 * 65], q[7 * 65]);
        *(u32x4*)(WT + (size_t)(n0 + nn) * K + k0 + 8 * c) = o; }
    asm volatile("s_waitcnt lgkmcnt(0)" ::: "memory"); __builtin_amdgcn_wave_barrier();
}

DI void phase_prep(KP p, LAS unsigned char* lds) {
    const int tid = tid_l(), lane = tid & 63, wave = tid >> 6, bid = blockIdx.x, G = gridDim.x;
    { float* SS = (float*)(p->ws + WS_SS);
      for (int i = bid * 512 + tid; i < 3 * MROWS; i += G * 512) SS[i] = 0.f;
      if (bid == 0 && tid < 64) ((unsigned*)(p->ws + WS_CTR))[tid] = 0u; }
    { const f32x4* src = (const f32x4*)p->ctx; f32x4* dst = (f32x4*)(p->ws + WS_XC);
      for (int i = bid * 512 + tid; i < 512 * DM / 4; i += G * 512) dst[i] = src[i]; }
    {
        LAS float* sv = (LAS float*)lds;
        LAS float* red = (LAS float*)(lds + 3 * 2048 * 4);
        for (int i = tid; i < 3 * 2048; i += 512) { const int v = i >> 11, k = i & 2047; const float x = v == 0 ? p->c[k] : (v == 1 ? p->c[2048 + k] : p->c_ctx[k]); sv[i] = x * sigmoidf_(x); }
        __syncthreads();
        float* MOD = (float*)(p->ws + WS_MOD);
        for (int it = bid; it < 2 * 384; it += G) {
            const int l = it / 384, n0 = (it % 384) * 32, j = tid & 7, kk = tid >> 3;
            const float* w = p->w_ada + (size_t)l * 2048 * 12288 + n0 + 4 * j;
            f32x4 a0 = {0, 0, 0, 0}, a1 = a0, a2 = a0;
#pragma unroll 16
            for (int k = kk; k < 2048; k += 64) { const f32x4 wv = *(const f32x4*)(w + (size_t)k * 12288); a0 += wv * sv[k]; a1 += wv * sv[2048 + k]; a2 += wv * sv[4096 + k]; }
            LAS float* r = red + (kk * 8 + j) * 12;
            *(LAS f32x4*)(r) = a0; *(LAS f32x4*)(r + 4) = a1; *(LAS f32x4*)(r + 8) = a2;
            __syncthreads();
            if (tid < 96) { const int v = tid >> 5, cc = tid & 31, jj = cc >> 2, e = cc & 3; float sum = 0.f;
                for (int q = 0; q < 64; ++q) sum += red[(q * 8 + jj) * 12 + v * 4 + e];
                MOD[(size_t)(l * 3 + v) * 12288 + n0 + cc] = sum + p->b_ada[l * 12288 + n0 + cc]; }
            __syncthreads();
        }
    }
    {
        f2_t* ROPE = (f2_t*)(p->ws + WS_ROPE);
        for (int i = bid * 512 + tid; i < 320 * 32; i += G * 512) { const int pos = i >> 5, f = i & 31; const int pa = pos < 256 ? pos : pos - 256;
            const float freq = 1.0f / powf(10000.0f, (float)(2 * f) / 64.0f); const float ang = (float)pa * freq; ROPE[i] = (f2_t){cosf(ang), sinf(ang)}; }
    }
    {
        LAS float* scr = (LAS float*)(lds + wave * 16640);
        const int gw = bid * 8 + wave, NGW = G * 8;
        constexpr int I_IN = 32 * 88, I_OUT = 32 * 32, I_F1 = 32 * 128, I_F2 = 128 * 32, I_L = I_IN + I_OUT + I_F1 + I_F2;
        for (int it = gw; it < 2 * I_L; it += NGW) {
            const int l = it / I_L; int r = it % I_L;
            if (r < I_IN) { transpose_item(p->w_in + (size_t)l * DM * NIN, DM, NIN, (u16*)(p->ws + WS_WIN + l * SZ_WIN), scr, r, 88, lane); continue; } r -= I_IN;
            if (r < I_OUT) { transpose_item(p->w_out + (size_t)l * DM * DM, DM, DM, (u16*)(p->ws + WS_WOUT + l * SZ_WOUT), scr, r, 32, lane); continue; } r -= I_OUT;
            if (r < I_F1) { transpose_item(p->w_ff1 + (size_t)l * DM * DFF, DM, DFF, (u16*)(p->ws + WS_WFF1 + l * SZ_WFF), scr, r, 128, lane); continue; } r -= I_F1;
            transpose_item(p->w_ff2 + (size_t)l * DFF * DM, DFF, DM, (u16*)(p->ws + WS_WFF2 + l * SZ_WFF), scr, r, 32, lane);
        }
    }
}

DI void phase_prep2(KP p, LAS unsigned char* lds) {
    const int tid = tid_l(), lane = tid & 63, wave = tid >> 6, bid = blockIdx.x, G = gridDim.x;
    const float* MOD = (const float*)(p->ws + WS_MOD);
    { float* GS = (float*)(p->ws + WS_GS);
      for (int i = bid * 512 + tid; i < 2 * 2 * 3 * DM; i += G * 512) { const int k = i & 2047, cls = (i >> 11) % 3, which = (i / (3 * DM)) & 1, l = i / (6 * DM);
          GS[i] = (which ? p->g_ffn : p->g_mix)[l * DM + k] * (1.f + MOD[(size_t)(l * 3 + cls) * 12288 + (which * 3 + 1) * DM + k]); } }
    LAS float* sh = (LAS float*)lds;
    const int gw = bid * 8 + wave, NGW = G * 8;
    for (int l = 0; l < 2; ++l) {
        __syncthreads();
        for (int i = tid; i < 6 * DM; i += 512) { const int k = i & 2047, cls = (i >> 11) % 3, which = i / (3 * DM); sh[i] = MOD[(size_t)(l * 3 + cls) * 12288 + (which * 3) * DM + k]; }
        __syncthreads();
        for (int r = gw; r < NPROJ + DFF; r += NGW) {
            const bool isf = r >= NPROJ; const int n = isf ? r - NPROJ : r;
            const u16* wrow = isf ? (const u16*)(p->ws + WS_WFF1 + l * SZ_WFF) + (size_t)n * DM : (const u16*)(p->ws + WS_WIN + l * SZ_WIN) + (size_t)n * DM;
            const LAS float* s0 = sh + (isf ? 3 * DM : 0);
            float a0 = 0.f, a1 = 0.f, a2 = 0.f;
#pragma unroll
            for (int j = 0; j < 4; ++j) { const int k = 8 * (lane + 64 * j); float w[8]; unpack8(*(const u32x4*)(wrow + k), w);
#pragma unroll
                for (int e = 0; e < 8; ++e) { a0 += w[e] * s0[k + e]; a1 += w[e] * s0[DM + k + e]; a2 += w[e] * s0[2 * DM + k + e]; } }
            a0 = wave_sum(a0); a1 = wave_sum(a1); a2 = wave_sum(a2);
            if (lane == 0) { float* B = isf ? (float*)(p->ws + WS_BIASF) + (size_t)l * 3 * DFF : (float*)(p->ws + WS_BIASP) + (size_t)l * 3 * NPROJ; const int N = isf ? DFF : NPROJ;
                B[n] = a0; B[N + n] = a1; B[2 * N + n] = a2; }
        }
    }
}

DI void phase_norm0(KP p) {
    const int tid = tid_l(), lane = tid & 63, gw = blockIdx.x * 8 + (tid >> 6), NGW = gridDim.x * 8;
    const float* gain = p->g_mix;
    u16* XN = (u16*)(p->ws + WS_XN);
    float* SS = (float*)(p->ws + WS_SS) + 3 * MROWS;
    f32x4 v[8], nx[8];
    if (gw < MROWS) { const float* xr = xrow_in(p, 0, gw);
#pragma unroll
        for (int j = 0; j < 8; ++j) v[j] = *(const f32x4*)(xr + 4 * lane + 256 * j); }
    for (int row = gw; row < MROWS; row += NGW) {
        const int nrow = row + NGW;
        if (nrow < MROWS) { const float* xr = xrow_in(p, 0, nrow);
#pragma unroll
            for (int j = 0; j < 8; ++j) nx[j] = *(const f32x4*)(xr + 4 * lane + 256 * j); }
        const float* md = (const float*)(p->ws + WS_MOD) + (size_t)mod_index(row) * 12288;
        float sum = 0.f;
#pragma unroll
        for (int j = 0; j < 8; ++j) sum += (v[j].x * v[j].x + v[j].y * v[j].y) + (v[j].z * v[j].z + v[j].w * v[j].w);
        sum = wave_sum(sum);
        if (lane == 0) SS[row] = sum;
#pragma unroll
        for (int j = 0; j < 8; ++j) { const int c = 4 * lane + 256 * j;
            const f32x4 g = *(const f32x4*)(gain + c), sc = *(const f32x4*)(md + DM + c);
            const f32x4 y = (v[j] * g) * (sc + 1.f);
            u32x2 o; o.x = pk2(y.x, y.y); o.y = pk2(y.z, y.w);
            *(u32x2*)(XN + (size_t)row * DM + c) = o; }
#pragma unroll
        for (int j = 0; j < 8; ++j) v[j] = nx[j];
    }
}
DI void phase_ctx_norm(KP p, const float* gs  , float* ss, int nsp) {
    const int tid = tid_l(), lane = tid & 63, gw = blockIdx.x * 8 + (tid >> 6), NGW = gridDim.x * 8;
    u16* XN = (u16*)(p->ws + WS_XN);
    for (int row = RLAT + gw; row < MROWS; row += NGW) {
        float* xr = (float*)(p->ws + WS_XC) + (size_t)(row - RLAT) * DM;
        const float* part = (const float*)(p->ws + WS_CST) + (size_t)(row - RLAT) * DM;
        f32x4 v[8]; float sum = 0.f;
#pragma unroll
        for (int j = 0; j < 8; ++j) v[j] = *(const f32x4*)(xr + 4 * lane + 256 * j);
        for (int ks = 0; ks < nsp; ++ks) {
#pragma unroll
            for (int j = 0; j < 8; ++j) v[j] += *(const f32x4*)(part + (size_t)ks * 512 * DM + 4 * lane + 256 * j); }
#pragma unroll
        for (int j = 0; j < 8; ++j) { *(f32x4*)(xr + 4 * lane + 256 * j) = v[j]; sum += (v[j].x * v[j].x + v[j].y * v[j].y) + (v[j].z * v[j].z + v[j].w * v[j].w); }
        sum = wave_sum(sum);
        if (lane == 0) ss[row] = sum;
#pragma unroll
        for (int j = 0; j < 8; ++j) { const int c = 4 * lane + 256 * j; const f32x4 y = v[j] * *(const f32x4*)(gs + c);
            u32x2 o; o.x = pk2(y.x, y.y); o.y = pk2(y.z, y.w); *(u32x2*)(XN + (size_t)row * DM + c) = o; }
    }
}
DI void phase_final(KP p) {
    const int tid = tid_l(), lane = tid & 63, gw = blockIdx.x * 8 + (tid >> 6), NGW = gridDim.x * 8;
    f32x4 v[8], nx[8];
    if (gw < RLAT) { const float* xr = p->out + (size_t)gw * DM;
#pragma unroll
        for (int j = 0; j < 8; ++j) v[j] = *(const f32x4*)(xr + 4 * lane + 256 * j); }
    for (int row = gw; row < RLAT; row += NGW) {
        const int nrow = row + NGW;
        if (nrow < RLAT) { const float* xn = p->out + (size_t)nrow * DM;
#pragma unroll
            for (int j = 0; j < 8; ++j) nx[j] = *(const f32x4*)(xn + 4 * lane + 256 * j); }
        float* xr = p->out + (size_t)row * DM;
        float sum = 0.f;
#pragma unroll
        for (int j = 0; j < 8; ++j) sum += (v[j].x * v[j].x + v[j].y * v[j].y) + (v[j].z * v[j].z + v[j].w * v[j].w);
        const float rstd = rsqrtf(wave_sum(sum) * (1.f / DM) + EPSN);
#pragma unroll
        for (int j = 0; j < 8; ++j) { const int c = 4 * lane + 256 * j; const f32x4 g = *(const f32x4*)(p->g_final + c); *(f32x4*)(xr + c) = v[j] * rstd * g; }
#pragma unroll
        for (int j = 0; j < 8; ++j) v[j] = nx[j];
    }
}

struct EpiProj {
    static constexpr bool PERM = true, AFTER_DRAIN = false;
    u16* O; float* gates; const float* ss; const float* bias0;
    __device__ __forceinline__ void operator()(const f32x4 (&acc)[2][2][4][2], const pg8::Unit& u, int wr, int wc, int fr, int fq) const {
        const int row0 = u.pm * 256 + wr * 64 + fr;
        const float* bias = bias0 + (size_t)mod_index(u.pm * 256) * NPROJ + u.pn * 256 + wc * 32 + 8 * fq;
        float rs[2][4];
#pragma unroll
        for (int ai = 0; ai < 2; ++ai)
#pragma unroll
            for (int m = 0; m < 4; ++m) rs[ai][m] = row_rstd(ss, row0 + ai * 128 + m * 16);
        {
            const int col0 = u.pn * 256 + wc * 32 + 8 * fq;
            f32x4 bb[2][2];
#pragma unroll
            for (int bj = 0; bj < 2; ++bj) { bb[bj][0] = *(const f32x4*)(bias + bj * 128); bb[bj][1] = *(const f32x4*)(bias + bj * 128 + 4); }
#pragma unroll
            for (int bj = 0; bj < 2; ++bj) { const f32x4 b0 = bb[bj][0], b1 = bb[bj][1];
#pragma unroll
                for (int ai = 0; ai < 2; ++ai)
#pragma unroll
                    for (int m = 0; m < 4; ++m) { const f32x4 v0 = acc[ai][bj][m][0] * rs[ai][m] + b0, v1 = acc[ai][bj][m][1] * rs[ai][m] + b1;
                        u32x4 o; o.x = pk2(v0[0], v0[1]); o.y = pk2(v0[2], v0[3]); o.z = pk2(v1[0], v1[1]); o.w = pk2(v1[2], v1[3]);
                        *(u32x4*)(O + (size_t)(row0 + ai * 128 + m * 16) * PLD + col0 + bj * 128) = o; } }
        }
    }
};
struct EpiRes {
    static constexpr bool PERM = false, AFTER_DRAIN = false;
    KP p; int stage; const float* gate0;
    const float* gs0; float* ssn;
    int ntfull;
    __device__ __forceinline__ void operator()(const f32x4 (&acc)[2][2][4][2], const pg8::Unit& u, int wr, int wc, int fr, int fq) const {
        const int row0 = u.pm * 256 + wr * 64 + fr, col0 = u.pn * 256 + wc * 32 + 4 * fq, cls = mod_index(u.pm * 256);
        const float* gate = gate0 + (size_t)cls * 12288 + col0;
        if (u.nt != ntfull) {
#pragma unroll
            for (int ai = 0; ai < 2; ++ai)
#pragma unroll
                for (int m = 0; m < 4; ++m) { float* xo = (float*)(p->ws + WS_CST) + ((size_t)(u.koff / 512) * 512 + (row0 + ai * 128 + m * 16 - RLAT)) * DM + col0;
#pragma unroll
                    for (int bj = 0; bj < 2; ++bj)
#pragma unroll
                        for (int n = 0; n < 2; ++n) { const int co = bj * 128 + n * 16; *(f32x4*)(xo + co) = *(const f32x4*)(gate + co) * acc[ai][bj][m][n]; } }
            return;
        }
        const float* gs = gs0 ? gs0 + cls * DM + col0 : nullptr;
        u16* XN = (u16*)(p->ws + WS_XN);
#pragma unroll
        for (int am = 0; am < 4; ++am) {
            f32x4 xv[2][2][2];
#pragma unroll
            for (int h = 0; h < 2; ++h) { const int ai = am >> 1, m = (am & 1) * 2 + h; const float* xi = xrow_in(p, stage, row0 + ai * 128 + m * 16) + col0;
#pragma unroll
                for (int bj = 0; bj < 2; ++bj)
#pragma unroll
                    for (int n = 0; n < 2; ++n) xv[h][bj][n] = *(const f32x4*)(xi + bj * 128 + n * 16); }
#pragma unroll
            for (int h = 0; h < 2; ++h) { const int ai = am >> 1, m = (am & 1) * 2 + h; const int row = row0 + ai * 128 + m * 16; float* xo = xrow_out(p, row) + col0;
                float sq = 0.f;
#pragma unroll
                for (int bj = 0; bj < 2; ++bj)
#pragma unroll
                    for (int n = 0; n < 2; ++n) { const int co = bj * 128 + n * 16;
                        const f32x4 v = xv[h][bj][n] + *(const f32x4*)(gate + co) * acc[ai][bj][m][n];
                        *(f32x4*)(xo + co) = v;
                        if (gs) { const f32x4 y = v * *(const f32x4*)(gs + co); u32x2 o; o.x = pk2(y.x, y.y); o.y = pk2(y.z, y.w);
                            *(u32x2*)(XN + (size_t)row * DM + col0 + co) = o; sq += (v.x * v.x + v.y * v.y) + (v.z * v.z + v.w * v.w); } }
                if (gs) { sq += __shfl_xor(sq, 16); sq += __shfl_xor(sq, 32); if (fq == 0) atomicAdd(ssn + row, sq); } }
        }
    }
};
struct EpiSqRelu {
    static constexpr bool PERM = true, AFTER_DRAIN = false;
    u16* O; const float* ss; const float* bias0;
    __device__ __forceinline__ void operator()(const f32x4 (&acc)[2][2][4][2], const pg8::Unit& u, int wr, int wc, int fr, int fq) const {
        const int row0 = u.pm * 256 + wr * 64 + fr, col0 = u.pn * 256 + wc * 32 + 8 * fq;
        const float* bias = bias0 + (size_t)mod_index(u.pm * 256) * DFF + col0;
        float rs[2][4];
#pragma unroll
        for (int ai = 0; ai < 2; ++ai)
#pragma unroll
            for (int m = 0; m < 4; ++m) rs[ai][m] = row_rstd(ss, row0 + ai * 128 + m * 16);
        f32x4 bb[2][2];
#pragma unroll
        for (int bj = 0; bj < 2; ++bj) { bb[bj][0] = *(const f32x4*)(bias + bj * 128); bb[bj][1] = *(const f32x4*)(bias + bj * 128 + 4); }
#pragma unroll
        for (int bj = 0; bj < 2; ++bj) { const f32x4 b0 = bb[bj][0], b1 = bb[bj][1];
#pragma unroll
            for (int ai = 0; ai < 2; ++ai)
#pragma unroll
                for (int m = 0; m < 4; ++m) { f32x4 v0 = acc[ai][bj][m][0] * rs[ai][m] + b0, v1 = acc[ai][bj][m][1] * rs[ai][m] + b1;
#pragma unroll
                    for (int e = 0; e < 4; ++e) { const float a = fmaxf(v0[e], 0.f), b = fmaxf(v1[e], 0.f); v0[e] = a * a; v1[e] = b * b; }
                    u32x4 o; o.x = pk2(v0[0], v0[1]); o.y = pk2(v0[2], v0[3]); o.z = pk2(v1[0], v1[1]); o.w = pk2(v1[2], v1[3]);
                    *(u32x4*)(O + (size_t)(row0 + ai * 128 + m * 16) * DFF + col0 + bj * 128) = o; } }
    }
};
template <class Epi> DI void run_gemm(LAS unsigned char* lds, const u16* A, const u16* Bt, int M, int N, int K, const Epi& E) {
    pg8::Gemm g; g.A = A; g.Bt = Bt; g.M = M; g.N = N; g.K = K;
    pg8::StaticOrder S; S.init(M, N, K, (int)gridDim.x, (int)blockIdx.x);
    pg8::gemm_phase<Epi, pg8::StaticOrder, false>(lds, g, S, E, nullptr);
}
struct SplitOrder : pg8::StaticOrder {
    int nsp, ksp, ntsp, pm0, nctx;
    __device__ __forceinline__ bool next(int i, pg8::Unit& u) const {
        const long L = (long)i * G + c;
        if (L < nwg) return pg8::StaticOrder::next(i, u);
        const int q = (int)(L - nwg); if (q >= nctx) return false;
        const int tile = q % (2 * nN), ks = q / (2 * nN);
        u.pm = pm0 + tile / nN; u.pn = tile % nN; u.koff = ks * ksp; u.nt = ntsp; return true;
    }
};
template <class Epi> DI void run_gemm_split(LAS unsigned char* lds, const u16* A, const u16* Bt, int Mlat, int N, int K, int nsp, const Epi& E) {
    pg8::Gemm g; g.A = A; g.Bt = Bt; g.M = Mlat; g.N = N; g.K = K;
    SplitOrder S; S.init(Mlat, N, K, (int)gridDim.x, (int)blockIdx.x);
    S.nsp = nsp; S.ksp = nsp ? K / nsp : K; S.ntsp = S.ksp / 64; S.pm0 = Mlat / 256; S.nctx = nsp ? 2 * (N / 256) * nsp : 0;
    S.wgm = 4;
    pg8::gemm_phase<Epi, SplitOrder, false>(lds, g, S, E, nullptr);
}


DI void stage_plain(LAS unsigned char* T, const u16* src, int ld, int tid) {
#pragma unroll
    for (int i = 0; i < 4; ++i) { const int id = tid + 512 * i, row = id >> 4, ch = id & 15;
        *(LAS u32x4*)(T + toff(row, ch)) = *(const u32x4*)(src + (size_t)row * ld + ch * 8); }
}
DI void stage_rope(LAS unsigned char* T, const u16* src, int ld, int pos0, float scale, const f2_t* ROPE, int tid) {
#pragma unroll
    for (int i = 0; i < 2; ++i) { const int task = tid + 512 * i, row = task >> 3, pp = task & 7, cq = pp & 3, half = pp >> 2, chA = half * 8 + cq;
        const int pos = pos0 + row, pa = half ? 256 + (pos & 63) : (pos >> 6);
        const u32x4 ra = *(const u32x4*)(src + (size_t)row * ld + chA * 8), rb = *(const u32x4*)(src + (size_t)row * ld + (chA + 4) * 8);
        float x1[8], x2[8], o1[8], o2[8]; unpack8(ra, x1); unpack8(rb, x2);
        const f2_t* tb = ROPE + pa * 32 + cq * 8;
#pragma unroll
        for (int e = 0; e < 8; ++e) { const f2_t cs = tb[e]; o1[e] = (x1[e] * cs.x - x2[e] * cs.y) * scale; o2[e] = (x1[e] * cs.y + x2[e] * cs.x) * scale; }
        *(LAS u32x4*)(T + toff(row, chA)) = pack8(o1); *(LAS u32x4*)(T + toff(row, chA + 4)) = pack8(o2); }
}
DI void stage_conv(LAS unsigned char* T, const u16* src, int ld, int lo, int hi, const float* cw  , const float* cb, float scale, int tid, u16* gdst = nullptr  ) {
    u32x4 pkk[4];
#pragma unroll
    for (int i = 0; i < 4; ++i) { const int id = tid + 512 * i, row = id >> 4, ch = id & 15;
        float xm[8], x0[8], xp[8], y[8];
        const u32x4 z = {0u, 0u, 0u, 0u};
        const bool okm = row - 1 >= lo, okp = row + 1 < hi;
        const u32x4 r0 = *(const u32x4*)(src + (size_t)row * ld + ch * 8);
        u32x4 rm = *(const u32x4*)(src + (ptrdiff_t)(okm ? row - 1 : row) * ld + ch * 8);
        u32x4 rp = *(const u32x4*)(src + (ptrdiff_t)(okp ? row + 1 : row) * ld + ch * 8);
        rm = okm ? rm : z; rp = okp ? rp : z;
        unpack8(rm, xm); unpack8(r0, x0); unpack8(rp, xp);
#pragma unroll
        for (int e = 0; e < 8; ++e) { const int c = ch * 8 + e; const float v = cb[c] + xm[e] * cw[c] + x0[e] * cw[1536 + c] + xp[e] * cw[3072 + c]; y[e] = v * sigmoidf_(v) * scale; }
        const u32x4 pk = pack8(y);
        *(LAS u32x4*)(T + toff(row, ch)) = pk; pkk[i] = pk; }
    if (gdst) {
#pragma unroll
        for (int i = 0; i < 4; ++i) { const int id = tid + 512 * i; *(u32x4*)(gdst + (size_t)(id >> 4) * 768 + (id & 15) * 8) = pkk[i]; } }
}

DI void gate_item(KP p, int l, int it, LAS unsigned char* lds) {
    const int tid = tid_l(), lane = tid & 63, wid = tid >> 6, fr = lane & 15, fq = lane >> 4;
    const int r0 = it * 128, srow = tid >> 4, sch = tid & 15;
    const u16* xa = (const u16*)(p->ws + WS_XN) + (size_t)(r0 + srow) * DM + sch * 8;
    const u16* wg = (const u16*)(p->ws + WS_WIN + l * SZ_WIN) + (size_t)(PLD + (tid >> 4)) * DM + sch * 8;
    LAS unsigned char* T0 = lds; LAS unsigned char* T1 = lds + TILE_B;
    u32x4 ar[4], wreg;
#pragma unroll
    for (int i = 0; i < 4; ++i) ar[i] = *(const u32x4*)(xa + (size_t)(32 * i) * DM);
    wreg = *(const u32x4*)wg;
    f32x4 acc0 = {0.f, 0.f, 0.f, 0.f}, acc1 = {0.f, 0.f, 0.f, 0.f};
    for (int kc = 0; kc < 16; ++kc) {
        __syncthreads();
#pragma unroll
        for (int i = 0; i < 4; ++i) *(LAS u32x4*)(T0 + toff(srow + 32 * i, sch)) = ar[i];
        *(LAS u32x4*)(T1 + toff(srow, sch)) = wreg;
        if (kc < 15) {
#pragma unroll
            for (int i = 0; i < 4; ++i) ar[i] = *(const u32x4*)(xa + (size_t)(32 * i) * DM + (kc + 1) * 128);
            wreg = *(const u32x4*)(wg + (kc + 1) * 128); }
        __syncthreads();
#pragma unroll
        for (int ks = 0; ks < 4; ++ks) { const bf16x8 xf = frag_row(T0, 16 * wid, 32 * ks, lane);
            acc0 = MFMA16(frag_row(T1, 0, 32 * ks, lane), xf, acc0); acc1 = MFMA16(frag_row(T1, 16, 32 * ks, lane), xf, acc1); }
    }
    const int row = r0 + 16 * wid + fr;
    const float rs = row_rstd((const float*)(p->ws + WS_SS) + (l == 0 ? 3 : 1) * MROWS, row);
    const float* bias = (const float*)(p->ws + WS_BIASP) + (size_t)(l * 3 + mod_index(row)) * NPROJ + PLD + 4 * fq;
    float* gp = (float*)(p->ws + WS_GATES) + (size_t)row * 32 + 4 * fq;
    *(f32x4*)gp = acc0 * rs + *(const f32x4*)bias; *(f32x4*)(gp + 16) = acc1 * rs + *(const f32x4*)(bias + 16);
    __syncthreads();
}

DI void gmlp_item(KP p, int l, int it, LAS unsigned char* lds) {
    const int tid = tid_l(), lane = tid & 63, wid = tid >> 6, fr = lane & 15, fq = lane >> 4;
    const int n = it >> 2, g = it & 3, r0 = n * 128;
    if (l == 1 && n >= 256) return;
    const u16* proj = (const u16*)(p->ws + WS_R);
    u16* Y = (u16*)(p->ws + WS_Y);
    LAS unsigned char* T0 = lds; LAS unsigned char* T1 = lds + TILE_B;
    u32x2 ur[2][4];
#pragma unroll
    for (int a = 0; a < 2; ++a)
#pragma unroll
        for (int b = 0; b < 4; ++b) ur[a][b] = *(const u32x2*)(proj + (size_t)(r0 + 64 * (wid & 1) + 16 * b + fr) * PLD + OFF_GU + g * 128 + 32 * (wid >> 1) + 16 * a + 4 * fq);
    { const float* ws = p->gm_w_s + (size_t)(l * 4 + g) * 16384;
#pragma unroll
      for (int i = 0; i < 8; ++i) { const int f = tid + 512 * i, row = f >> 5, c4 = f & 31; const f32x4 v = *(const f32x4*)(ws + (size_t)f * 4);
          u32x2 o; o.x = pk2(v.x, v.y); o.y = pk2(v.z, v.w); *(LAS u32x2*)(T0 + toff(row, c4 >> 1) + 8 * (c4 & 1)) = o; } }
    { const float* vg = p->gm_v_gain + l * 512 + g * 128;
#pragma unroll
      for (int i = 0; i < 4; ++i) { const int id = tid + 512 * i, row = id >> 4, ch = id & 15;
          float v[8]; unpack8(*(const u32x4*)(proj + (size_t)(r0 + row) * PLD + OFF_GV + g * 128 + ch * 8), v);
          float ss = 0.f;
#pragma unroll
          for (int e = 0; e < 8; ++e) { v[e] = gelu_tanh(v[e]); ss += v[e] * v[e]; }
          ss += __shfl_xor(ss, 1); ss += __shfl_xor(ss, 2); ss += __shfl_xor(ss, 4); ss += __shfl_xor(ss, 8);
          const float rstd = rsqrtf(ss * (1.f / 128.f) + EPSN);
#pragma unroll
          for (int e = 0; e < 8; ++e) v[e] = v[e] * rstd * vg[ch * 8 + e];
          *(LAS u32x4*)(T1 + toff(row, ch)) = pack8(v); } }
    __syncthreads();
    const int cb = 32 * (wid >> 1), pb = 64 * (wid & 1);
    f32x4 acc[2][4];
#pragma unroll
    for (int a = 0; a < 2; ++a)
#pragma unroll
        for (int b = 0; b < 4; ++b) acc[a][b] = (f32x4){0.f, 0.f, 0.f, 0.f};
#pragma unroll
    for (int ks = 0; ks < 4; ++ks) {
        bf16x8 af[2], bfg[4];
#pragma unroll
        for (int a = 0; a < 2; ++a) af[a] = frag_tr(T1, 32 * ks, cb + 16 * a, lane);
#pragma unroll
        for (int b = 0; b < 4; ++b) bfg[b] = frag_row(T0, pb + 16 * b, 32 * ks, lane);
#pragma unroll
        for (int a = 0; a < 2; ++a)
#pragma unroll
            for (int b = 0; b < 4; ++b) acc[a][b] = MFMA16(af[a], bfg[b], acc[a][b]);
    }
    const float* bs = p->gm_b_s + (l * 4 + g) * 128;
    float bsr[4];
#pragma unroll
    for (int b = 0; b < 4; ++b) bsr[b] = bs[pb + 16 * b + fr];
#pragma unroll
    for (int a = 0; a < 2; ++a)
#pragma unroll
        for (int b = 0; b < 4; ++b) { const int pp = pb + 16 * b + fr, c0 = cb + 16 * a + 4 * fq; const float bias = bsr[b];
            const u32x2 uu = ur[a][b];
            const float u0 = gelu_tanh(bf_lo(uu.x)), u1 = gelu_tanh(bf_hi(uu.x)), u2 = gelu_tanh(bf_lo(uu.y)), u3 = gelu_tanh(bf_hi(uu.y));
            u32x2 o; o.x = pk2(u0 * (acc[a][b][0] + bias), u1 * (acc[a][b][1] + bias)); o.y = pk2(u2 * (acc[a][b][2] + bias), u3 * (acc[a][b][3] + bias));
            *(u32x2*)(Y + (size_t)(r0 + pp) * DM + g * 128 + c0) = o; }
    __syncthreads();
}

DI void rope_item(KP p, int it) {
    const int tid = tid_l();
    u16* proj = (u16*)(p->ws + WS_R);
    const f2_t* ROPE = (const f2_t*)(p->ws + WS_ROPE);
    const float qs = QSCALE * LOG2E;
    const int row0 = it * 128;
    if (it < 256) {
        const int pos0 = (it & 127) * 128;
        for (int i0 = 0; i0 < 16; i0 += 4) {
            u32x4 ra[4], rb[4]; f2_t cs[4][8];
#pragma unroll
            for (int k = 0; k < 4; ++k) { const int task = tid + 512 * (i0 + k), hh = task >> 10, row = (task >> 3) & 127, pp = task & 7, cq = pp & 3, half = pp >> 2, chA = half * 8 + cq;
                const int pos = pos0 + row, pa = half ? 256 + (pos & 63) : (pos >> 6);
                const u16* src = proj + (size_t)(row0 + row) * PLD + OFF_AQ + hh * 128;
                ra[k] = *(const u32x4*)(src + chA * 8); rb[k] = *(const u32x4*)(src + (chA + 4) * 8);
                const f2_t* tb = ROPE + pa * 32 + cq * 8;
#pragma unroll
                for (int e = 0; e < 8; ++e) cs[k][e] = tb[e]; }
#pragma unroll
            for (int k = 0; k < 4; ++k) { const int task = tid + 512 * (i0 + k), hh = task >> 10, row = (task >> 3) & 127, pp = task & 7, cq = pp & 3, half = pp >> 2, chA = half * 8 + cq;
                u16* src = proj + (size_t)(row0 + row) * PLD + OFF_AQ + hh * 128;
                const float scale = hh < 6 ? qs : 1.f;
                float x1[8], x2[8], o1[8], o2[8]; unpack8(ra[k], x1); unpack8(rb[k], x2);
#pragma unroll
                for (int e = 0; e < 8; ++e) { o1[e] = (x1[e] * cs[k][e].x - x2[e] * cs[k][e].y) * scale; o2[e] = (x1[e] * cs[k][e].y + x2[e] * cs[k][e].x) * scale; }
                *(u32x4*)(src + chA * 8) = pack8(o1); *(u32x4*)(src + (chA + 4) * 8) = pack8(o2); }
        }
    } else {
#pragma unroll 2
        for (int i = 0; i < 24; ++i) { const int id = tid + 512 * i, row = id / 96, ch = id % 96; float v[8];
            u16* src = proj + (size_t)(row0 + row) * PLD + OFF_AQ + ch * 8;
            unpack8(*(const u32x4*)src, v);
#pragma unroll
            for (int e = 0; e < 8; ++e) v[e] *= qs;
            *(u32x4*)src = pack8(v); }
    }
}

DI void attn_tile(int kt, bool isctx, int b, int nb, bool& valid, int& krow0, int& jloc) {
    jloc = 0; valid = true;
    if (kt < 2) { krow0 = RLAT + b * LCTX + kt * 128; return; }
    jloc = kt - 3; const int kb = nb + jloc; krow0 = b * SEQ + kb * 128;
    valid = !isctx && kb >= 0 && kb <= 127 && kt < 5;
    if (!valid) krow0 = 0;
}
DI void attn_item(KP p, int l, int it, LAS unsigned char* lds) {
    const int tid = tid_l(), lane = tid & 63, wid = tid >> 6, fr = lane & 15, fq = lane >> 4;
    const u16* proj = (const u16*)(p->ws + WS_R);
    u16* Y = (u16*)(p->ws + WS_Y);
    LAS unsigned char* T0 = lds; LAS unsigned char* T1 = lds + TILE_B; LAS unsigned char* T2 = lds + 2 * TILE_B;
    int b, nb, hq, qrow0; bool isctx;
    if (it < 1536) { hq = it % 6; nb = (it / 6) & 127; b = it / 768; qrow0 = b * SEQ + nb * 128; isctx = false; }
    else { if (l == 1) return; const int r = it - 1536; hq = r % 6; const int cbk = (r / 6) & 1; b = r / 12; nb = 0; qrow0 = RLAT + b * LCTX + cbk * 128; isctx = true; }
    const int kvh = hq / 3;
    const int srow = tid >> 4, sch = tid & 15;
    u32x4 kr[4], vr[4];
    { const u16* ks = proj + (size_t)(RLAT + b * LCTX) * PLD + OFF_AK + kvh * 128 + sch * 8; const u16* vs = proj + (size_t)(RLAT + b * LCTX) * PLD + OFF_AV + kvh * 128 + sch * 8;
#pragma unroll
      for (int i = 0; i < 4; ++i) { kr[i] = *(const u32x4*)(ks + (size_t)(srow + 32 * i) * PLD); vr[i] = *(const u32x4*)(vs + (size_t)(srow + 32 * i) * PLD); } }
    stage_plain(T0, proj + (size_t)qrow0 * PLD + OFF_AQ + hq * 128, PLD, tid);
    __syncthreads();
    bf16x8 Qf[4];
#pragma unroll
    for (int ks = 0; ks < 4; ++ks) Qf[ks] = frag_row(T0, 16 * wid, 32 * ks, lane);
    float m = p->attn_sink[l * 6 + hq] * LOG2E, lsum = 1.f;
    f32x4 O[8];
#pragma unroll
    for (int i = 0; i < 8; ++i) O[i] = (f32x4){0.f, 0.f, 0.f, 0.f};
    const int rin = 16 * wid + fr;
    for (int kt = 0; kt < 5; ++kt) {
        bool valid; int krow0, jloc; attn_tile(kt, isctx, b, nb, valid, krow0, jloc);
        if (!valid) continue;
        __syncthreads();
#pragma unroll
        for (int i = 0; i < 4; ++i) { *(LAS u32x4*)(T1 + toff(srow + 32 * i, sch)) = kr[i]; *(LAS u32x4*)(T2 + toff(srow + 32 * i, sch)) = vr[i]; }
        {
          int kn = kt + 1; bool vn; int rn, jn; attn_tile(kn, isctx, b, nb, vn, rn, jn);
          if (!vn && kn < 4) { ++kn; attn_tile(kn, isctx, b, nb, vn, rn, jn); }
          if (vn) { const u16* ks = proj + (size_t)rn * PLD + OFF_AK + kvh * 128 + sch * 8; const u16* vs = proj + (size_t)rn * PLD + OFF_AV + kvh * 128 + sch * 8;
#pragma unroll
              for (int i = 0; i < 4; ++i) { kr[i] = *(const u32x4*)(ks + (size_t)(srow + 32 * i) * PLD); vr[i] = *(const u32x4*)(vs + (size_t)(srow + 32 * i) * PLD); } } }
        __syncthreads();
        const bool local = kt >= 2;
        f32x4 S[8];
#pragma unroll
        for (int n = 0; n < 8; ++n) S[n] = (f32x4){0.f, 0.f, 0.f, 0.f};
        {
            bf16x8 kf[2][8];
#pragma unroll
            for (int n = 0; n < 8; ++n) kf[0][n] = frag_row(T1, 16 * n, 0, lane);
#pragma unroll
            for (int ks = 0; ks < 4; ++ks) {
                if (ks < 3) {
#pragma unroll
                    for (int n = 0; n < 8; ++n) kf[(ks + 1) & 1][n] = frag_row(T1, 16 * n, 32 * (ks + 1), lane);
                }
#pragma unroll
                for (int n = 0; n < 8; ++n) S[n] = MFMA16(kf[ks & 1][n], Qf[ks], S[n]);
            }
        }
        if (local && jloc != 0) {
#pragma unroll
            for (int n = 0; n < 8; ++n)
#pragma unroll
                for (int j = 0; j < 4; ++j) { const int dk = 16 * n + 4 * fq + j - rin; const bool keep = jloc < 0 ? dk >= 0 : dk <= 0; S[n][j] = keep ? S[n][j] : -INFINITY; }
        }
        float mx = -INFINITY;
#pragma unroll
        for (int n = 0; n < 8; ++n) mx = fmaxf(fmaxf(mx, fmaxf(S[n][0], S[n][1])), fmaxf(S[n][2], S[n][3]));
        mx = fmaxf(mx, __shfl_xor(mx, 16)); mx = fmaxf(mx, __shfl_xor(mx, 32));
        const float mnew = fmaxf(m, mx), alpha = __builtin_amdgcn_exp2f(m - mnew);
        float rs = 0.f;
#pragma unroll
        for (int n = 0; n < 8; ++n)
#pragma unroll
            for (int j = 0; j < 4; ++j) { const float e = __builtin_amdgcn_exp2f(S[n][j] - mnew); S[n][j] = e; rs += e; }
        rs += __shfl_xor(rs, 16); rs += __shfl_xor(rs, 32);
        lsum = lsum * alpha + rs; m = mnew;
#pragma unroll
        for (int i = 0; i < 8; ++i) O[i] *= alpha;
        bf16x8 Pf[4];
#pragma unroll
        for (int nn = 0; nn < 4; ++nn) { u32x4 o; o.x = pk2(S[2 * nn][0], S[2 * nn][1]); o.y = pk2(S[2 * nn][2], S[2 * nn][3]); o.z = pk2(S[2 * nn + 1][0], S[2 * nn + 1][1]); o.w = pk2(S[2 * nn + 1][2], S[2 * nn + 1][3]); Pf[nn] = __builtin_bit_cast(bf16x8, o); }
        {
            bf16x8 vf[2][8];
#pragma unroll
            for (int nd = 0; nd < 8; ++nd) vf[0][nd] = frag_tr_perm(T2, 0, 16 * nd, lane);
#pragma unroll
            for (int nn = 0; nn < 4; ++nn) {
                if (nn < 3) {
#pragma unroll
                    for (int nd = 0; nd < 8; ++nd) vf[(nn + 1) & 1][nd] = frag_tr_perm(T2, 32 * (nn + 1), 16 * nd, lane);
                }
#pragma unroll
                for (int nd = 0; nd < 8; ++nd) O[nd] = MFMA16(vf[nn & 1][nd], Pf[nn], O[nd]);
            }
        }
    }
    const float inv = __builtin_amdgcn_rcpf(lsum);
    u16* yr = Y + (size_t)(qrow0 + rin) * DM + 512 + hq * 128 + 4 * fq;
#pragma unroll
    for (int nd = 0; nd < 8; ++nd) { u32x2 o; o.x = pk2(O[nd][0] * inv, O[nd][1] * inv); o.y = pk2(O[nd][2] * inv, O[nd][3] * inv); *(u32x2*)(yr + 16 * nd) = o; }
    __syncthreads();
}

DI void ml_item_geom(int it, int& b, int& c, int& h, int& base, int& lo, int& hi) {
    h = it % 6; c = (it / 6) % NCH; b = it / (6 * NCH);
    if (c < 2) { base = RLAT + b * LCTX + c * 128; lo = -c * 128; hi = LCTX - c * 128; }
    else { base = b * SEQ + (c - 2) * 128; lo = -(c - 2) * 128; hi = SEQ - (c - 2) * 128; }
}
DI int ml_pos(int c, int d) { return d == 0 ? c : (c < 2 ? 1 - c : 131 - c); }
DI void ml_gate_scan(const float* gates, int base, int d, int h, float bi, float bff, int lane, int& t0, int& t1, float& li0, float& li1, float& b0, float& b1) {
    t0 = d ? 127 - 2 * lane : 2 * lane; t1 = d ? t0 - 1 : t0 + 1;
    const float* g0 = gates + (size_t)(base + t0) * 32 + d * 12 + h; const float* g1 = gates + (size_t)(base + t1) * 32 + d * 12 + h;
    li0 = g0[0] + bi; li1 = g1[0] + bi;
    const float lf0 = log_sigmoid(g0[6] + bff), lf1 = log_sigmoid(g1[6] + bff);
    float s = lf0 + lf1;
#pragma unroll
    for (int o = 1; o < 64; o <<= 1) { const float v = __shfl_up(s, o); if (lane >= o) s += v; }
    b1 = s; b0 = s - lf1;
}

DI void ml1_item(KP p, int l, int it, LAS unsigned char* lds) {
    const int tid = tid_l(), lane = tid & 63, wid = tid >> 6, fr = lane & 15, fq = lane >> 4;
    int b, c, h, base, lo, hi; ml_item_geom(it, b, c, h, base, lo, hi);
    const u16* proj = (const u16*)(p->ws + WS_R);
    const float* gates = (const float*)(p->ws + WS_GATES);
    LAS unsigned char* T0 = lds; LAS unsigned char* T1 = lds + TILE_B; LAS unsigned char* T2 = lds + 2 * TILE_B;
    LAS float* wsc = (LAS float*)(lds + SC_OFF);
    if (wid < 2) { const int d = wid; int t0, t1; float li0, li1, b0, b1;
        ml_gate_scan(gates, base, d, h, p->ml_b_i[l * 12 + d * 6 + h], p->ml_b_f[l * 12 + d * 6 + h], lane, t0, t1, li0, li1, b0, b1);
        const float g = __shfl(b1, 63);
        const float a0 = g - b0 + li0, a1 = g - b1 + li1;
        const float ml = wave_max(fmaxf(a0, a1));
        wsc[d * 128 + t0] = __expf(a0 - ml); wsc[d * 128 + t1] = __expf(a1 - ml);
        if (lane == 0) { const int sq = ((b * 6 + h) * 2 + d) * NCH + ml_pos(c, d); ((float*)(p->ws + WS_GSC))[sq] = g; ((float*)(p->ws + WS_MLS))[sq] = ml; } }
    stage_conv(T0, proj + (size_t)base * PLD + OFF_MK + h * 128, PLD, lo, hi, p->ml_conv_w + (size_t)l * 4608 + 768 + h * 128, p->ml_conv_b + l * 1536 + 768 + h * 128, QSCALE, tid,
               (u16*)(p->ws + WS_XN) + (size_t)base * 768 + h * 128);
    __syncthreads();
#pragma unroll
    for (int i = 0; i < 4; ++i) { const int id = tid + 512 * i, row = id >> 4, ch = id & 15; float v[8], y[8];
        unpack8(*(const u32x4*)(proj + (size_t)(base + row) * PLD + OFF_MV + h * 128 + ch * 8), v);
        const float w0 = wsc[row], w1 = wsc[128 + row];
#pragma unroll
        for (int e = 0; e < 8; ++e) y[e] = v[e] * w0;
        *(LAS u32x4*)(T1 + toff(row, ch)) = pack8(y);
#pragma unroll
        for (int e = 0; e < 8; ++e) y[e] = v[e] * w1;
        *(LAS u32x4*)(T2 + toff(row, ch)) = pack8(y); }
    __syncthreads();
    const int kb = 32 * (wid >> 1), vb = 64 * (wid & 1);
    u16* CST = (u16*)(p->ws + WS_CST);
#pragma unroll
    for (int d = 0; d < 2; ++d) {
        const LAS unsigned char* TV = d ? T2 : T1;
        f32x4 acc[2][4];
#pragma unroll
        for (int a = 0; a < 2; ++a)
#pragma unroll
            for (int bb = 0; bb < 4; ++bb) acc[a][bb] = (f32x4){0.f, 0.f, 0.f, 0.f};
#pragma unroll
        for (int ks = 0; ks < 4; ++ks) {
            bf16x8 af[2], bfg[4];
#pragma unroll
            for (int a = 0; a < 2; ++a) af[a] = frag_tr(T0, 32 * ks, kb + 16 * a, lane);
#pragma unroll
            for (int bb = 0; bb < 4; ++bb) bfg[bb] = frag_tr(TV, 32 * ks, vb + 16 * bb, lane);
#pragma unroll
            for (int a = 0; a < 2; ++a)
#pragma unroll
                for (int bb = 0; bb < 4; ++bb) acc[a][bb] = MFMA16(af[a], bfg[bb], acc[a][bb]);
        }
        u16* Cd = CST + ((size_t)(((b * 6 + h) * 2 + d) * NCH + ml_pos(c, d))) * 16384;
#pragma unroll
        for (int a = 0; a < 2; ++a)
#pragma unroll
            for (int bb = 0; bb < 4; ++bb) { const int v = vb + 16 * bb + fr, k0 = kb + 16 * a + 4 * fq;
                u32x2 o; o.x = pk2(acc[a][bb][0], acc[a][bb][1]); o.y = pk2(acc[a][bb][2], acc[a][bb][3]); *(u32x2*)(Cd + v * 128 + k0) = o; }
    }
    { const int d = tid >> 8, k2 = tid & 63, tq = (tid >> 6) & 3; float s0 = 0.f, s1 = 0.f;
#pragma unroll 8
        for (int t = 32 * tq; t < 32 * tq + 32; ++t) { const float w = wsc[d * 128 + t]; const unsigned kv = *(const LAS unsigned*)(T0 + toff(t, k2 >> 2) + 4 * (k2 & 3)); s0 += w * bf_lo(kv); s1 += w * bf_hi(kv); }
        LAS float* red = (LAS float*)(lds + SC_OFF + 2048);
        red[(d * 4 + tq) * 128 + 2 * k2] = s0; red[(d * 4 + tq) * 128 + 2 * k2 + 1] = s1;
        __syncthreads();
        if (tid < 256) { const int dd = tid >> 7, k = tid & 127; const float sum = (red[(dd * 4 + 0) * 128 + k] + red[(dd * 4 + 1) * 128 + k]) + (red[(dd * 4 + 2) * 128 + k] + red[(dd * 4 + 3) * 128 + k]);
            ((float*)(p->ws + WS_NST))[((size_t)(((b * 6 + h) * 2 + dd) * NCH + ml_pos(c, dd))) * 128 + k] = sum; } }
    __syncthreads();
}

DI void scan_item(KP p, int it) {
    const float* GSC = (const float*)(p->ws + WS_GSC); const float* MLS = (const float*)(p->ws + WS_MLS);
    const int gt = it * 512 + tid_l();
    if (gt < NSEQ * 4096) {
        const int sq = gt >> 12, e4 = gt & 4095;
        u16* base = (u16*)(p->ws + WS_CST) + (size_t)sq * NCH * 16384 + e4 * 4;
        float c0 = 0.f, c1 = 0.f, c2 = 0.f, c3 = 0.f, m = 0.f;
        for (int j0 = 0; j0 < NCH; j0 += 10) {
            u32x2 v[10]; float gj[10], mj[10];
#pragma unroll
            for (int u = 0; u < 10; ++u) { v[u] = *(const u32x2*)(base + (size_t)(j0 + u) * 16384); gj[u] = GSC[sq * NCH + j0 + u]; mj[u] = MLS[sq * NCH + j0 + u]; }
#pragma unroll
            for (int u = 0; u < 10; ++u) {
                u32x2 o; o.x = pk2(c0, c1); o.y = pk2(c2, c3); *(u32x2*)(base + (size_t)(j0 + u) * 16384) = o;
                const float mn = fmaxf(gj[u] + m, mj[u]), ao = __expf(gj[u] + m - mn), an = __expf(mj[u] - mn);
                c0 = ao * c0 + an * bf_lo(v[u].x); c1 = ao * c1 + an * bf_hi(v[u].x); c2 = ao * c2 + an * bf_lo(v[u].y); c3 = ao * c3 + an * bf_hi(v[u].y); m = mn; }
        }
    } else {
        const int r = gt - NSEQ * 4096, sq = r >> 7, k = r & 127;
        float* nb = (float*)(p->ws + WS_NST) + (size_t)sq * NCH * 128 + k; float* M0 = (float*)(p->ws + WS_M0);
        float n = 0.f, m = 0.f;
        for (int j = 0; j < NCH; ++j) { const float dn = nb[(size_t)j * 128], gj = GSC[sq * NCH + j], mj = MLS[sq * NCH + j];
            nb[(size_t)j * 128] = n; if (k == 0) M0[sq * NCH + j] = m;
            const float mn = fmaxf(gj + m, mj), ao = __expf(gj + m - mn), an = __expf(mj - mn); n = ao * n + an * dn; m = mn; }
    }
}

DI void ml3_item(KP p, int l, int it, LAS unsigned char* lds) {
    const int tid = tid_l(), lane = tid & 63, wid = tid >> 6, fr = lane & 15, fq = lane >> 4;
    int b, c, h, base, lo, hi; ml_item_geom(it, b, c, h, base, lo, hi);
    if (l == 1 && c < 2) return;
    const u16* proj = (const u16*)(p->ws + WS_R);
    const float* gates = (const float*)(p->ws + WS_GATES);
    u16* Y = (u16*)(p->ws + WS_Y);
    LAS unsigned char* T0 = lds; LAS unsigned char* T1 = lds + TILE_B; LAS unsigned char* T2 = lds + 2 * TILE_B; LAS unsigned char* T3 = T0;
    LAS float* sc_rt = (LAS float*)(lds + SC_OFF);
    LAS float* sc_ct = sc_rt + 256;
    LAS float* sc_in = sc_rt + 512;
    LAS float* sc_em = sc_rt + 768;
    LAS float* sc_n0 = sc_rt + 1024;
    const int srow = tid >> 4, sch = tid & 15;
    u32x4 c0a[4], c0b[4]; u32x2 mor[8];
    { const u16* ca = (const u16*)(p->ws + WS_CST) + (size_t)(((b * 6 + h) * 2 + 0) * NCH + ml_pos(c, 0)) * 16384 + srow * 128 + sch * 8;
      const u16* cb = (const u16*)(p->ws + WS_CST) + (size_t)(((b * 6 + h) * 2 + 1) * NCH + ml_pos(c, 1)) * 16384 + srow * 128 + sch * 8;
#pragma unroll
      for (int i = 0; i < 4; ++i) { c0a[i] = *(const u32x4*)(ca + i * 32 * 128); c0b[i] = *(const u32x4*)(cb + i * 32 * 128); }
      const u16* mo_ = proj + (size_t)(base + 16 * wid + fr) * PLD + OFF_MO + h * 128 + 4 * fq;
#pragma unroll
      for (int nd = 0; nd < 8; ++nd) mor[nd] = *(const u32x2*)(mo_ + 16 * nd); }
    if (wid < 2) { const int d = wid; int t0, t1; float li0, li1, b0, b1;
        ml_gate_scan(gates, base, d, h, p->ml_b_i[l * 12 + d * 6 + h], p->ml_b_f[l * 12 + d * 6 + h], lane, t0, t1, li0, li1, b0, b1);
        const int sq = ((b * 6 + h) * 2 + d) * NCH + ml_pos(c, d);
        const float m0 = ((const float*)(p->ws + WS_M0))[sq];
        const float ct0 = li0 - b0, ct1 = li1 - b1;
        float pm = fmaxf(ct0, ct1);
#pragma unroll
        for (int o = 1; o < 64; o <<= 1) { const float v = __shfl_up(pm, o); if (lane >= o) pm = fmaxf(pm, v); }
        float pe = __shfl_up(pm, 1); if (lane == 0) pe = -INFINITY;
        const float pm0 = fmaxf(pe, ct0), pm1 = pm;
        const float mt0 = fmaxf(b0 + m0, b0 + pm0), mt1 = fmaxf(b1 + m0, b1 + pm1);
        sc_rt[d * 128 + t0] = b0 - mt0; sc_rt[d * 128 + t1] = b1 - mt1;
        sc_ct[d * 128 + t0] = ct0; sc_ct[d * 128 + t1] = ct1;
        sc_in[d * 128 + t0] = __expf(b0 + m0 - mt0); sc_in[d * 128 + t1] = __expf(b1 + m0 - mt1);
        sc_em[d * 128 + t0] = __expf(-mt0); sc_em[d * 128 + t1] = __expf(-mt1);
        const float* n0 = (const float*)(p->ws + WS_NST) + (size_t)sq * 128;
        sc_n0[d * 128 + 2 * lane] = n0[2 * lane]; sc_n0[d * 128 + 2 * lane + 1] = n0[2 * lane + 1]; }
    stage_conv(T0, proj + (size_t)base * PLD + OFF_MQ + h * 128, PLD, lo, hi, p->ml_conv_w + (size_t)l * 4608 + h * 128, p->ml_conv_b + l * 1536 + h * 128, 1.f, tid);
    stage_plain(T1, (const u16*)(p->ws + WS_XN) + (size_t)base * 768 + h * 128, 768, tid);
    stage_plain(T2, proj + (size_t)base * PLD + OFF_MV + h * 128, PLD, tid);
    __syncthreads();
    const int t = 16 * wid + fr;
    bf16x8 Qf[4];
#pragma unroll
    for (int ks = 0; ks < 4; ++ks) Qf[ks] = frag_row(T0, 16 * wid, 32 * ks, lane);
    float nq[2] = {0.f, 0.f};
#pragma unroll
    for (int ks = 0; ks < 4; ++ks) { const u32x4 qv = __builtin_bit_cast(u32x4, Qf[ks]); float q[8]; unpack8(qv, q);
#pragma unroll
        for (int e = 0; e < 8; ++e) { const int k = 32 * ks + 8 * fq + e; nq[0] += q[e] * sc_n0[k]; nq[1] += q[e] * sc_n0[128 + k]; } }
#pragma unroll
    for (int d = 0; d < 2; ++d) { nq[d] += __shfl_xor(nq[d], 16); nq[d] += __shfl_xor(nq[d], 32); }
    f32x4 hs[8];
#pragma unroll
    for (int i = 0; i < 8; ++i) hs[i] = (f32x4){0.f, 0.f, 0.f, 0.f};
#pragma unroll 1
    for (int d = 0; d < 2; ++d) {
        const int sq = ((b * 6 + h) * 2 + d) * NCH + ml_pos(c, d);
        const float nqd = d ? nq[1] : nq[0];
        __syncthreads();
#pragma unroll
        for (int i = 0; i < 4; ++i) { const u32x4 v = d ? c0b[i] : c0a[i]; *(LAS u32x4*)(T3 + toff(srow + 32 * i, sch)) = v; }
        __syncthreads();
        const float rt = sc_rt[d * 128 + t], inter = sc_in[d * 128 + t], em = sc_em[d * 128 + t];
        f32x4 S[8]; float den = 0.f;
#pragma unroll
        for (int n = 0; n < 8; ++n) { S[n] = (f32x4){0.f, 0.f, 0.f, 0.f};
            const bool need = d ? (n >= wid) : (n <= wid);
            if (need) {
#pragma unroll
                for (int ks = 0; ks < 4; ++ks) S[n] = MFMA16(frag_row(T1, 16 * n, 32 * ks, lane), Qf[ks], S[n]);
#pragma unroll
                for (int j = 0; j < 4; ++j) { const int s = 16 * n + 4 * fq + j; const bool valid = d ? (s >= t) : (s <= t);
                    const float w = valid ? __expf(rt + sc_ct[d * 128 + s]) : 0.f; const float pv = S[n][j] * w; S[n][j] = pv; den += pv; }
            }
            __builtin_amdgcn_sched_barrier(0); }
        den += __shfl_xor(den, 16); den += __shfl_xor(den, 32);
        den += inter * nqd;
        bf16x8 Pf[4];
#pragma unroll
        for (int nn = 0; nn < 4; ++nn) { u32x4 o; o.x = pk2(S[2 * nn][0], S[2 * nn][1]); o.y = pk2(S[2 * nn][2], S[2 * nn][3]); o.z = pk2(S[2 * nn + 1][0], S[2 * nn + 1][1]); o.w = pk2(S[2 * nn + 1][2], S[2 * nn + 1][3]); Pf[nn] = __builtin_bit_cast(bf16x8, o); }
        const float inv = 1.f / fmaxf(fabsf(den), em);
#pragma unroll
        for (int nd = 0; nd < 8; ++nd) {
            f32x4 a1 = {0.f, 0.f, 0.f, 0.f}, a2 = {0.f, 0.f, 0.f, 0.f};
#pragma unroll
            for (int nn = 0; nn < 4; ++nn) a1 = MFMA16(frag_tr_perm(T2, 32 * nn, 16 * nd, lane), Pf[nn], a1);
#pragma unroll
            for (int ks = 0; ks < 4; ++ks) a2 = MFMA16(frag_row(T3, 16 * nd, 32 * ks, lane), Qf[ks], a2);
            hs[nd] += (a1 + a2 * inter) * inv;
            __builtin_amdgcn_sched_barrier(0);
        }
    }
    float ss = 0.f;
#pragma unroll
    for (int nd = 0; nd < 8; ++nd) ss += (hs[nd][0] * hs[nd][0] + hs[nd][1] * hs[nd][1]) + (hs[nd][2] * hs[nd][2] + hs[nd][3] * hs[nd][3]);
    ss += __shfl_xor(ss, 16); ss += __shfl_xor(ss, 32);
    const float rstd = rsqrtf(ss * (1.f / 128.f) + EPSN);
    const float* og = p->ml_out_gain + l * 768 + h * 128;
    u16* yr = Y + (size_t)(base + t) * DM + 1280 + h * 128;
    f32x4 gnr[8];
#pragma unroll
    for (int nd = 0; nd < 8; ++nd) gnr[nd] = *(const f32x4*)(og + 16 * nd + 4 * fq);
#pragma unroll
    for (int nd = 0; nd < 8; ++nd) { const int v0 = 16 * nd + 4 * fq; const u32x2 ov = mor[nd]; const f32x4 gn = gnr[nd];
        const float y0 = hs[nd][0] * rstd * gn[0] * sigmoidf_(bf_lo(ov.x)), y1 = hs[nd][1] * rstd * gn[1] * sigmoidf_(bf_hi(ov.x));
        const float y2 = hs[nd][2] * rstd * gn[2] * sigmoidf_(bf_lo(ov.y)), y3 = hs[nd][3] * rstd * gn[3] * sigmoidf_(bf_hi(ov.y));
        u32x2 o; o.x = pk2(y0, y1); o.y = pk2(y2, y3); *(u32x2*)(yr + v0) = o; }
    __syncthreads();
}

#define XB_TMO      128
#define XB_XCNT(j)  (256  + 64 * (j))
#define XB_XSUB(j)  (1280 + 64 * (j))
#define XB_XGEN(j)  (2304 + 64 * (j))
#define XB_TOP      3328
#define XB_TOPGEN   3392
#define XCD_BAR_WORDS 3456
#define XB_SPIN_CAP (1u << 18)

__device__ __forceinline__ unsigned xb_ld(unsigned* p)              { return __hip_atomic_load(p, __ATOMIC_RELAXED, __HIP_MEMORY_SCOPE_AGENT); }
__device__ __forceinline__ unsigned xb_add(unsigned* p, unsigned v) { return __hip_atomic_fetch_add(p, v, __ATOMIC_RELAXED, __HIP_MEMORY_SCOPE_AGENT); }
__device__ __forceinline__ unsigned xb_xcc_id() { return (unsigned)__builtin_amdgcn_s_getreg((3 << 11) | 20) & 0xFu; }
#define XB_SPIN(cond, bar) do { unsigned _sp = 0; while (cond) { __builtin_amdgcn_s_sleep(1); \
    if ((++_sp & 255u) == 0u) { if (xb_ld(&(bar)[XB_TMO])) break; if (_sp > XB_SPIN_CAP) { atomicAdd(&(bar)[XB_TMO], 1u); break; } } } } while (0)

struct XcdBarrier {
    unsigned* bar; unsigned x;
    volatile LAS unsigned* st;
};

__device__ __forceinline__ XcdBarrier xcd_barrier_post(unsigned* bar, volatile LAS unsigned* st) {
    XcdBarrier b; b.bar = bar; b.x = xb_xcc_id(); b.st = st;
    if (threadIdx.x == 0) (void)xb_add(&bar[XB_XCNT(b.x)], 1u);
    return b;
}
__device__ __forceinline__ void xcd_barrier_complete(unsigned* bar, unsigned x, unsigned& nloc, unsigned& nx) {
    const unsigned G = gridDim.x * gridDim.y * gridDim.z;
    unsigned sum, cnt, mine, sp = 0u;
    for (;;) {
        sum = 0u; cnt = 0u; mine = 0u;
#pragma unroll
        for (unsigned j = 0; j < 16; ++j) { const unsigned c = xb_ld(&bar[XB_XCNT(j)]); sum += c; cnt += (c > 0u) ? 1u : 0u; mine = (j == x) ? c : mine; }
        if (sum == G) break;
        __builtin_amdgcn_s_sleep(1);
        if ((++sp & 255u) == 0u) { if (xb_ld(&bar[XB_TMO])) break; if (sp > XB_SPIN_CAP) { atomicAdd(&bar[XB_TMO], 1u); break; } }
    }
    nloc = mine > 0u ? mine : 1u; nx = cnt > 0u ? cnt : 1u;
}

__device__ __forceinline__ void xcd_barrier(const XcdBarrier& b) {
    asm volatile("s_waitcnt vmcnt(0)" ::: "memory");
    __syncthreads();
    if (threadIdx.x == 0) {
        unsigned* bar = b.bar;
        __builtin_amdgcn_s_waitcnt(0);
        unsigned nloc = b.st[0], nx = b.st[1];
        if (nloc == 0u) { xcd_barrier_complete(bar, b.x, nloc, nx); b.st[0] = nloc; b.st[1] = nx; }
        const unsigned old = xb_add(&bar[XB_XSUB(b.x)], 1u);
        const unsigned gen = old / nloc;
        if (old + 1u == (gen + 1u) * nloc) {
            __builtin_amdgcn_fence(__ATOMIC_RELEASE, "agent");
            asm volatile("s_waitcnt vmcnt(0)" ::: "memory");
            const unsigned og = xb_add(&bar[XB_TOP], 1u);
            const unsigned tg = og / nx;
            if (og + 1u == (tg + 1u) * nx) xb_add(&bar[XB_TOPGEN], 1u);
            else XB_SPIN(xb_ld(&bar[XB_TOPGEN]) == tg, bar);
            __builtin_amdgcn_fence(__ATOMIC_ACQUIRE, "agent");
            xb_add(&bar[XB_XGEN(b.x)], 1u);
            asm volatile("s_waitcnt vmcnt(0)" ::: "memory");
        } else {
            XB_SPIN(xb_ld(&bar[XB_XGEN(b.x)]) == gen, bar);
            __builtin_amdgcn_fence(__ATOMIC_ACQUIRE, "agent");
            asm volatile("s_waitcnt vmcnt(0)" ::: "memory");
        }
    }
    __syncthreads();
}

constexpr int N_ATT = 1560, N_ML = 2 * NCH * 6  , N_GM = 260 * 4, N_SCAN = 198, N_ROPE = 260;

DI int next_item(unsigned* ctr, LAS unsigned char* lds) {
    LAS int* slot = (LAS int*)(lds + LDS_BYTES - 16);
    __syncthreads();
    if (threadIdx.x == 0) *slot = (int)atomicAdd(ctr, 1u);
    __syncthreads();
    return *slot;
}

__global__ void __launch_bounds__(512, 2) fwd_megakernel(Params p_unused) {
    const KP kp = (KP)__builtin_amdgcn_kernarg_segment_ptr();
#define PP launder(kp)
    extern __shared__ __attribute__((aligned(16))) unsigned char smem[];
    LAS unsigned char* lds = (LAS unsigned char*)smem;
    cg::grid_group grid = cg::this_grid();
    volatile LAS unsigned* xst = (volatile LAS unsigned*)(lds + LDS_BYTES - 32);
    if (threadIdx.x == 0) { xst[0] = 0u; xst[1] = 0u; }
    __syncthreads();
    { XcdBarrier b0 = xcd_barrier_post((unsigned*)(PP->ws + WS_BAR), xst); (void)b0; }
#define GSYNC() do { XcdBarrier b_; b_.bar = (unsigned*)(PP->ws + WS_BAR); b_.x = xb_xcc_id(); b_.st = xst; xcd_barrier(b_); } while (0)
    phase_prep(PP, lds);
    if (PP->ws == nullptr) grid.sync();
    GSYNC();
    phase_norm0(PP);
    phase_prep2(PP, lds);
    GSYNC();
    for (int l = 0; l < 2; ++l) {
        const int stage = l;
        const int Mres = l == 0 ? MROWS : RLAT;
        unsigned* ctr = (unsigned*)(PP->ws + WS_CTR) + l * 4;
        { EpiProj E; E.O = (u16*)(PP->ws + WS_R); E.gates = (float*)(PP->ws + WS_GATES);
          E.ss = (const float*)(PP->ws + WS_SS) + (l == 0 ? 3 : 1) * MROWS; E.bias0 = (const float*)(PP->ws + WS_BIASP) + (size_t)l * 3 * NPROJ;
          run_gemm(lds, (const u16*)(PP->ws + WS_XN), (const u16*)(PP->ws + WS_WIN + l * SZ_WIN), MROWS, PLD, DM, E); }
        for (;;) { const int it = next_item(ctr + 3, lds); if (it >= 260) break; gate_item(PP, l, it, lds); }
        GSYNC();
        for (;;) { const int it = next_item(ctr + 0, lds); if (it >= N_ROPE + N_ML) break; if (it < N_ROPE) rope_item(PP, it); else ml1_item(PP, l, it - N_ROPE, lds); }
        GSYNC();
        for (;;) { const int it = next_item(ctr + 1, lds); if (it >= N_SCAN + N_ATT + N_GM) break;
            if (it < N_SCAN) scan_item(PP, it);
            else if (it < N_SCAN + N_ATT) attn_item(PP, l, it - N_SCAN, lds);
            else gmlp_item(PP, l, it - N_SCAN - N_ATT, lds); }
        GSYNC();
        for (;;) { const int it = next_item(ctr + 2, lds); if (it >= N_ML) break; ml3_item(PP, l, it, lds); }
        GSYNC();
        { EpiRes E; E.p = PP; E.stage = stage; E.gate0 = (const float*)(PP->ws + WS_MOD) + (size_t)l * 3 * 12288 + 2 * DM;
          E.gs0 = (const float*)(PP->ws + WS_GS) + (size_t)(l * 2 + 1) * 3 * DM; E.ssn = (float*)(PP->ws + WS_SS) + (l == 0 ? 0 : 2) * MROWS; E.ntfull = DM / 64;
          run_gemm_split(lds, (const u16*)(PP->ws + WS_Y), (const u16*)(PP->ws + WS_WOUT + l * SZ_WOUT), RLAT, DM, DM, l == 0 ? 4 : 0, E); }
        GSYNC();
        if (l == 0) { phase_ctx_norm(PP, (const float*)(PP->ws + WS_GS) + (size_t)((0 * 2 + 1) * 3 + 2) * DM, (float*)(PP->ws + WS_SS) + 0 * MROWS, 4); GSYNC(); }
        { EpiSqRelu E; E.O = (u16*)(PP->ws + WS_R); E.ss = (const float*)(PP->ws + WS_SS) + (l == 0 ? 0 : 2) * MROWS; E.bias0 = (const float*)(PP->ws + WS_BIASF) + (size_t)l * 3 * DFF;
          run_gemm(lds, (const u16*)(PP->ws + WS_XN), (const u16*)(PP->ws + WS_WFF1 + l * SZ_WFF), Mres, DFF, DM, E); }
        GSYNC();
        { EpiRes E; E.p = PP; E.stage = 1; E.gate0 = (const float*)(PP->ws + WS_MOD) + (size_t)l * 3 * 12288 + 5 * DM;
          E.gs0 = l == 0 ? (const float*)(PP->ws + WS_GS) + (size_t)(1 * 2 + 0) * 3 * DM : nullptr; E.ssn = (float*)(PP->ws + WS_SS) + 1 * MROWS; E.ntfull = DFF / 64;
          run_gemm_split(lds, (const u16*)(PP->ws + WS_R), (const u16*)(PP->ws + WS_WFF2 + l * SZ_WFF), RLAT, DM, DFF, l == 0 ? 16 : 0, E); }
        GSYNC();
        if (l == 0) { phase_ctx_norm(PP, (const float*)(PP->ws + WS_GS) + (size_t)((1 * 2 + 0) * 3 + 2) * DM, (float*)(PP->ws + WS_SS) + 1 * MROWS, 16); GSYNC(); }
    }
    phase_final(PP);
#undef GSYNC
#undef PP
}

extern "C" void kernel_launch(void* const* d_in, const int* in_sizes, int n_in, void* d_out, int out_size, void* d_ws, size_t ws_size, hipStream_t stream) {
    static int grid_blocks = 0;
    if (grid_blocks == 0) {
        if (n_in != 22 || ws_size < WS_END || out_size != RLAT * DM) { fprintf(stderr, "kernel_launch: unexpected shapes (n_in %d ws %zu need %zu out %d)\n", n_in, ws_size, (size_t)WS_END, out_size); grid_blocks = -1; return; }
        int dev = 0, cus = 0, per_cu = 0;
        hipGetDevice(&dev);
        hipDeviceGetAttribute(&cus, hipDeviceAttributeMultiprocessorCount, dev);
        if (hipFuncSetAttribute((const void*)fwd_megakernel, hipFuncAttributeMaxDynamicSharedMemorySize, LDS_BYTES) != hipSuccess) { fprintf(stderr, "kernel_launch: hipFuncSetAttribute failed\n"); grid_blocks = -1; return; }
        hipOccupancyMaxActiveBlocksPerMultiprocessor(&per_cu, (const void*)fwd_megakernel, 512, LDS_BYTES);
        if (per_cu < 1) { fprintf(stderr, "kernel_launch: occupancy query says %d blocks per CU\n", per_cu); per_cu = 1; }
        (void)hipGetLastError();
        grid_blocks = cus * 1;
    }
    if (grid_blocks < 0) return;
    if (hipMemsetAsync((unsigned char*)d_ws + WS_BAR, 0, 16384, stream) != hipSuccess) { fprintf(stderr, "kernel_launch: memset failed\n"); return; }
    Params p{};
    const float** pp = (const float**)&p;
    for (int i = 0; i < 22; ++i) pp[i] = (const float*)d_in[i];
    p.out = (float*)d_out; p.ws = (unsigned char*)d_ws;
    void* args[] = {&p};
    hipError_t e = hipLaunchCooperativeKernel((const void*)fwd_megakernel, dim3(grid_blocks), dim3(512), args, LDS_BYTES, stream);
    if (e != hipSuccess) fprintf(stderr, "cooperative launch failed: %s (grid %d)\n", hipGetErrorString(e), grid_blocks);
}
```

```cpp
#include <hip/hip_runtime.h>
#include <hip/hip_cooperative_groups.h>
#include <cstdio>
namespace cg = cooperative_groups;
namespace pg8 {
#define PG8_LAS __attribute__((address_space(3)))
typedef unsigned short bf16_t;
typedef short bf16x8 __attribute__((ext_vector_type(8)));
typedef float f32x4 __attribute__((ext_vector_type(4)));
typedef unsigned u32x4 __attribute__((ext_vector_type(4)));
constexpr int BM = 256, BK = 64, HALF = 128, HTB = HALF * BK * 2  , STAGE_BYTES = 8 * HTB, NXCD = 8, WGM = 8;

__host__ __device__ __forceinline__ int lds_byte(int r, int c) { const int st = (r >> 4) * 2 + (c >> 5), rr = r & 15, cc = c & 31, ob = rr * 64 + cc * 2; return st * 1024 + (ob ^ (((ob >> 9) & 1) << 5)); }
__host__ __device__ __forceinline__ void stage_rc(int b, int& R, int& C) { const int st = b / 1024, sb = b % 1024, swz = sb ^ (((sb >> 9) & 1) << 5); R = (st >> 1) * 16 + swz / 64; C = (st & 1) * 32 + (swz % 64) / 2; }
__host__ __device__ __forceinline__ int perm32(int rho) { const int n = rho >> 4, i = rho & 15; return 8 * (i >> 2) + 4 * n + (i & 3); }

struct Unit { int pm, pn, koff, nt; };
struct Gemm { const bf16_t* A; const bf16_t* Bt; int M, N, K; };

struct StaticOrder {
    int nM, nN, nwg, G, c, ntf, wgm;
    __host__ __device__ void init(int M, int N, int K, int G_, int c_) { nM = M / BM; nN = N / BM; nwg = nM * nN; G = G_; c = c_; ntf = K / BK; wgm = WGM; }
    __host__ __device__ bool next(int i, Unit& u) const {
        const long L = (long)i * G + c; if (L >= nwg) return false;
        int wgid = (int)L; { const int q = nwg / NXCD, r = nwg % NXCD, xcd = wgid % NXCD, off = wgid / NXCD; wgid = (xcd < r ? xcd * (q + 1) : r * (q + 1) + (xcd - r) * q) + off; }
        const int nig = wgm * nN, gid = wgid / nig, fm = gid * wgm, gsz = (nM - fm) < wgm ? (nM - fm) : wgm;
        u.pm = fm + ((wgid % nig) % gsz); u.pn = (wgid % nig) / gsz; u.koff = 0; u.nt = ntf; return true;
    }
    __device__ __forceinline__ void a_ready(const Unit&) const {}
    __device__ __forceinline__ void done(const Unit&) const {}
};
template <class Epi, class Sched, bool STAMP = false>
__device__ __forceinline__ void gemm_phase(PG8_LAS unsigned char* lds, const Gemm g, const Sched& S, const Epi& E, unsigned long long* stamps) {
    int tid_ = threadIdx.x; asm volatile("" : "+v"(tid_)); const int tid = tid_, wid = __builtin_amdgcn_readfirstlane(tid >> 6), lane = tid & 63, wr = wid >> 2, wc = wid & 3, fr = lane & 15, fq = lane >> 4;
    const int K = g.K;
    int ts_lo = 0, ts_hi = 0, nts = 0; const unsigned long long rt_entry = STAMP ? (unsigned long long)wall_clock64() : 0ull;
#define PG8_STAMP() do { if (STAMP && wid == 0 && nts < 64) { const unsigned long long _c = (unsigned long long)clock64(); \
        ts_lo = (lane == nts) ? (int)(unsigned)_c : ts_lo; ts_hi = (lane == nts) ? (int)(unsigned)(_c >> 32) : ts_hi; ++nts; } } while (0)
    PG8_STAMP();
    unsigned voffA[2], voffB[2];
#pragma unroll
    for (int i = 0; i < 2; ++i) { int R, C; stage_rc(tid * 16 + i * 8192, R, C); const int Rb = Epi::PERM ? ((R & ~31) + perm32(R & 31)) : R;
        voffA[i] = (unsigned)(R * K + C) * 2u; voffB[i] = (unsigned)(Rb * K + C) * 2u; }
    const size_t kstep = (size_t)(BK * 2);
    const size_t hstep = (size_t)HALF * K * 2;
    const size_t tstep = 2 * hstep;
    const unsigned ldsw = (unsigned)wid * 1024u;
    const int aoff = lds_byte(wr * 64 + fr, fq * 8), boff = lds_byte(wc * 32 + fr, fq * 8);
#define PG8_SA(b, h) (((b) * 2 + (h)) * HTB)
#define PG8_SB(b, h) ((4 + (b) * 2 + (h)) * HTB)
#define PG8_STAGE(bufoff, gbase, voff) do { _Pragma("unroll") for (int _i = 0; _i < 2; ++_i) \
        __builtin_amdgcn_global_load_lds((const unsigned*)((const char*)(gbase) + (voff)[_i]), (PG8_LAS unsigned*)(lds + (bufoff) + ldsw + _i * 8192), 16, 0, 0); } while (0)
#define PG8_LDA(dst, b, h) do { _Pragma("unroll") for (int m = 0; m < 4; ++m) _Pragma("unroll") for (int k = 0; k < 2; ++k) dst[m][k] = *(const PG8_LAS bf16x8*)(lds + PG8_SA(b, h) + aoff + m * 2048 + k * 1024); } while (0)
#define PG8_LDB(dst, b, h) do { _Pragma("unroll") for (int n = 0; n < 2; ++n) _Pragma("unroll") for (int k = 0; k < 2; ++k) dst[n][k] = *(const PG8_LAS bf16x8*)(lds + PG8_SB(b, h) + boff + n * 2048 + k * 1024); } while (0)
#define PG8_MMA(ai, bj, At, Bt) do { __builtin_amdgcn_s_setprio(1); _Pragma("unroll") for (int m = 0; m < 4; ++m) _Pragma("unroll") for (int n = 0; n < 2; ++n) _Pragma("unroll") for (int k = 0; k < 2; ++k) \
        acc[ai][bj][m][n] = __builtin_amdgcn_mfma_f32_16x16x32_bf16(Bt[n][k], At[m][k], acc[ai][bj][m][n], 0, 0, 0); __builtin_amdgcn_s_setprio(0); } while (0)
#define PG8_WAIT_V(n) asm volatile("s_waitcnt vmcnt(" #n ")" ::: "memory")
#define PG8_WAIT_L(n) asm volatile("s_waitcnt lgkmcnt(" #n ")" ::: "memory")
#define PG8_BAR __builtin_amdgcn_s_barrier()
#define PG8_SCHED __builtin_amdgcn_sched_barrier(0)
    Unit cur, nxt; int ui = 0;
    if (!S.next(0, cur)) return;
    f32x4 acc[2][2][4][2];
#pragma unroll
    for (int a = 0; a < 2; ++a)
#pragma unroll
        for (int b = 0; b < 2; ++b)
#pragma unroll
            for (int m = 0; m < 4; ++m)
#pragma unroll
                for (int n = 0; n < 2; ++n) acc[a][b][m][n] = (f32x4){0.f, 0.f, 0.f, 0.f};
    bf16x8 At[4][2], B0[2][2], B1[2][2];
    const char* cA = (const char*)g.A + (size_t)cur.pm * tstep + (size_t)cur.koff * 2; const char* cB = (const char*)g.Bt + (size_t)cur.pn * tstep + (size_t)cur.koff * 2;
    S.a_ready(cur);
    PG8_STAGE(PG8_SB(0, 0), cB, voffB); PG8_STAGE(PG8_SA(0, 0), cA, voffA); PG8_STAGE(PG8_SB(0, 1), cB + hstep, voffB); PG8_STAGE(PG8_SA(0, 1), cA + hstep, voffA);
    if (wr == 1) PG8_BAR;
    PG8_WAIT_V(4); PG8_BAR;
    PG8_STAGE(PG8_SB(1, 0), cB + kstep, voffB); PG8_STAGE(PG8_SA(1, 0), cA + kstep, voffA); PG8_STAGE(PG8_SB(1, 1), cB + hstep + kstep, voffB);
    PG8_WAIT_V(6); PG8_BAR;
    PG8_STAMP();
    for (;;) {
        const bool has_next = S.next(ui + 1, nxt);
        const char* nA = has_next ? (const char*)g.A + (size_t)nxt.pm * tstep + (size_t)nxt.koff * 2 : cA; const char* nB = has_next ? (const char*)g.Bt + (size_t)nxt.pn * tstep + (size_t)nxt.koff * 2 : cB;
        const int nt = cur.nt;
        for (int t = 0; t < nt; t += 2) {
            const bool last = (t == nt - 2);
            const char* a1 = cA + (size_t)(t + 1) * kstep;
            const char* a2 = last ? nA : cA + (size_t)(t + 2) * kstep; const char* b2 = last ? nB : cB + (size_t)(t + 2) * kstep;
            const char* a3 = a2 + kstep; const char* b3 = b2 + kstep;
            if (last && has_next) S.a_ready(nxt);
            PG8_LDB(B0, 0, 0); PG8_SCHED; PG8_LDA(At, 0, 0); PG8_STAGE(PG8_SA(1, 1), a1 + hstep, voffA);
            PG8_WAIT_L(8); PG8_BAR; PG8_WAIT_L(0); PG8_MMA(0, 0, At, B0); PG8_BAR; PG8_SCHED;
            PG8_LDB(B1, 0, 1); PG8_STAGE(PG8_SB(0, 0), b2, voffB);
            PG8_BAR; PG8_WAIT_L(0); PG8_MMA(0, 1, At, B1); PG8_BAR;
            PG8_LDA(At, 0, 1); PG8_STAGE(PG8_SA(0, 0), a2, voffA);
            PG8_BAR; PG8_WAIT_L(0); PG8_MMA(1, 0, At, B0); PG8_BAR; PG8_SCHED;
            PG8_STAGE(PG8_SB(0, 1), b2 + hstep, voffB);
            PG8_WAIT_V(6); PG8_BAR; PG8_MMA(1, 1, At, B1); PG8_BAR;
            PG8_LDB(B0, 1, 0); PG8_SCHED; PG8_LDA(At, 1, 0); PG8_STAGE(PG8_SA(0, 1), a2 + hstep, voffA);
            PG8_WAIT_L(8); PG8_BAR; PG8_WAIT_L(0); PG8_MMA(0, 0, At, B0); PG8_BAR; PG8_SCHED;
            PG8_LDB(B1, 1, 1); PG8_STAGE(PG8_SB(1, 0), b3, voffB);
            PG8_BAR; PG8_WAIT_L(0); PG8_MMA(0, 1, At, B1); PG8_BAR;
            PG8_LDA(At, 1, 1); PG8_STAGE(PG8_SA(1, 0), a3, voffA);
            PG8_BAR; PG8_WAIT_L(0); PG8_MMA(1, 0, At, B0); PG8_BAR; PG8_SCHED;
            PG8_STAGE(PG8_SB(1, 1), b3 + hstep, voffB);
            PG8_WAIT_V(6); PG8_BAR; PG8_MMA(1, 1, At, B1); PG8_BAR;
        }
        PG8_STAMP();
        if constexpr (!Epi::AFTER_DRAIN) { E(acc, cur, wr, wc, fr, fq); S.done(cur); }
        PG8_STAMP();
        if (!has_next) break;
#pragma unroll
        for (int a = 0; a < 2; ++a)
#pragma unroll
            for (int b = 0; b < 2; ++b)
#pragma unroll
                for (int m = 0; m < 4; ++m)
#pragma unroll
                    for (int n = 0; n < 2; ++n) acc[a][b][m][n] = (f32x4){0.f, 0.f, 0.f, 0.f};
        cur = nxt; cA = nA; cB = nB; ++ui;
    }
    PG8_WAIT_V(0);
    if (wr == 0) PG8_BAR;
    PG8_BAR;
    if constexpr (Epi::AFTER_DRAIN) { E.fused(acc, cur, wr, wc, fr, fq, lds, wid, lane); S.done(cur); }
    PG8_STAMP();
    if (STAMP && wid == 0) { stamps[lane] = lane < nts ? (((unsigned long long)(unsigned)ts_hi << 32) | (unsigned)ts_lo) : 0ull;
        if (lane == 62) stamps[62] = rt_entry; if (lane == 63) stamps[63] = (unsigned long long)wall_clock64(); }
#undef PG8_STAMP
#undef PG8_SA
#undef PG8_SB
#undef PG8_STAGE
#undef PG8_LDA
#undef PG8_LDB
#undef PG8_MMA
#undef PG8_WAIT_V
#undef PG8_WAIT_L
#undef PG8_BAR
#undef PG8_SCHED
}
}

#define LAS __attribute__((address_space(3)))
typedef unsigned short u16;
typedef short s16x4 __attribute__((ext_vector_type(4)));
typedef unsigned u32x2 __attribute__((ext_vector_type(2)));
typedef __bf16 bf2_t __attribute__((ext_vector_type(2)));
typedef float f2_t __attribute__((ext_vector_type(2)));
using pg8::bf16x8; using pg8::f32x4; using pg8::u32x4;

constexpr int DM = 2048, SEQ = 16384, RLAT = 32768, LCTX = 256, MROWS = 33280, DFF = 8192;
constexpr int PLD = 5376, NPROJ = 5632, NIN = 5400;
constexpr int OFF_GU = 0, OFF_GV = 512, OFF_AQ = 1024, OFF_AK = 1792, OFF_AV = 2048, OFF_MQ = 2304, OFF_MK = 3072, OFF_MV = 3840, OFF_MO = 4608;
constexpr int NCH = 130;
constexpr int NSEQ = 24;
constexpr float EPSN = 1e-6f;
constexpr float LOG2E = 1.4426950408889634f;
constexpr float QSCALE = 0.08838834764831845f;

constexpr size_t WS_WIN = 0;
constexpr size_t SZ_WIN = (size_t)NPROJ * DM * 2;
constexpr size_t WS_WOUT = WS_WIN + 2 * SZ_WIN;
constexpr size_t SZ_WOUT = (size_t)DM * DM * 2;
constexpr size_t WS_WFF1 = WS_WOUT + 2 * SZ_WOUT;
constexpr size_t SZ_WFF = (size_t)DFF * DM * 2;
constexpr size_t WS_WFF2 = WS_WFF1 + 2 * SZ_WFF;
constexpr size_t WS_MOD = WS_WFF2 + 2 * SZ_WFF;
constexpr size_t WS_ROPE = WS_MOD + 2 * 3 * 12288 * 4;
constexpr size_t WS_XC = WS_ROPE + 320 * 32 * 8;
constexpr size_t WS_GATES = WS_XC + (size_t)512 * DM * 4;
constexpr size_t WS_NST = WS_GATES + (size_t)MROWS * 32 * 4;
constexpr size_t WS_GSC = WS_NST + (size_t)NSEQ * NCH * 128 * 4;
constexpr size_t WS_MLS = WS_GSC + 16384;
constexpr size_t WS_M0 = WS_MLS + 16384;
constexpr size_t WS_SS = WS_M0 + 16384;
constexpr size_t WS_BIASP = WS_SS + (size_t)4 * MROWS * 4;
constexpr size_t WS_BIASF = WS_BIASP + (size_t)2 * 3 * NPROJ * 4;
constexpr size_t WS_GS = WS_BIASF + (size_t)2 * 3 * DFF * 4;
constexpr size_t WS_CTR = WS_GS + (size_t)2 * 2 * 3 * DM * 4;
constexpr size_t WS_BAR = WS_CTR + 256;
constexpr size_t WS_XN = WS_BAR + 16384;
constexpr size_t WS_R = WS_XN + (size_t)MROWS * DM * 2;
constexpr size_t SZ_PROJ = (size_t)MROWS * PLD * 2;
constexpr size_t WS_Y = WS_R + SZ_PROJ;
constexpr size_t SZ_H = (size_t)MROWS * DFF * 2;
constexpr size_t WS_CST = WS_R + SZ_H;
constexpr size_t WS_END = WS_CST + (size_t)NSEQ * NCH * 16384 * 2;

constexpr int LDS_BYTES = 163840;
constexpr int TSTR = 320;
constexpr int TILE_B = 128 * TSTR;
constexpr int SC_OFF = 3 * TILE_B;

struct Params {
    const float *x, *c, *ctx, *c_ctx, *w_ada, *b_ada, *g_mix, *g_ffn, *w_in, *gm_v_gain, *gm_w_s, *gm_b_s, *attn_sink,
        *ml_conv_w, *ml_conv_b, *ml_b_i, *ml_b_f, *ml_out_gain, *w_out, *w_ff1, *w_ff2, *g_final;
    float* out; unsigned char* ws;
};

#define DI __device__ __forceinline__
typedef const __attribute__((address_space(4))) Params* KP;
DI int tid_l() { int t = threadIdx.x; asm volatile("" : "+v"(t)); return t; }
DI KP launder(KP p) { asm volatile("" : "+s"(p)); return p; }
DI unsigned pk2(float lo, float hi) { bf2_t v = __builtin_convertvector((f2_t){lo, hi}, bf2_t); return __builtin_bit_cast(unsigned, v); }
DI float bf_lo(unsigned u) { return __uint_as_float(u << 16); }
DI float bf_hi(unsigned u) { return __uint_as_float(u & 0xffff0000u); }
DI float wave_sum(float v) {
#pragma unroll
    for (int o = 1; o < 64; o <<= 1) v += __shfl_xor(v, o);
    return v;
}
DI float wave_max(float v) {
#pragma unroll
    for (int o = 1; o < 64; o <<= 1) v = fmaxf(v, __shfl_xor(v, o));
    return v;
}
DI float gelu_tanh(float x) {
    const float k1 = -2.f * 0.7978845608028654f * LOG2E, k2 = k1 * 0.044715f;
    const float a = x * __builtin_fmaf(x * x, k2, k1);
    return x * __builtin_amdgcn_rcpf(1.f + __builtin_amdgcn_exp2f(a));
}
DI float sigmoidf_(float x) { return __builtin_amdgcn_rcpf(1.f + __builtin_amdgcn_exp2f(-LOG2E * x)); }
DI float log_sigmoid(float x) { return fminf(x, 0.f) - log1pf(__expf(-fabsf(x))); }
DI void unpack8(const u32x4 v, float* f) { f[0] = bf_lo(v.x); f[1] = bf_hi(v.x); f[2] = bf_lo(v.y); f[3] = bf_hi(v.y); f[4] = bf_lo(v.z); f[5] = bf_hi(v.z); f[6] = bf_lo(v.w); f[7] = bf_hi(v.w); }
DI u32x4 pack8(const float* f) { u32x4 o; o.x = pk2(f[0], f[1]); o.y = pk2(f[2], f[3]); o.z = pk2(f[4], f[5]); o.w = pk2(f[6], f[7]); return o; }
#define MFMA16(a, b, c) __builtin_amdgcn_mfma_f32_16x16x32_bf16((a), (b), (c), 0, 0, 0)

DI int toff(int row, int ch) { return row * TSTR + 16 * ch; }
DI bf16x8 frag_row(const LAS unsigned char* tile, int idx0, int k0, int lane) {
    return *(const LAS bf16x8*)(tile + toff(idx0 + (lane & 15), (k0 >> 3) + (lane >> 4)));
}
DI bf16x8 tr_pair(const LAS unsigned char* p, const LAS unsigned char* p2) {
    s16x4 a = __builtin_amdgcn_ds_read_tr16_b64_v4i16((LAS s16x4*)p);
    s16x4 b = __builtin_amdgcn_ds_read_tr16_b64_v4i16((LAS s16x4*)p2);
    return (bf16x8){a[0], a[1], a[2], a[3], b[0], b[1], b[2], b[3]};
}
DI bf16x8 frag_tr(const LAS unsigned char* tile, int k0, int idx0, int lane) {
    const int i = lane & 15, q = lane >> 4, row = k0 + 8 * q + (i >> 2), ch = (idx0 >> 3) + ((i & 3) >> 1), sub = 8 * (i & 1);
    return tr_pair(tile + toff(row, ch) + sub, tile + toff(row + 4, ch) + sub);
}
DI bf16x8 frag_tr_perm(const LAS unsigned char* tile, int k0, int idx0, int lane) {
    const int i = lane & 15, q = lane >> 4, row = k0 + 4 * q + (i >> 2), ch = (idx0 >> 3) + ((i & 3) >> 1), sub = 8 * (i & 1);
    const LAS unsigned char* a = tile + toff(row, ch) + sub;
    return tr_pair(a, a + 16 * TSTR);
}

DI const float* xrow_in(KP p, int stage, int row) {
    if (row < RLAT) return (stage ? (const float*)p->out : p->x) + (size_t)row * DM;
    return (stage ? (const float*)(p->ws + WS_XC) : p->ctx) + (size_t)(row - RLAT) * DM;
}
DI float* xrow_out(KP p, int row) {
    if (row < RLAT) return p->out + (size_t)row * DM;
    return (float*)(p->ws + WS_XC) + (size_t)(row - RLAT) * DM;
}
DI int mod_index(int row) { return row < SEQ ? 0 : (row < RLAT ? 1 : 2); }
DI float row_rstd(const float* ss, int row) { return rsqrtf(ss[row] * (1.f / DM) + EPSN); }

DI void transpose_item(const float* W, int K, int N, u16* WT, LAS float* scr  , int item, int nblk, int lane) {
    const int kb = item / nblk, nb = item % nblk, k0 = 64 * kb, n0 = 64 * nb;
    const int c4 = lane & 15, rr = lane >> 4;
    const bool ok = n0 + 4 * c4 < N;
    f32x4 v[16];
#pragma unroll
    for (int i = 0; i < 16; ++i) v[i] = ok ? *(const f32x4*)(W + (size_t)(k0 + 4 * i + rr) * N + n0 + 4 * c4) : (f32x4){0.f, 0.f, 0.f, 0.f};
#pragma unroll
    for (int i = 0; i < 16; ++i) { LAS float* d = scr + (4 * i + rr) * 65 + 4 * c4; d[0] = v[i].x; d[1] = v[i].y; d[2] = v[i].z; d[3] = v[i].w; }
    asm volatile("s_waitcnt lgkmcnt(0)" ::: "memory"); __builtin_amdgcn_wave_barrier();
    const int c = lane & 7;
#pragma unroll
    for (int j = 0; j < 8; ++j) { const int nn = (lane >> 3) + 8 * j; const LAS float* q = scr + (8 * c) * 65 + nn;
        u32x4 o; o.x = pk2(q[0 * 65], q[1 * 65]); o.y = pk2(q[2 * 65], q[3 * 65]); o.z = pk2(q[4 * 65], q[5 * 65]); o.w = pk2(q[6 * 65], q[7 * 65]);
        *(u32x4*)(WT + (size_t)(n0 + nn) * K + k0 + 8 * c) = o; }
    asm volatile("s_waitcnt lgkmcnt(0)" ::: "memory"); __builtin_amdgcn_wave_barrier();
}

DI void phase_prep(KP p, LAS unsigned char* lds) {
    const int tid = tid_l(), lane = tid & 63, wave = tid >> 6, bid = blockIdx.x, G = gridDim.x;
    { float* SS = (float*)(p->ws + WS_SS);
      for (int i = bid * 512 + tid; i < 3 * MROWS; i += G * 512) SS[i] = 0.f;
      if (bid == 0 && tid < 64) ((unsigned*)(p->ws + WS_CTR))[tid] = 0u; }
    { const f32x4* src = (const f32x4*)p->ctx; f32x4* dst = (f32x4*)(p->ws + WS_XC);
      for (int i = bid * 512 + tid; i < 512 * DM / 4; i += G * 512) dst[i] = src[i]; }
    {
        LAS float* sv = (LAS float*)lds;
        LAS float* red = (LAS float*)(lds + 3 * 2048 * 4);
        for (int i = tid; i < 3 * 2048; i += 512) { const int v = i >> 11, k = i & 2047; const float x = v == 0 ? p->c[k] : (v == 1 ? p->c[2048 + k] : p->c_ctx[k]); sv[i] = x * sigmoidf_(x); }
        __syncthreads();
        float* MOD = (float*)(p->ws + WS_MOD);
        for (int it = bid; it < 2 * 384; it += G) {
            const int l = it / 384, n0 = (it % 384) * 32, j = tid & 7, kk = tid >> 3;
            const float* w = p->w_ada + (size_t)l * 2048 * 12288 + n0 + 4 * j;
            f32x4 a0 = {0, 0, 0, 0}, a1 = a0, a2 = a0;
#pragma unroll 16
            for (int k = kk; k < 2048; k += 64) { const f32x4 wv = *(const f32x4*)(w + (size_t)k * 12288); a0 += wv * sv[k]; a1 += wv * sv[2048 + k]; a2 += wv * sv[4096 + k]; }
            LAS float* r = red + (kk * 8 + j) * 12;
            *(LAS f32x4*)(r) = a0; *(LAS f32x4*)(r + 4) = a1; *(LAS f32x4*)(r + 8) = a2;
            __syncthreads();
            if (tid < 96) { const int v = tid >> 5, cc = tid & 31, jj = cc >> 2, e = cc & 3; float sum = 0.f;
                for (int q = 0; q < 64; ++q) sum += red[(q * 8 + jj) * 12 + v * 4 + e];
                MOD[(size_t)(l * 3 + v) * 12288 + n0 + cc] = sum + p->b_ada[l * 12288 + n0 + cc]; }
            __syncthreads();
        }
    }
    {
        f2_t* ROPE = (f2_t*)(p->ws + WS_ROPE);
        for (int i = bid * 512 + tid; i < 320 * 32; i += G * 512) { const int pos = i >> 5, f = i & 31; const int pa = pos < 256 ? pos : pos - 256;
            const float freq = 1.0f / powf(10000.0f, (float)(2 * f) / 64.0f); const float ang = (float)pa * freq; ROPE[i] = (f2_t){cosf(ang), sinf(ang)}; }
    }
    {
        LAS float* scr = (LAS float*)(lds + wave * 16640);
        const int gw = bid * 8 + wave, NGW = G * 8;
        constexpr int I_IN = 32 * 88, I_OUT = 32 * 32, I_F1 = 32 * 128, I_F2 = 128 * 32, I_L = I_IN + I_OUT + I_F1 + I_F2;
        for (int it = gw; it < 2 * I_L; it += NGW) {
            const int l = it / I_L; int r = it % I_L;
            if (r < I_IN) { transpose_item(p->w_in + (size_t)l * DM * NIN, DM, NIN, (u16*)(p->ws + WS_WIN + l * SZ_WIN), scr, r, 88, lane); continue; } r -= I_IN;
            if (r < I_OUT) { transpose_item(p->w_out + (size_t)l * DM * DM, DM, DM, (u16*)(p->ws + WS_WOUT + l * SZ_WOUT), scr, r, 32, lane); continue; } r -= I_OUT;
            if (r < I_F1) { transpose_item(p->w_ff1 + (size_t)l * DM * DFF, DM, DFF, (u16*)(p->ws + WS_WFF1 + l * SZ_WFF), scr, r, 128, lane); continue; } r -= I_F1;
            transpose_item(p->w_ff2 + (size_t)l * DFF * DM, DFF, DM, (u16*)(p->ws + WS_WFF2 + l * SZ_WFF), scr, r, 32, lane);
        }
    }
}

DI void phase_prep2(KP p, LAS unsigned char* lds) {
    const int tid = tid_l(), lane = tid & 63, wave = tid >> 6, bid = blockIdx.x, G = gridDim.x;
    const float* MOD = (const float*)(p->ws + WS_MOD);
    { float* GS = (float*)(p->ws + WS_GS);
      for (int i = bid * 512 + tid; i < 2 * 2 * 3 * DM; i += G * 512) { const int k = i & 2047, cls = (i >> 11) % 3, which = (i / (3 * DM)) & 1, l = i / (6 * DM);
          GS[i] = (which ? p->g_ffn : p->g_mix)[l * DM + k] * (1.f + MOD[(size_t)(l * 3 + cls) * 12288 + (which * 3 + 1) * DM + k]); } }
    LAS float* sh = (LAS float*)lds;
    const int gw = bid * 8 + wave, NGW = G * 8;
    for (int l = 0; l < 2; ++l) {
        __syncthreads();
        for (int i = tid; i < 6 * DM; i += 512) { const int k = i & 2047, cls = (i >> 11) % 3, which = i / (3 * DM); sh[i] = MOD[(size_t)(l * 3 + cls) * 12288 + (which * 3) * DM + k]; }
        __syncthreads();
        for (int r = gw; r < NPROJ + DFF; r += NGW) {
            const bool isf = r >= NPROJ; const int n = isf ? r - NPROJ : r;
            const u16* wrow = isf ? (const u16*)(p->ws + WS_WFF1 + l * SZ_WFF) + (size_t)n * DM : (const u16*)(p->ws + WS_WIN + l * SZ_WIN) + (size_t)n * DM;
            const LAS float* s0 = sh + (isf ? 3 * DM : 0);
            float a0 = 0.f, a1 = 0.f, a2 = 0.f;
#pragma unroll
            for (int j = 0; j < 4; ++j) { const int k = 8 * (lane + 64 * j); float w[8]; unpack8(*(const u32x4*)(wrow + k), w);
#pragma unroll
                for (int e = 0; e < 8; ++e) { a0 += w[e] * s0[k + e]; a1 += w[e] * s0[DM + k + e]; a2 += w[e] * s0[2 * DM + k + e]; } }
            a0 = wave_sum(a0); a1 = wave_sum(a1); a2 = wave_sum(a2);
            if (lane == 0) { float* B = isf ? (float*)(p->ws + WS_BIASF) + (size_t)l * 3 * DFF : (float*)(p->ws + WS_BIASP) + (size_t)l * 3 * NPROJ; const int N = isf ? DFF : NPROJ;
                B[n] = a0; B[N + n] = a1; B[2 * N + n] = a2; }
        }
    }
}

DI void phase_norm0(KP p) {
    const int tid = tid_l(), lane = tid & 63, gw = blockIdx.x * 8 + (tid >> 6), NGW = gridDim.x * 8;
    const float* gain = p->g_mix;
    u16* XN = (u16*)(p->ws + WS_XN);
    float* SS = (float*)(p->ws + WS_SS) + 3 * MROWS;
    f32x4 v[8], nx[8];
    if (gw < MROWS) { const float* xr = xrow_in(p, 0, gw);
#pragma unroll
        for (int j = 0; j < 8; ++j) v[j] = *(const f32x4*)(xr + 4 * lane + 256 * j); }
    for (int row = gw; row < MROWS; row += NGW) {
        const int nrow = row + NGW;
        if (nrow < MROWS) { const float* xr = xrow_in(p, 0, nrow);
#pragma unroll
            for (int j = 0; j < 8; ++j) nx[j] = *(const f32x4*)(xr + 4 * lane + 256 * j); }
        const float* md = (const float*)(p->ws + WS_MOD) + (size_t)mod_index(row) * 12288;
        float sum = 0.f;
#pragma unroll
        for (int j = 0; j < 8; ++j) sum += (v[j].x * v[j].x + v[j].y * v[j].y) + (v[j].z * v[j].z + v[j].w * v[j].w);
        sum = wave_sum(sum);
        if (lane == 0) SS[row] = sum;
#pragma unroll
        for (int j = 0; j < 8; ++j) { const int c = 4 * lane + 256 * j;
            const f32x4 g = *(const f32x4*)(gain + c), sc = *(const f32x4*)(md + DM + c);
            const f32x4 y = (v[j] * g) * (sc + 1.f);
            u32x2 o; o.x = pk2(y.x, y.y); o.y = pk2(y.z, y.w);
            *(u32x2*)(XN + (size_t)row * DM + c) = o; }
#pragma unroll
        for (int j = 0; j < 8; ++j) v[j] = nx[j];
    }
}
DI void phase_ctx_norm(KP p, const float* gs  , float* ss, int nsp) {
    const int tid = tid_l(), lane = tid & 63, gw = blockIdx.x * 8 + (tid >> 6), NGW = gridDim.x * 8;
    u16* XN = (u16*)(p->ws + WS_XN);
    for (int row = RLAT + gw; row < MROWS; row += NGW) {
        float* xr = (float*)(p->ws + WS_XC) + (size_t)(row - RLAT) * DM;
        const float* part = (const float*)(p->ws + WS_CST) + (size_t)(row - RLAT) * DM;
        f32x4 v[8]; float sum = 0.f;
#pragma unroll
        for (int j = 0; j < 8; ++j) v[j] = *(const f32x4*)(xr + 4 * lane + 256 * j);
        for (int ks = 0; ks < nsp; ++ks) {
#pragma unroll
            for (int j = 0; j < 8; ++j) v[j] += *(const f32x4*)(part + (size_t)ks * 512 * DM + 4 * lane + 256 * j); }
#pragma unroll
        for (int j = 0; j < 8; ++j) { *(f32x4*)(xr + 4 * lane + 256 * j) = v[j]; sum += (v[j].x * v[j].x + v[j].y * v[j].y) + (v[j].z * v[j].z + v[j].w * v[j].w); }
        sum = wave_sum(sum);
        if (lane == 0) ss[row] = sum;
#pragma unroll
        for (int j = 0; j < 8; ++j) { const int c = 4 * lane + 256 * j; const f32x4 y = v[j] * *(const f32x4*)(gs + c);
            u32x2 o; o.x = pk2(y.x, y.y); o.y = pk2(y.z, y.w); *(u32x2*)(XN + (size_t)row * DM + c) = o; }
    }
}
DI void phase_final(KP p) {
    const int tid = tid_l(), lane = tid & 63, gw = blockIdx.x * 8 + (tid >> 6), NGW = gridDim.x * 8;
    f32x4 v[8], nx[8];
    if (gw < RLAT) { const float* xr = p->out + (size_t)gw * DM;
#pragma unroll
        for (int j = 0; j < 8; ++j) v[j] = *(const f32x4*)(xr + 4 * lane + 256 * j); }
    for (int row = gw; row < RLAT; row += NGW) {
        const int nrow = row + NGW;
        if (nrow < RLAT) { const float* xn = p->out + (size_t)nrow * DM;
#pragma unroll
            for (int j = 0; j < 8; ++j) nx[j] = *(const f32x4*)(xn + 4 * lane + 256 * j); }
        float* xr = p->out + (size_t)row * DM;
        float sum = 0.f;
#pragma unroll
        for (int j = 0; j < 8; ++j) sum += (v[j].x * v[j].x + v[j].y * v[j].y) + (v[j].z * v[j].z + v[j].w * v[j].w);
        const float rstd = rsqrtf(wave_sum(sum) * (1.f / DM) + EPSN);
#pragma unroll
        for (int j = 0; j < 8; ++j) { const int c = 4 * lane + 256 * j; const f32x4 g = *(const f32x4*)(p->g_final + c); *(f32x4*)(xr + c) = v[j] * rstd * g; }
#pragma unroll
        for (int j = 0; j < 8; ++j) v[j] = nx[j];
    }
}

struct EpiProj {
    static constexpr bool PERM = true, AFTER_DRAIN = false;
    u16* O; float* gates; const float* ss; const float* bias0;
    __device__ __forceinline__ void operator()(const f32x4 (&acc)[2][2][4][2], const pg8::Unit& u, int wr, int wc, int fr, int fq) const {
        const int row0 = u.pm * 256 + wr * 64 + fr;
        const float* bias = bias0 + (size_t)mod_index(u.pm * 256) * NPROJ + u.pn * 256 + wc * 32 + 8 * fq;
        float rs[2][4];
#pragma unroll
        for (int ai = 0; ai < 2; ++ai)
#pragma unroll
            for (int m = 0; m < 4; ++m) rs[ai][m] = row_rstd(ss, row0 + ai * 128 + m * 16);
        {
            const int col0 = u.pn * 256 + wc * 32 + 8 * fq;
            f32x4 bb[2][2];
#pragma unroll
            for (int bj = 0; bj < 2; ++bj) { bb[bj][0] = *(const f32x4*)(bias + bj * 128); bb[bj][1] = *(const f32x4*)(bias + bj * 128 + 4); }
#pragma unroll
            for (int bj = 0; bj < 2; ++bj) { const f32x4 b0 = bb[bj][0], b1 = bb[bj][1];
#pragma unroll
                for (int ai = 0; ai < 2; ++ai)
#pragma unroll
                    for (int m = 0; m < 4; ++m) { const f32x4 v0 = acc[ai][bj][m][0] * rs[ai][m] + b0, v1 = acc[ai][bj][m][1] * rs[ai][m] + b1;
                        u32x4 o; o.x = pk2(v0[0], v0[1]); o.y = pk2(v0[2], v0[3]); o.z = pk2(v1[0], v1[1]); o.w = pk2(v1[2], v1[3]);
                        *(u32x4*)(O + (size_t)(row0 + ai * 128 + m * 16) * PLD + col0 + bj * 128) = o; } }
        }
    }
};
struct EpiRes {
    static constexpr bool PERM = false, AFTER_DRAIN = false;
    KP p; int stage; const float* gate0;
    const float* gs0; float* ssn;
    int ntfull;
    __device__ __forceinline__ void operator()(const f32x4 (&acc)[2][2][4][2], const pg8::Unit& u, int wr, int wc, int fr, int fq) const {
        const int row0 = u.pm * 256 + wr * 64 + fr, col0 = u.pn * 256 + wc * 32 + 4 * fq, cls = mod_index(u.pm * 256);
        const float* gate = gate0 + (size_t)cls * 12288 + col0;
        if (u.nt != ntfull) {
#pragma unroll
            for (int ai = 0; ai < 2; ++ai)
#pragma unroll
                for (int m = 0; m < 4; ++m) { float* xo = (float*)(p->ws + WS_CST) + ((size_t)(u.koff / 512) * 512 + (row0 + ai * 128 + m * 16 - RLAT)) * DM + col0;
#pragma unroll
                    for (int bj = 0; bj < 2; ++bj)
#pragma unroll
                        for (int n = 0; n < 2; ++n) { const int co = bj * 128 + n * 16; *(f32x4*)(xo + co) = *(const f32x4*)(gate + co) * acc[ai][bj][m][n]; } }
            return;
        }
        const float* gs = gs0 ? gs0 + cls * DM + col0 : nullptr;
        u16* XN = (u16*)(p->ws + WS_XN);
        f32x4 gt[2][2], gv[2][2];
#pragma unroll
        for (int bj = 0; bj < 2; ++bj)
#pragma unroll
            for (int n = 0; n < 2; ++n) { gt[bj][n] = *(const f32x4*)(gate + bj * 128 + n * 16); gv[bj][n] = gs ? *(const f32x4*)(gs + bj * 128 + n * 16) : (f32x4){0.f, 0.f, 0.f, 0.f}; }
#pragma unroll
        for (int am = 0; am < 4; ++am) {
            f32x4 xv[2][2][2];
#pragma unroll
            for (int h = 0; h < 2; ++h) { const int ai = am >> 1, m = (am & 1) * 2 + h; const float* xi = xrow_in(p, stage, row0 + ai * 128 + m * 16) + col0;
#pragma unroll
                for (int bj = 0; bj < 2; ++bj)
#pragma unroll
                    for (int n = 0; n < 2; ++n) xv[h][bj][n] = *(const f32x4*)(xi + bj * 128 + n * 16); }
#pragma unroll
            for (int h = 0; h < 2; ++h) { const int ai = am >> 1, m = (am & 1) * 2 + h; const int row = row0 + ai * 128 + m * 16; float* xo = xrow_out(p, row) + col0;
                float sq = 0.f;
#pragma unroll
                for (int bj = 0; bj < 2; ++bj)
#pragma unroll
                    for (int n = 0; n < 2; ++n) { const int co = bj * 128 + n * 16;
                        const f32x4 v = xv[h][bj][n] + gt[bj][n] * acc[ai][bj][m][n];
                        *(f32x4*)(xo + co) = v;
                        if (gs) { const f32x4 y = v * gv[bj][n]; u32x2 o; o.x = pk2(y.x, y.y); o.y = pk2(y.z, y.w);
                            *(u32x2*)(XN + (size_t)row * DM + col0 + co) = o; sq += (v.x * v.x + v.y * v.y) + (v.z * v.z + v.w * v.w); } }
                if (gs) { sq += __shfl_xor(sq, 16); sq += __shfl_xor(sq, 32); if (fq == 0) atomicAdd(ssn + row, sq); } }
        }
    }
};
struct EpiSqRelu {
    static constexpr bool PERM = true, AFTER_DRAIN = false;
    u16* O; const float* ss; const float* bias0;
    __device__ __forceinline__ void operator()(const f32x4 (&acc)[2][2][4][2], const pg8::Unit& u, int wr, int wc, int fr, int fq) const {
        const int row0 = u.pm * 256 + wr * 64 + fr, col0 = u.pn * 256 + wc * 32 + 8 * fq;
        const float* bias = bias0 + (size_t)mod_index(u.pm * 256) * DFF + col0;
        float rs[2][4];
#pragma unroll
        for (int ai = 0; ai < 2; ++ai)
#pragma unroll
            for (int m = 0; m < 4; ++m) rs[ai][m] = row_rstd(ss, row0 + ai * 128 + m * 16);
        f32x4 bb[2][2];
#pragma unroll
        for (int bj = 0; bj < 2; ++bj) { bb[bj][0] = *(const f32x4*)(bias + bj * 128); bb[bj][1] = *(const f32x4*)(bias + bj * 128 + 4); }
#pragma unroll
        for (int bj = 0; bj < 2; ++bj) { const f32x4 b0 = bb[bj][0], b1 = bb[bj][1];
#pragma unroll
            for (int ai = 0; ai < 2; ++ai)
#pragma unroll
                for (int m = 0; m < 4; ++m) { f32x4 v0 = acc[ai][bj][m][0] * rs[ai][m] + b0, v1 = acc[ai][bj][m][1] * rs[ai][m] + b1;
#pragma unroll
                    for (int e = 0; e < 4; ++e) { const float a = fmaxf(v0[e], 0.f), b = fmaxf(v1[e], 0.f); v0[e] = a * a; v1[e] = b * b; }
                    u32x4 o; o.x = pk2(v0[0], v0[1]); o.y = pk2(v0[2], v0[3]); o.z = pk2(v1[0], v1[1]); o.w = pk2(v1[2], v1[3]);
                    *(u32x4*)(O + (size_t)(row0 + ai * 128 + m * 16) * DFF + col0 + bj * 128) = o; } }
    }
};
template <class Epi> DI void run_gemm(LAS unsigned char* lds, const u16* A, const u16* Bt, int M, int N, int K, const Epi& E) {
    pg8::Gemm g; g.A = A; g.Bt = Bt; g.M = M; g.N = N; g.K = K;
    pg8::StaticOrder S; S.init(M, N, K, (int)gridDim.x, (int)blockIdx.x);
    pg8::gemm_phase<Epi, pg8::StaticOrder, false>(lds, g, S, E, nullptr);
}
struct SplitOrder : pg8::StaticOrder {
    int nsp, ksp, ntsp, pm0, nctx;
    __device__ __forceinline__ bool next(int i, pg8::Unit& u) const {
        const long L = (long)i * G + c;
        if (L < nwg) return pg8::StaticOrder::next(i, u);
        const int q = (int)(L - nwg); if (q >= nctx) return false;
        const int tile = q % (2 * nN), ks = q / (2 * nN);
        u.pm = pm0 + tile / nN; u.pn = tile % nN; u.koff = ks * ksp; u.nt = ntsp; return true;
    }
};
template <class Epi> DI void run_gemm_split(LAS unsigned char* lds, const u16* A, const u16* Bt, int Mlat, int N, int K, int nsp, const Epi& E) {
    pg8::Gemm g; g.A = A; g.Bt = Bt; g.M = Mlat; g.N = N; g.K = K;
    SplitOrder S; S.init(Mlat, N, K, (int)gridDim.x, (int)blockIdx.x);
    S.nsp = nsp; S.ksp = nsp ? K / nsp : K; S.ntsp = S.ksp / 64; S.pm0 = Mlat / 256; S.nctx = nsp ? 2 * (N / 256) * nsp : 0;
    S.wgm = 4;
    pg8::gemm_phase<Epi, SplitOrder, false>(lds, g, S, E, nullptr);
}


DI void stage_plain(LAS unsigned char* T, const u16* src, int ld, int tid) {
#pragma unroll
    for (int i = 0; i < 4; ++i) { const int id = tid + 512 * i, row = id >> 4, ch = id & 15;
        *(LAS u32x4*)(T + toff(row, ch)) = *(const u32x4*)(src + (size_t)row * ld + ch * 8); }
}
DI void stage_rope(LAS unsigned char* T, const u16* src, int ld, int pos0, float scale, const f2_t* ROPE, int tid) {
#pragma unroll
    for (int i = 0; i < 2; ++i) { const int task = tid + 512 * i, row = task >> 3, pp = task & 7, cq = pp & 3, half = pp >> 2, chA = half * 8 + cq;
        const int pos = pos0 + row, pa = half ? 256 + (pos & 63) : (pos >> 6);
        const u32x4 ra = *(const u32x4*)(src + (size_t)row * ld + chA * 8), rb = *(const u32x4*)(src + (size_t)row * ld + (chA + 4) * 8);
        float x1[8], x2[8], o1[8], o2[8]; unpack8(ra, x1); unpack8(rb, x2);
        const f2_t* tb = ROPE + pa * 32 + cq * 8;
#pragma unroll
        for (int e = 0; e < 8; ++e) { const f2_t cs = tb[e]; o1[e] = (x1[e] * cs.x - x2[e] * cs.y) * scale; o2[e] = (x1[e] * cs.y + x2[e] * cs.x) * scale; }
        *(LAS u32x4*)(T + toff(row, chA)) = pack8(o1); *(LAS u32x4*)(T + toff(row, chA + 4)) = pack8(o2); }
}
DI void stage_conv(LAS unsigned char* T, const u16* src, int ld, int lo, int hi, const float* cw  , const float* cb, float scale, int tid, u16* gdst = nullptr  ) {
    u32x4 pkk[4];
#pragma unroll
    for (int i = 0; i < 4; ++i) { const int id = tid + 512 * i, row = id >> 4, ch = id & 15;
        float xm[8], x0[8], xp[8], y[8];
        const u32x4 z = {0u, 0u, 0u, 0u};
        const bool okm = row - 1 >= lo, okp = row + 1 < hi;
        const u32x4 r0 = *(const u32x4*)(src + (size_t)row * ld + ch * 8);
        u32x4 rm = *(const u32x4*)(src + (ptrdiff_t)(okm ? row - 1 : row) * ld + ch * 8);
        u32x4 rp = *(const u32x4*)(src + (ptrdiff_t)(okp ? row + 1 : row) * ld + ch * 8);
        rm = okm ? rm : z; rp = okp ? rp : z;
        unpack8(rm, xm); unpack8(r0, x0); unpack8(rp, xp);
#pragma unroll
        for (int e = 0; e < 8; ++e) { const int c = ch * 8 + e; const float v = cb[c] + xm[e] * cw[c] + x0[e] * cw[1536 + c] + xp[e] * cw[3072 + c]; y[e] = v * sigmoidf_(v) * scale; }
        const u32x4 pk = pack8(y);
        *(LAS u32x4*)(T + toff(row, ch)) = pk; pkk[i] = pk; }
    if (gdst) {
#pragma unroll
        for (int i = 0; i < 4; ++i) { const int id = tid + 512 * i; *(u32x4*)(gdst + (size_t)(id >> 4) * 768 + (id & 15) * 8) = pkk[i]; } }
}

DI void gate_item(KP p, int l, int it, LAS unsigned char* lds) {
    const int tid = tid_l(), lane = tid & 63, wid = tid >> 6, fr = lane & 15, fq = lane >> 4;
    const int r0 = it * 128, srow = tid >> 4, sch = tid & 15;
    const u16* xa = (const u16*)(p->ws + WS_XN) + (size_t)(r0 + srow) * DM + sch * 8;
    const u16* wg = (const u16*)(p->ws + WS_WIN + l * SZ_WIN) + (size_t)(PLD + (tid >> 4)) * DM + sch * 8;
    LAS unsigned char* T0 = lds; LAS unsigned char* T1 = lds + TILE_B;
    u32x4 ar[4], wreg;
#pragma unroll
    for (int i = 0; i < 4; ++i) ar[i] = *(const u32x4*)(xa + (size_t)(32 * i) * DM);
    wreg = *(const u32x4*)wg;
    f32x4 acc0 = {0.f, 0.f, 0.f, 0.f}, acc1 = {0.f, 0.f, 0.f, 0.f};
    for (int kc = 0; kc < 16; ++kc) {
        __syncthreads();
#pragma unroll
        for (int i = 0; i < 4; ++i) *(LAS u32x4*)(T0 + toff(srow + 32 * i, sch)) = ar[i];
        *(LAS u32x4*)(T1 + toff(srow, sch)) = wreg;
        if (kc < 15) {
#pragma unroll
            for (int i = 0; i < 4; ++i) ar[i] = *(const u32x4*)(xa + (size_t)(32 * i) * DM + (kc + 1) * 128);
            wreg = *(const u32x4*)(wg + (kc + 1) * 128); }
        __syncthreads();
#pragma unroll
        for (int ks = 0; ks < 4; ++ks) { const bf16x8 xf = frag_row(T0, 16 * wid, 32 * ks, lane);
            acc0 = MFMA16(frag_row(T1, 0, 32 * ks, lane), xf, acc0); acc1 = MFMA16(frag_row(T1, 16, 32 * ks, lane), xf, acc1); }
    }
    const int row = r0 + 16 * wid + fr;
    const float rs = row_rstd((const float*)(p->ws + WS_SS) + (l == 0 ? 3 : 1) * MROWS, row);
    const float* bias = (const float*)(p->ws + WS_BIASP) + (size_t)(l * 3 + mod_index(row)) * NPROJ + PLD + 4 * fq;
    float* gp = (float*)(p->ws + WS_GATES) + (size_t)row * 32 + 4 * fq;
    *(f32x4*)gp = acc0 * rs + *(const f32x4*)bias; *(f32x4*)(gp + 16) = acc1 * rs + *(const f32x4*)(bias + 16);
    __syncthreads();
}

DI void gmlp_item(KP p, int l, int it, LAS unsigned char* lds) {
    const int tid = tid_l(), lane = tid & 63, wid = tid >> 6, fr = lane & 15, fq = lane >> 4;
    const int n = it >> 2, g = it & 3, r0 = n * 128;
    if (l == 1 && n >= 256) return;
    const u16* proj = (const u16*)(p->ws + WS_R);
    u16* Y = (u16*)(p->ws + WS_Y);
    LAS unsigned char* T0 = lds; LAS unsigned char* T1 = lds + TILE_B;
    u32x2 ur[2][4];
#pragma unroll
    for (int a = 0; a < 2; ++a)
#pragma unroll
        for (int b = 0; b < 4; ++b) ur[a][b] = *(const u32x2*)(proj + (size_t)(r0 + 64 * (wid & 1) + 16 * b + fr) * PLD + OFF_GU + g * 128 + 32 * (wid >> 1) + 16 * a + 4 * fq);
    { const float* ws = p->gm_w_s + (size_t)(l * 4 + g) * 16384;
#pragma unroll
      for (int i = 0; i < 8; ++i) { const int f = tid + 512 * i, row = f >> 5, c4 = f & 31; const f32x4 v = *(const f32x4*)(ws + (size_t)f * 4);
          u32x2 o; o.x = pk2(v.x, v.y); o.y = pk2(v.z, v.w); *(LAS u32x2*)(T0 + toff(row, c4 >> 1) + 8 * (c4 & 1)) = o; } }
    { const float* vg = p->gm_v_gain + l * 512 + g * 128;
#pragma unroll
      for (int i = 0; i < 4; ++i) { const int id = tid + 512 * i, row = id >> 4, ch = id & 15;
          float v[8]; unpack8(*(const u32x4*)(proj + (size_t)(r0 + row) * PLD + OFF_GV + g * 128 + ch * 8), v);
          float ss = 0.f;
#pragma unroll
          for (int e = 0; e < 8; ++e) { v[e] = gelu_tanh(v[e]); ss += v[e] * v[e]; }
          ss += __shfl_xor(ss, 1); ss += __shfl_xor(ss, 2); ss += __shfl_xor(ss, 4); ss += __shfl_xor(ss, 8);
          const float rstd = rsqrtf(ss * (1.f / 128.f) + EPSN);
#pragma unroll
          for (int e = 0; e < 8; ++e) v[e] = v[e] * rstd * vg[ch * 8 + e];
          *(LAS u32x4*)(T1 + toff(row, ch)) = pack8(v); } }
    __syncthreads();
    const int cb = 32 * (wid >> 1), pb = 64 * (wid & 1);
    f32x4 acc[2][4];
#pragma unroll
    for (int a = 0; a < 2; ++a)
#pragma unroll
        for (int b = 0; b < 4; ++b) acc[a][b] = (f32x4){0.f, 0.f, 0.f, 0.f};
#pragma unroll
    for (int ks = 0; ks < 4; ++ks) {
        bf16x8 af[2], bfg[4];
#pragma unroll
        for (int a = 0; a < 2; ++a) af[a] = frag_tr(T1, 32 * ks, cb + 16 * a, lane);
#pragma unroll
        for (int b = 0; b < 4; ++b) bfg[b] = frag_row(T0, pb + 16 * b, 32 * ks, lane);
#pragma unroll
        for (int a = 0; a < 2; ++a)
#pragma unroll
            for (int b = 0; b < 4; ++b) acc[a][b] = MFMA16(af[a], bfg[b], acc[a][b]);
    }
    const float* bs = p->gm_b_s + (l * 4 + g) * 128;
    float bsr[4];
#pragma unroll
    for (int b = 0; b < 4; ++b) bsr[b] = bs[pb + 16 * b + fr];
#pragma unroll
    for (int a = 0; a < 2; ++a)
#pragma unroll
        for (int b = 0; b < 4; ++b) { const int pp = pb + 16 * b + fr, c0 = cb + 16 * a + 4 * fq; const float bias = bsr[b];
            const u32x2 uu = ur[a][b];
            const float u0 = gelu_tanh(bf_lo(uu.x)), u1 = gelu_tanh(bf_hi(uu.x)), u2 = gelu_tanh(bf_lo(uu.y)), u3 = gelu_tanh(bf_hi(uu.y));
            u32x2 o; o.x = pk2(u0 * (acc[a][b][0] + bias), u1 * (acc[a][b][1] + bias)); o.y = pk2(u2 * (acc[a][b][2] + bias), u3 * (acc[a][b][3] + bias));
            *(u32x2*)(Y + (size_t)(r0 + pp) * DM + g * 128 + c0) = o; }
    __syncthreads();
}

DI void rope_item(KP p, int it) {
    const int tid = tid_l();
    u16* proj = (u16*)(p->ws + WS_R);
    const f2_t* ROPE = (const f2_t*)(p->ws + WS_ROPE);
    const float qs = QSCALE * LOG2E;
    const int row0 = it * 128;
    if (it < 256) {
        const int pos0 = (it & 127) * 128;
        for (int i0 = 0; i0 < 16; i0 += 4) {
            u32x4 ra[4], rb[4]; f2_t cs[4][8];
#pragma unroll
            for (int k = 0; k < 4; ++k) { const int task = tid + 512 * (i0 + k), hh = task >> 10, row = (task >> 3) & 127, pp = task & 7, cq = pp & 3, half = pp >> 2, chA = half * 8 + cq;
                const int pos = pos0 + row, pa = half ? 256 + (pos & 63) : (pos >> 6);
                const u16* src = proj + (size_t)(row0 + row) * PLD + OFF_AQ + hh * 128;
                ra[k] = *(const u32x4*)(src + chA * 8); rb[k] = *(const u32x4*)(src + (chA + 4) * 8);
                const f2_t* tb = ROPE + pa * 32 + cq * 8;
#pragma unroll
                for (int e = 0; e < 8; ++e) cs[k][e] = tb[e]; }
#pragma unroll
            for (int k = 0; k < 4; ++k) { const int task = tid + 512 * (i0 + k), hh = task >> 10, row = (task >> 3) & 127, pp = task & 7, cq = pp & 3, half = pp >> 2, chA = half * 8 + cq;
                u16* src = proj + (size_t)(row0 + row) * PLD + OFF_AQ + hh * 128;
                const float scale = hh < 6 ? qs : 1.f;
                float x1[8], x2[8], o1[8], o2[8]; unpack8(ra[k], x1); unpack8(rb[k], x2);
#pragma unroll
                for (int e = 0; e < 8; ++e) { o1[e] = (x1[e] * cs[k][e].x - x2[e] * cs[k][e].y) * scale; o2[e] = (x1[e] * cs[k][e].y + x2[e] * cs[k][e].x) * scale; }
                *(u32x4*)(src + chA * 8) = pack8(o1); *(u32x4*)(src + (chA + 4) * 8) = pack8(o2); }
        }
    } else {
#pragma unroll 2
        for (int i = 0; i < 24; ++i) { const int id = tid + 512 * i, row = id / 96, ch = id % 96; float v[8];
            u16* src = proj + (size_t)(row0 + row) * PLD + OFF_AQ + ch * 8;
            unpack8(*(const u32x4*)src, v);
#pragma unroll
            for (int e = 0; e < 8; ++e) v[e] *= qs;
            *(u32x4*)src = pack8(v); }
    }
}

DI void attn_tile(int kt, bool isctx, int b, int nb, bool& valid, int& krow0, int& jloc) {
    jloc = 0; valid = true;
    if (kt < 2) { krow0 = RLAT + b * LCTX + kt * 128; return; }
    jloc = kt - 3; const int kb = nb + jloc; krow0 = b * SEQ + kb * 128;
    valid = !isctx && kb >= 0 && kb <= 127 && kt < 5;
    if (!valid) krow0 = 0;
}
DI void attn_item(KP p, int l, int it, LAS unsigned char* lds) {
    const int tid = tid_l(), lane = tid & 63, wid = tid >> 6, fr = lane & 15, fq = lane >> 4;
    const u16* proj = (const u16*)(p->ws + WS_R);
    u16* Y = (u16*)(p->ws + WS_Y);
    LAS unsigned char* T0 = lds; LAS unsigned char* T1 = lds + TILE_B; LAS unsigned char* T2 = lds + 2 * TILE_B;
    int b, nb, hq, qrow0; bool isctx;
    if (it < 1536) { hq = it % 6; nb = (it / 6) & 127; b = it / 768; qrow0 = b * SEQ + nb * 128; isctx = false; }
    else { if (l == 1) return; const int r = it - 1536; hq = r % 6; const int cbk = (r / 6) & 1; b = r / 12; nb = 0; qrow0 = RLAT + b * LCTX + cbk * 128; isctx = true; }
    const int kvh = hq / 3;
    const int srow = tid >> 4, sch = tid & 15;
    u32x4 kr[4], vr[4];
    { const u16* ks = proj + (size_t)(RLAT + b * LCTX) * PLD + OFF_AK + kvh * 128 + sch * 8; const u16* vs = proj + (size_t)(RLAT + b * LCTX) * PLD + OFF_AV + kvh * 128 + sch * 8;
#pragma unroll
      for (int i = 0; i < 4; ++i) { kr[i] = *(const u32x4*)(ks + (size_t)(srow + 32 * i) * PLD); vr[i] = *(const u32x4*)(vs + (size_t)(srow + 32 * i) * PLD); } }
    stage_plain(T0, proj + (size_t)qrow0 * PLD + OFF_AQ + hq * 128, PLD, tid);
    __syncthreads();
    bf16x8 Qf[4];
#pragma unroll
    for (int ks = 0; ks < 4; ++ks) Qf[ks] = frag_row(T0, 16 * wid, 32 * ks, lane);
    float m = p->attn_sink[l * 6 + hq] * LOG2E, lsum = 1.f;
    f32x4 O[8];
#pragma unroll
    for (int i = 0; i < 8; ++i) O[i] = (f32x4){0.f, 0.f, 0.f, 0.f};
    const int rin = 16 * wid + fr;
    for (int kt = 0; kt < 5; ++kt) {
        bool valid; int krow0, jloc; attn_tile(kt, isctx, b, nb, valid, krow0, jloc);
        if (!valid) continue;
        __syncthreads();
#pragma unroll
        for (int i = 0; i < 4; ++i) { *(LAS u32x4*)(T1 + toff(srow + 32 * i, sch)) = kr[i]; *(LAS u32x4*)(T2 + toff(srow + 32 * i, sch)) = vr[i]; }
        {
          int kn = kt + 1; bool vn; int rn, jn; attn_tile(kn, isctx, b, nb, vn, rn, jn);
          if (!vn && kn < 4) { ++kn; attn_tile(kn, isctx, b, nb, vn, rn, jn); }
          if (vn) { const u16* ks = proj + (size_t)rn * PLD + OFF_AK + kvh * 128 + sch * 8; const u16* vs = proj + (size_t)rn * PLD + OFF_AV + kvh * 128 + sch * 8;
#pragma unroll
              for (int i = 0; i < 4; ++i) { kr[i] = *(const u32x4*)(ks + (size_t)(srow + 32 * i) * PLD); vr[i] = *(const u32x4*)(vs + (size_t)(srow + 32 * i) * PLD); } } }
        __syncthreads();
        const bool local = kt >= 2;
        f32x4 S[8];
#pragma unroll
        for (int n = 0; n < 8; ++n) S[n] = (f32x4){0.f, 0.f, 0.f, 0.f};
        {
            bf16x8 kf[2][8];
#pragma unroll
            for (int n = 0; n < 8; ++n) kf[0][n] = frag_row(T1, 16 * n, 0, lane);
#pragma unroll
            for (int ks = 0; ks < 4; ++ks) {
                if (ks < 3) {
#pragma unroll
                    for (int n = 0; n < 8; ++n) kf[(ks + 1) & 1][n] = frag_row(T1, 16 * n, 32 * (ks + 1), lane);
                }
#pragma unroll
                for (int n = 0; n < 8; ++n) S[n] = MFMA16(kf[ks & 1][n], Qf[ks], S[n]);
            }
        }
        if (local && jloc != 0) {
#pragma unroll
            for (int n = 0; n < 8; ++n)
#pragma unroll
                for (int j = 0; j < 4; ++j) { const int dk = 16 * n + 4 * fq + j - rin; const bool keep = jloc < 0 ? dk >= 0 : dk <= 0; S[n][j] = keep ? S[n][j] : -INFINITY; }
        }
        float mx = -INFINITY;
#pragma unroll
        for (int n = 0; n < 8; ++n) mx = fmaxf(fmaxf(mx, fmaxf(S[n][0], S[n][1])), fmaxf(S[n][2], S[n][3]));
        mx = fmaxf(mx, __shfl_xor(mx, 16)); mx = fmaxf(mx, __shfl_xor(mx, 32));
        const float mnew = fmaxf(m, mx), alpha = __builtin_amdgcn_exp2f(m - mnew);
        float rs = 0.f;
#pragma unroll
        for (int n = 0; n < 8; ++n)
#pragma unroll
            for (int j = 0; j < 4; ++j) { const float e = __builtin_amdgcn_exp2f(S[n][j] - mnew); S[n][j] = e; rs += e; }
        rs += __shfl_xor(rs, 16); rs += __shfl_xor(rs, 32);
        lsum = lsum * alpha + rs; m = mnew;
#pragma unroll
        for (int i = 0; i < 8; ++i) O[i] *= alpha;
        bf16x8 Pf[4];
#pragma unroll
        for (int nn = 0; nn < 4; ++nn) { u32x4 o; o.x = pk2(S[2 * nn][0], S[2 * nn][1]); o.y = pk2(S[2 * nn][2], S[2 * nn][3]); o.z = pk2(S[2 * nn + 1][0], S[2 * nn + 1][1]); o.w = pk2(S[2 * nn + 1][2], S[2 * nn + 1][3]); Pf[nn] = __builtin_bit_cast(bf16x8, o); }
        {
            bf16x8 vf[2][8];
#pragma unroll
            for (int nd = 0; nd < 8; ++nd) vf[0][nd] = frag_tr_perm(T2, 0, 16 * nd, lane);
#pragma unroll
            for (int nn = 0; nn < 4; ++nn) {
                if (nn < 3) {
#pragma unroll
                    for (int nd = 0; nd < 8; ++nd) vf[(nn + 1) & 1][nd] = frag_tr_perm(T2, 32 * (nn + 1), 16 * nd, lane);
                }
#pragma unroll
                for (int nd = 0; nd < 8; ++nd) O[nd] = MFMA16(vf[nn & 1][nd], Pf[nn], O[nd]);
            }
        }
    }
    const float inv = __builtin_amdgcn_rcpf(lsum);
    u16* yr = Y + (size_t)(qrow0 + rin) * DM + 512 + hq * 128 + 4 * fq;
#pragma unroll
    for (int nd = 0; nd < 8; ++nd) { u32x2 o; o.x = pk2(O[nd][0] * inv, O[nd][1] * inv); o.y = pk2(O[nd][2] * inv, O[nd][3] * inv); *(u32x2*)(yr + 16 * nd) = o; }
    __syncthreads();
}

DI void ml_item_geom(int it, int& b, int& c, int& h, int& base, int& lo, int& hi) {
    h = it % 6; c = (it / 6) % NCH; b = it / (6 * NCH);
    if (c < 2) { base = RLAT + b * LCTX + c * 128; lo = -c * 128; hi = LCTX - c * 128; }
    else { base = b * SEQ + (c - 2) * 128; lo = -(c - 2) * 128; hi = SEQ - (c - 2) * 128; }
}
DI int ml_pos(int c, int d) { return d == 0 ? c : (c < 2 ? 1 - c : 131 - c); }
DI void ml_gate_scan(const float* gates, int base, int d, int h, float bi, float bff, int lane, int& t0, int& t1, float& li0, float& li1, float& b0, float& b1) {
    t0 = d ? 127 - 2 * lane : 2 * lane; t1 = d ? t0 - 1 : t0 + 1;
    const float* g0 = gates + (size_t)(base + t0) * 32 + d * 12 + h; const float* g1 = gates + (size_t)(base + t1) * 32 + d * 12 + h;
    li0 = g0[0] + bi; li1 = g1[0] + bi;
    const float lf0 = log_sigmoid(g0[6] + bff), lf1 = log_sigmoid(g1[6] + bff);
    float s = lf0 + lf1;
#pragma unroll
    for (int o = 1; o < 64; o <<= 1) { const float v = __shfl_up(s, o); if (lane >= o) s += v; }
    b1 = s; b0 = s - lf1;
}

DI void ml1_item(KP p, int l, int it, LAS unsigned char* lds) {
    const int tid = tid_l(), lane = tid & 63, wid = tid >> 6, fr = lane & 15, fq = lane >> 4;
    int b, c, h, base, lo, hi; ml_item_geom(it, b, c, h, base, lo, hi);
    const u16* proj = (const u16*)(p->ws + WS_R);
    const float* gates = (const float*)(p->ws + WS_GATES);
    LAS unsigned char* T0 = lds; LAS unsigned char* T1 = lds + TILE_B; LAS unsigned char* T2 = lds + 2 * TILE_B;
    LAS float* wsc = (LAS float*)(lds + SC_OFF);
    float g_keep = 0.f, ml_keep = 0.f;
    if (wid < 2) { const int d = wid; int t0, t1; float li0, li1, b0, b1;
        ml_gate_scan(gates, base, d, h, p->ml_b_i[l * 12 + d * 6 + h], p->ml_b_f[l * 12 + d * 6 + h], lane, t0, t1, li0, li1, b0, b1);
        const float g = __shfl(b1, 63);
        const float a0 = g - b0 + li0, a1 = g - b1 + li1;
        const float ml = wave_max(fmaxf(a0, a1));
        wsc[d * 128 + t0] = __expf(a0 - ml); wsc[d * 128 + t1] = __expf(a1 - ml);
        g_keep = g; ml_keep = ml; }
    stage_conv(T0, proj + (size_t)base * PLD + OFF_MK + h * 128, PLD, lo, hi, p->ml_conv_w + (size_t)l * 4608 + 768 + h * 128, p->ml_conv_b + l * 1536 + 768 + h * 128, QSCALE, tid,
               (u16*)(p->ws + WS_XN) + (size_t)base * 768 + h * 128);
    if (wid < 2 && lane == 0) { const int sq = ((b * 6 + h) * 2 + wid) * NCH + ml_pos(c, wid); ((float*)(p->ws + WS_GSC))[sq] = g_keep; ((float*)(p->ws + WS_MLS))[sq] = ml_keep; }
    __syncthreads();
#pragma unroll
    for (int i = 0; i < 4; ++i) { const int id = tid + 512 * i, row = id >> 4, ch = id & 15; float v[8], y[8];
        unpack8(*(const u32x4*)(proj + (size_t)(base + row) * PLD + OFF_MV + h * 128 + ch * 8), v);
        const float w0 = wsc[row], w1 = wsc[128 + row];
#pragma unroll
        for (int e = 0; e < 8; ++e) y[e] = v[e] * w0;
        *(LAS u32x4*)(T1 + toff(row, ch)) = pack8(y);
#pragma unroll
        for (int e = 0; e < 8; ++e) y[e] = v[e] * w1;
        *(LAS u32x4*)(T2 + toff(row, ch)) = pack8(y); }
    __syncthreads();
    const int kb = 32 * (wid >> 1), vb = 64 * (wid & 1);
    u16* CST = (u16*)(p->ws + WS_CST);
#pragma unroll
    for (int d = 0; d < 2; ++d) {
        const LAS unsigned char* TV = d ? T2 : T1;
        f32x4 acc[2][4];
#pragma unroll
        for (int a = 0; a < 2; ++a)
#pragma unroll
            for (int bb = 0; bb < 4; ++bb) acc[a][bb] = (f32x4){0.f, 0.f, 0.f, 0.f};
#pragma unroll
        for (int ks = 0; ks < 4; ++ks) {
            bf16x8 af[2], bfg[4];
#pragma unroll
            for (int a = 0; a < 2; ++a) af[a] = frag_tr(T0, 32 * ks, kb + 16 * a, lane);
#pragma unroll
            for (int bb = 0; bb < 4; ++bb) bfg[bb] = frag_tr(TV, 32 * ks, vb + 16 * bb, lane);
#pragma unroll
            for (int a = 0; a < 2; ++a)
#pragma unroll
                for (int bb = 0; bb < 4; ++bb) acc[a][bb] = MFMA16(af[a], bfg[bb], acc[a][bb]);
        }
        u16* Cd = CST + ((size_t)(((b * 6 + h) * 2 + d) * NCH + ml_pos(c, d))) * 16384;
#pragma unroll
        for (int a = 0; a < 2; ++a)
#pragma unroll
            for (int bb = 0; bb < 4; ++bb) { const int v = vb + 16 * bb + fr, k0 = kb + 16 * a + 4 * fq;
                u32x2 o; o.x = pk2(acc[a][bb][0], acc[a][bb][1]); o.y = pk2(acc[a][bb][2], acc[a][bb][3]); *(u32x2*)(Cd + v * 128 + k0) = o; }
    }
    { const int d = tid >> 8, k2 = tid & 63, tq = (tid >> 6) & 3; float s0 = 0.f, s1 = 0.f;
#pragma unroll 8
        for (int t = 32 * tq; t < 32 * tq + 32; ++t) { const float w = wsc[d * 128 + t]; const unsigned kv = *(const LAS unsigned*)(T0 + toff(t, k2 >> 2) + 4 * (k2 & 3)); s0 += w * bf_lo(kv); s1 += w * bf_hi(kv); }
        LAS float* red = (LAS float*)(lds + SC_OFF + 2048);
        red[(d * 4 + tq) * 128 + 2 * k2] = s0; red[(d * 4 + tq) * 128 + 2 * k2 + 1] = s1;
        __syncthreads();
        if (tid < 256) { const int dd = tid >> 7, k = tid & 127; const float sum = (red[(dd * 4 + 0) * 128 + k] + red[(dd * 4 + 1) * 128 + k]) + (red[(dd * 4 + 2) * 128 + k] + red[(dd * 4 + 3) * 128 + k]);
            ((float*)(p->ws + WS_NST))[((size_t)(((b * 6 + h) * 2 + dd) * NCH + ml_pos(c, dd))) * 128 + k] = sum; } }
    __syncthreads();
}

DI void scan_item(KP p, int it) {
    const float* GSC = (const float*)(p->ws + WS_GSC); const float* MLS = (const float*)(p->ws + WS_MLS);
    const int gt = it * 512 + tid_l();
    if (gt < NSEQ * 4096) {
        const int sq = gt >> 12, e4 = gt & 4095;
        u16* base = (u16*)(p->ws + WS_CST) + (size_t)sq * NCH * 16384 + e4 * 4;
        float c0 = 0.f, c1 = 0.f, c2 = 0.f, c3 = 0.f, m = 0.f;
        for (int j0 = 0; j0 < NCH; j0 += 10) {
            u32x2 v[10]; float gj[10], mj[10];
#pragma unroll
            for (int u = 0; u < 10; ++u) { v[u] = *(const u32x2*)(base + (size_t)(j0 + u) * 16384); gj[u] = GSC[sq * NCH + j0 + u]; mj[u] = MLS[sq * NCH + j0 + u]; }
#pragma unroll
            for (int u = 0; u < 10; ++u) {
                u32x2 o; o.x = pk2(c0, c1); o.y = pk2(c2, c3); *(u32x2*)(base + (size_t)(j0 + u) * 16384) = o;
                const float mn = fmaxf(gj[u] + m, mj[u]), ao = __expf(gj[u] + m - mn), an = __expf(mj[u] - mn);
                c0 = ao * c0 + an * bf_lo(v[u].x); c1 = ao * c1 + an * bf_hi(v[u].x); c2 = ao * c2 + an * bf_lo(v[u].y); c3 = ao * c3 + an * bf_hi(v[u].y); m = mn; }
        }
    } else {
        const int r = gt - NSEQ * 4096, sq = r >> 7, k = r & 127;
        float* nb = (float*)(p->ws + WS_NST) + (size_t)sq * NCH * 128 + k; float* M0 = (float*)(p->ws + WS_M0);
        float n = 0.f, m = 0.f;
        for (int j = 0; j < NCH; ++j) { const float dn = nb[(size_t)j * 128], gj = GSC[sq * NCH + j], mj = MLS[sq * NCH + j];
            nb[(size_t)j * 128] = n; if (k == 0) M0[sq * NCH + j] = m;
            const float mn = fmaxf(gj + m, mj), ao = __expf(gj + m - mn), an = __expf(mj - mn); n = ao * n + an * dn; m = mn; }
    }
}

DI void ml3_item(KP p, int l, int it, LAS unsigned char* lds) {
    const int tid = tid_l(), lane = tid & 63, wid = tid >> 6, fr = lane & 15, fq = lane >> 4;
    int b, c, h, base, lo, hi; ml_item_geom(it, b, c, h, base, lo, hi);
    if (l == 1 && c < 2) return;
    const u16* proj = (const u16*)(p->ws + WS_R);
    const float* gates = (const float*)(p->ws + WS_GATES);
    u16* Y = (u16*)(p->ws + WS_Y);
    LAS unsigned char* T0 = lds; LAS unsigned char* T1 = lds + TILE_B; LAS unsigned char* T2 = lds + 2 * TILE_B; LAS unsigned char* T3 = T0;
    LAS float* sc_rt = (LAS float*)(lds + SC_OFF);
    LAS float* sc_ct = sc_rt + 256;
    LAS float* sc_in = sc_rt + 512;
    LAS float* sc_em = sc_rt + 768;
    LAS float* sc_n0 = sc_rt + 1024;
    const int srow = tid >> 4, sch = tid & 15;
    u32x4 c0a[4], c0b[4]; u32x2 mor[8];
    { const u16* ca = (const u16*)(p->ws + WS_CST) + (size_t)(((b * 6 + h) * 2 + 0) * NCH + ml_pos(c, 0)) * 16384 + srow * 128 + sch * 8;
      const u16* cb = (const u16*)(p->ws + WS_CST) + (size_t)(((b * 6 + h) * 2 + 1) * NCH + ml_pos(c, 1)) * 16384 + srow * 128 + sch * 8;
#pragma unroll
      for (int i = 0; i < 4; ++i) { c0a[i] = *(const u32x4*)(ca + i * 32 * 128); c0b[i] = *(const u32x4*)(cb + i * 32 * 128); }
      const u16* mo_ = proj + (size_t)(base + 16 * wid + fr) * PLD + OFF_MO + h * 128 + 4 * fq;
#pragma unroll
      for (int nd = 0; nd < 8; ++nd) mor[nd] = *(const u32x2*)(mo_ + 16 * nd); }
    if (wid < 2) { const int d = wid; int t0, t1; float li0, li1, b0, b1;
        ml_gate_scan(gates, base, d, h, p->ml_b_i[l * 12 + d * 6 + h], p->ml_b_f[l * 12 + d * 6 + h], lane, t0, t1, li0, li1, b0, b1);
        const int sq = ((b * 6 + h) * 2 + d) * NCH + ml_pos(c, d);
        const float m0 = ((const float*)(p->ws + WS_M0))[sq];
        const float ct0 = li0 - b0, ct1 = li1 - b1;
        float pm = fmaxf(ct0, ct1);
#pragma unroll
        for (int o = 1; o < 64; o <<= 1) { const float v = __shfl_up(pm, o); if (lane >= o) pm = fmaxf(pm, v); }
        float pe = __shfl_up(pm, 1); if (lane == 0) pe = -INFINITY;
        const float pm0 = fmaxf(pe, ct0), pm1 = pm;
        const float mt0 = fmaxf(b0 + m0, b0 + pm0), mt1 = fmaxf(b1 + m0, b1 + pm1);
        sc_rt[d * 128 + t0] = b0 - mt0; sc_rt[d * 128 + t1] = b1 - mt1;
        sc_ct[d * 128 + t0] = ct0; sc_ct[d * 128 + t1] = ct1;
        sc_in[d * 128 + t0] = __expf(b0 + m0 - mt0); sc_in[d * 128 + t1] = __expf(b1 + m0 - mt1);
        sc_em[d * 128 + t0] = __expf(-mt0); sc_em[d * 128 + t1] = __expf(-mt1);
        const float* n0 = (const float*)(p->ws + WS_NST) + (size_t)sq * 128;
        sc_n0[d * 128 + 2 * lane] = n0[2 * lane]; sc_n0[d * 128 + 2 * lane + 1] = n0[2 * lane + 1]; }
    stage_conv(T0, proj + (size_t)base * PLD + OFF_MQ + h * 128, PLD, lo, hi, p->ml_conv_w + (size_t)l * 4608 + h * 128, p->ml_conv_b + l * 1536 + h * 128, 1.f, tid);
    stage_plain(T1, (const u16*)(p->ws + WS_XN) + (size_t)base * 768 + h * 128, 768, tid);
    stage_plain(T2, proj + (size_t)base * PLD + OFF_MV + h * 128, PLD, tid);
    __syncthreads();
    const int t = 16 * wid + fr;
    bf16x8 Qf[4];
#pragma unroll
    for (int ks = 0; ks < 4; ++ks) Qf[ks] = frag_row(T0, 16 * wid, 32 * ks, lane);
    float nq[2] = {0.f, 0.f};
#pragma unroll
    for (int ks = 0; ks < 4; ++ks) { const u32x4 qv = __builtin_bit_cast(u32x4, Qf[ks]); float q[8]; unpack8(qv, q);
#pragma unroll
        for (int e = 0; e < 8; ++e) { const int k = 32 * ks + 8 * fq + e; nq[0] += q[e] * sc_n0[k]; nq[1] += q[e] * sc_n0[128 + k]; } }
#pragma unroll
    for (int d = 0; d < 2; ++d) { nq[d] += __shfl_xor(nq[d], 16); nq[d] += __shfl_xor(nq[d], 32); }
    f32x4 hs[8];
#pragma unroll
    for (int i = 0; i < 8; ++i) hs[i] = (f32x4){0.f, 0.f, 0.f, 0.f};
#pragma unroll 1
    for (int d = 0; d < 2; ++d) {
        const int sq = ((b * 6 + h) * 2 + d) * NCH + ml_pos(c, d);
        const float nqd = d ? nq[1] : nq[0];
        __syncthreads();
#pragma unroll
        for (int i = 0; i < 4; ++i) { const u32x4 v = d ? c0b[i] : c0a[i]; *(LAS u32x4*)(T3 + toff(srow + 32 * i, sch)) = v; }
        __syncthreads();
        const float rt = sc_rt[d * 128 + t], inter = sc_in[d * 128 + t], em = sc_em[d * 128 + t];
        f32x4 S[8]; float den = 0.f;
#pragma unroll
        for (int n = 0; n < 8; ++n) { S[n] = (f32x4){0.f, 0.f, 0.f, 0.f};
            const bool need = d ? (n >= wid) : (n <= wid);
            if (need) {
#pragma unroll
                for (int ks = 0; ks < 4; ++ks) S[n] = MFMA16(frag_row(T1, 16 * n, 32 * ks, lane), Qf[ks], S[n]);
#pragma unroll
                for (int j = 0; j < 4; ++j) { const int s = 16 * n + 4 * fq + j; const bool valid = d ? (s >= t) : (s <= t);
                    const float w = valid ? __expf(rt + sc_ct[d * 128 + s]) : 0.f; const float pv = S[n][j] * w; S[n][j] = pv; den += pv; }
            }
            __builtin_amdgcn_sched_barrier(0); }
        den += __shfl_xor(den, 16); den += __shfl_xor(den, 32);
        den += inter * nqd;
        bf16x8 Pf[4];
#pragma unroll
        for (int nn = 0; nn < 4; ++nn) { u32x4 o; o.x = pk2(S[2 * nn][0], S[2 * nn][1]); o.y = pk2(S[2 * nn][2], S[2 * nn][3]); o.z = pk2(S[2 * nn + 1][0], S[2 * nn + 1][1]); o.w = pk2(S[2 * nn + 1][2], S[2 * nn + 1][3]); Pf[nn] = __builtin_bit_cast(bf16x8, o); }
        const float inv = 1.f / fmaxf(fabsf(den), em);
#pragma unroll
        for (int nd = 0; nd < 8; ++nd) {
            f32x4 a1 = {0.f, 0.f, 0.f, 0.f}, a2 = {0.f, 0.f, 0.f, 0.f};
#pragma unroll
            for (int nn = 0; nn < 4; ++nn) a1 = MFMA16(frag_tr_perm(T2, 32 * nn, 16 * nd, lane), Pf[nn], a1);
#pragma unroll
            for (int ks = 0; ks < 4; ++ks) a2 = MFMA16(frag_row(T3, 16 * nd, 32 * ks, lane), Qf[ks], a2);
            hs[nd] += (a1 + a2 * inter) * inv;
            __builtin_amdgcn_sched_barrier(0);
        }
    }
    float ss = 0.f;
#pragma unroll
    for (int nd = 0; nd < 8; ++nd) ss += (hs[nd][0] * hs[nd][0] + hs[nd][1] * hs[nd][1]) + (hs[nd][2] * hs[nd][2] + hs[nd][3] * hs[nd][3]);
    ss += __shfl_xor(ss, 16); ss += __shfl_xor(ss, 32);
    const float rstd = rsqrtf(ss * (1.f / 128.f) + EPSN);
    const float* og = p->ml_out_gain + l * 768 + h * 128;
    u16* yr = Y + (size_t)(base + t) * DM + 1280 + h * 128;
    f32x4 gnr[8];
#pragma unroll
    for (int nd = 0; nd < 8; ++nd) gnr[nd] = *(const f32x4*)(og + 16 * nd + 4 * fq);
#pragma unroll
    for (int nd = 0; nd < 8; ++nd) { const int v0 = 16 * nd + 4 * fq; const u32x2 ov = mor[nd]; const f32x4 gn = gnr[nd];
        const float y0 = hs[nd][0] * rstd * gn[0] * sigmoidf_(bf_lo(ov.x)), y1 = hs[nd][1] * rstd * gn[1] * sigmoidf_(bf_hi(ov.x));
        const float y2 = hs[nd][2] * rstd * gn[2] * sigmoidf_(bf_lo(ov.y)), y3 = hs[nd][3] * rstd * gn[3] * sigmoidf_(bf_hi(ov.y));
        u32x2 o; o.x = pk2(y0, y1); o.y = pk2(y2, y3); *(u32x2*)(yr + v0) = o; }
    __syncthreads();
}

#define XB_TMO      128
#define XB_XCNT(j)  (256  + 64 * (j))
#define XB_XSUB(j)  (1280 + 64 * (j))
#define XB_XGEN(j)  (2304 + 64 * (j))
#define XB_TOP      3328
#define XB_TOPGEN   3392
#define XCD_BAR_WORDS 3456
#define XB_SPIN_CAP (1u << 18)

__device__ __forceinline__ unsigned xb_ld(unsigned* p)              { return __hip_atomic_load(p, __ATOMIC_RELAXED, __HIP_MEMORY_SCOPE_AGENT); }
__device__ __forceinline__ unsigned xb_add(unsigned* p, unsigned v) { return __hip_atomic_fetch_add(p, v, __ATOMIC_RELAXED, __HIP_MEMORY_SCOPE_AGENT); }
__device__ __forceinline__ unsigned xb_xcc_id() { return (unsigned)__builtin_amdgcn_s_getreg((3 << 11) | 20) & 0xFu; }
#define XB_SPIN(cond, bar) do { unsigned _sp = 0; while (cond) { __builtin_amdgcn_s_sleep(1); \
    if ((++_sp & 255u) == 0u) { if (xb_ld(&(bar)[XB_TMO])) break; if (_sp > XB_SPIN_CAP) { atomicAdd(&(bar)[XB_TMO], 1u); break; } } } } while (0)

struct XcdBarrier {
    unsigned* bar; unsigned x;
    volatile LAS unsigned* st;
};

__device__ __forceinline__ XcdBarrier xcd_barrier_post(unsigned* bar, volatile LAS unsigned* st) {
    XcdBarrier b; b.bar = bar; b.x = xb_xcc_id(); b.st = st;
    if (threadIdx.x == 0) (void)xb_add(&bar[XB_XCNT(b.x)], 1u);
    return b;
}
__device__ __forceinline__ void xcd_barrier_complete(unsigned* bar, unsigned x, unsigned& nloc, unsigned& nx) {
    const unsigned G = gridDim.x * gridDim.y * gridDim.z;
    unsigned sum, cnt, mine, sp = 0u;
    for (;;) {
        sum = 0u; cnt = 0u; mine = 0u;
#pragma unroll
        for (unsigned j = 0; j < 16; ++j) { const unsigned c = xb_ld(&bar[XB_XCNT(j)]); sum += c; cnt += (c > 0u) ? 1u : 0u; mine = (j == x) ? c : mine; }
        if (sum == G) break;
        __builtin_amdgcn_s_sleep(1);
        if ((++sp & 255u) == 0u) { if (xb_ld(&bar[XB_TMO])) break; if (sp > XB_SPIN_CAP) { atomicAdd(&bar[XB_TMO], 1u); break; } }
    }
    nloc = mine > 0u ? mine : 1u; nx = cnt > 0u ? cnt : 1u;
}

__device__ __forceinline__ void xcd_barrier(const XcdBarrier& b) {
    asm volatile("s_waitcnt vmcnt(0)" ::: "memory");
    __syncthreads();
    if (threadIdx.x == 0) {
        unsigned* bar = b.bar;
        __builtin_amdgcn_s_waitcnt(0);
        unsigned nloc = b.st[0], nx = b.st[1];
        if (nloc == 0u) { xcd_barrier_complete(bar, b.x, nloc, nx); b.st[0] = nloc; b.st[1] = nx; }
        const unsigned old = xb_add(&bar[XB_XSUB(b.x)], 1u);
        const unsigned gen = old / nloc;
        if (old + 1u == (gen + 1u) * nloc) {
            __builtin_amdgcn_fence(__ATOMIC_RELEASE, "agent");
            asm volatile("s_waitcnt vmcnt(0)" ::: "memory");
            const unsigned og = xb_add(&bar[XB_TOP], 1u);
            const unsigned tg = og / nx;
            if (og + 1u == (tg + 1u) * nx) xb_add(&bar[XB_TOPGEN], 1u);
            else XB_SPIN(xb_ld(&bar[XB_TOPGEN]) == tg, bar);
            __builtin_amdgcn_fence(__ATOMIC_ACQUIRE, "agent");
            xb_add(&bar[XB_XGEN(b.x)], 1u);
            asm volatile("s_waitcnt vmcnt(0)" ::: "memory");
        } else {
            XB_SPIN(xb_ld(&bar[XB_XGEN(b.x)]) == gen, bar);
            __builtin_amdgcn_fence(__ATOMIC_ACQUIRE, "agent");
            asm volatile("s_waitcnt vmcnt(0)" ::: "memory");
        }
    }
    __syncthreads();
}

constexpr int N_ATT = 1560, N_ML = 2 * NCH * 6  , N_GM = 260 * 4, N_SCAN = 198, N_ROPE = 260;

DI int next_item(unsigned* ctr, LAS unsigned char* lds) {
    LAS int* slot = (LAS int*)(lds + LDS_BYTES - 16);
    __syncthreads();
    if (threadIdx.x == 0) *slot = (int)atomicAdd(ctr, 1u);
    __syncthreads();
    return *slot;
}

__global__ void __launch_bounds__(512, 2) fwd_megakernel(Params p_unused) {
    const KP kp = (KP)__builtin_amdgcn_kernarg_segment_ptr();
#define PP launder(kp)
    extern __shared__ __attribute__((aligned(16))) unsigned char smem[];
    LAS unsigned char* lds = (LAS unsigned char*)smem;
    cg::grid_group grid = cg::this_grid();
    volatile LAS unsigned* xst = (volatile LAS unsigned*)(lds + LDS_BYTES - 32);
    if (threadIdx.x == 0) { xst[0] = 0u; xst[1] = 0u; }
    __syncthreads();
    { XcdBarrier b0 = xcd_barrier_post((unsigned*)(PP->ws + WS_BAR), xst); (void)b0; }
#define GSYNC() do { XcdBarrier b_; b_.bar = (unsigned*)(PP->ws + WS_BAR); b_.x = xb_xcc_id(); b_.st = xst; xcd_barrier(b_); } while (0)
    phase_prep(PP, lds);
    if (PP->ws == nullptr) grid.sync();
    GSYNC();
    phase_norm0(PP);
    phase_prep2(PP, lds);
    GSYNC();
    for (int l = 0; l < 2; ++l) {
        const int stage = l;
        const int Mres = l == 0 ? MROWS : RLAT;
        unsigned* ctr = (unsigned*)(PP->ws + WS_CTR) + l * 4;
        { EpiProj E; E.O = (u16*)(PP->ws + WS_R); E.gates = (float*)(PP->ws + WS_GATES);
          E.ss = (const float*)(PP->ws + WS_SS) + (l == 0 ? 3 : 1) * MROWS; E.bias0 = (const float*)(PP->ws + WS_BIASP) + (size_t)l * 3 * NPROJ;
          run_gemm(lds, (const u16*)(PP->ws + WS_XN), (const u16*)(PP->ws + WS_WIN + l * SZ_WIN), MROWS, PLD, DM, E); }
        for (;;) { const int it = next_item(ctr + 3, lds); if (it >= 260) break; gate_item(PP, l, it, lds); }
        GSYNC();
        for (;;) { const int it = next_item(ctr + 0, lds); if (it >= N_ROPE + N_ML) break; if (it < N_ROPE) rope_item(PP, it); else ml1_item(PP, l, it - N_ROPE, lds); }
        GSYNC();
        for (;;) { const int it = next_item(ctr + 1, lds); if (it >= N_SCAN + N_ATT + N_GM) break;
            if (it < N_SCAN) scan_item(PP, it);
            else if (it < N_SCAN + N_ATT) attn_item(PP, l, it - N_SCAN, lds);
            else gmlp_item(PP, l, it - N_SCAN - N_ATT, lds); }
        GSYNC();
        for (;;) { const int it = next_item(ctr + 2, lds); if (it >= N_ML) break; ml3_item(PP, l, it, lds); }
        GSYNC();
        { EpiRes E; E.p = PP; E.stage = stage; E.gate0 = (const float*)(PP->ws + WS_MOD) + (size_t)l * 3 * 12288 + 2 * DM;
          E.gs0 = (const float*)(PP->ws + WS_GS) + (size_t)(l * 2 + 1) * 3 * DM; E.ssn = (float*)(PP->ws + WS_SS) + (l == 0 ? 0 : 2) * MROWS; E.ntfull = DM / 64;
          run_gemm_split(lds, (const u16*)(PP->ws + WS_Y), (const u16*)(PP->ws + WS_WOUT + l * SZ_WOUT), RLAT, DM, DM, l == 0 ? 4 : 0, E); }
        GSYNC();
        if (l == 0) { phase_ctx_norm(PP, (const float*)(PP->ws + WS_GS) + (size_t)((0 * 2 + 1) * 3 + 2) * DM, (float*)(PP->ws + WS_SS) + 0 * MROWS, 4); GSYNC(); }
        { EpiSqRelu E; E.O = (u16*)(PP->ws + WS_R); E.ss = (const float*)(PP->ws + WS_SS) + (l == 0 ? 0 : 2) * MROWS; E.bias0 = (const float*)(PP->ws + WS_BIASF) + (size_t)l * 3 * DFF;
          run_gemm(lds, (const u16*)(PP->ws + WS_XN), (const u16*)(PP->ws + WS_WFF1 + l * SZ_WFF), Mres, DFF, DM, E); }
        GSYNC();
        { EpiRes E; E.p = PP; E.stage = 1; E.gate0 = (const float*)(PP->ws + WS_MOD) + (size_t)l * 3 * 12288 + 5 * DM;
          E.gs0 = l == 0 ? (const float*)(PP->ws + WS_GS) + (size_t)(1 * 2 + 0) * 3 * DM : nullptr; E.ssn = (float*)(PP->ws + WS_SS) + 1 * MROWS; E.ntfull = DFF / 64;
          run_gemm_split(lds, (const u16*)(PP->ws + WS_R), (const u16*)(PP->ws + WS_WFF2 + l * SZ_WFF), RLAT, DM, DFF, l == 0 ? 16 : 0, E); }
        GSYNC();
        if (l == 0) { phase_ctx_norm(PP, (const float*)(PP->ws + WS_GS) + (size_t)((1 * 2 + 0) * 3 + 2) * DM, (float*)(PP->ws + WS_SS) + 1 * MROWS, 16); GSYNC(); }
    }
    phase_final(PP);
#undef GSYNC
#undef PP
}

extern "C" void kernel_launch(void* const* d_in, const int* in_sizes, int n_in, void* d_out, int out_size, void* d_ws, size_t ws_size, hipStream_t stream) {
    static int grid_blocks = 0;
    if (grid_blocks == 0) {
        if (n_in != 22 || ws_size < WS_END || out_size != RLAT * DM) { fprintf(stderr, "kernel_launch: unexpected shapes (n_in %d ws %zu need %zu out %d)\n", n_in, ws_size, (size_t)WS_END, out_size); grid_blocks = -1; return; }
        int dev = 0, cus = 0, per_cu = 0;
        hipGetDevice(&dev);
        hipDeviceGetAttribute(&cus, hipDeviceAttributeMultiprocessorCount, dev);
        if (hipFuncSetAttribute((const void*)fwd_megakernel, hipFuncAttributeMaxDynamicSharedMemorySize, LDS_BYTES) != hipSuccess) { fprintf(stderr, "kernel_launch: hipFuncSetAttribute failed\n"); grid_blocks = -1; return; }
        hipOccupancyMaxActiveBlocksPerMultiprocessor(&per_cu, (const void*)fwd_megakernel, 512, LDS_BYTES);
        if (per_cu < 1) { fprintf(stderr, "kernel_launch: occupancy query says %d blocks per CU\n", per_cu); per_cu = 1; }
        (void)hipGetLastError();
        grid_blocks = cus * 1;
    }
    if (grid_blocks < 0) return;
    if (hipMemsetAsync((unsigned char*)d_ws + WS_BAR, 0, 16384, stream) != hipSuccess) { fprintf(stderr, "kernel_launch: memset failed\n"); return; }
    Params p{};
    const float** pp = (const float**)&p;
    for (int i = 0; i < 22; ++i) pp[i] = (const float*)d_in[i];
    p.out = (float*)d_out; p.ws = (unsigned char*)d_ws;
    void* args[] = {&p};
    hipError_t e = hipLaunchCooperativeKernel((const void*)fwd_megakernel, dim3(grid_blocks), dim3(512), args, LDS_BYTES, stream);
    if (e != hipSuccess) fprintf(stderr, "cooperative launch failed: %s (grid %d)\n", hipGetErrorString(e), grid_blocks);
}
```
